# Optimizing an MI355X kernel written in HIP

```python
import jax, jax.numpy as jnp
from jax import lax
import numpy as np

D_MODEL = 1024
BATCH = 32
SEQ = 2048
DEPTH = 1

HG_HEADS = 4
HG_DIM = 128
HG_WIDTH = HG_HEADS * HG_DIM
HG_CHUNK = 64
MB_HEADS = 8
MB_HEAD_DIM = 64
MB_WIDTH = MB_HEADS * MB_HEAD_DIM
MB_BLOCK = 256
MB_TOPK = 3
MB_QCHUNK = 4
ROPE_THETA = 10000.0
D_FF = 2816
CONV_WIDTH = 3
NORM_EPS = 1e-6
IN_WIDTHS = (HG_WIDTH, HG_WIDTH, HG_WIDTH, HG_WIDTH, MB_WIDTH, MB_WIDTH, MB_WIDTH, D_MODEL, D_MODEL)
D_IN = sum(IN_WIDTHS)
IN_SPLITS = tuple(int(s) for s in np.cumsum(IN_WIDTHS)[:-1])

kernel_name = "hybrid_hgrn2_moba_convffn_block"


def rms_norm(x, g):
    xf = x.astype(jnp.float32)
    y = xf * lax.rsqrt(jnp.mean(xf * xf, axis=-1, keepdims=True) + NORM_EPS)
    return (y * g.astype(jnp.float32)).astype(x.dtype)


def rope(x, pos):
    d = x.shape[-1]
    half = d // 2
    inv = 1.0 / (ROPE_THETA ** (jnp.arange(half, dtype=jnp.float32) * 2.0 / d))
    ang = pos.astype(jnp.float32)[:, None] * inv[None, :]
    cos = jnp.cos(ang)[:, None, :]
    sin = jnp.sin(ang)[:, None, :]
    xf = x.astype(jnp.float32)
    x1, x2 = xf[..., :half], xf[..., half:]
    return jnp.concatenate([x1 * cos - x2 * sin, x2 * cos + x1 * sin], axis=-1).astype(x.dtype)


def _to_chunks(t):
    b, s, h, e = t.shape
    return t.reshape(b, s // HG_CHUNK, HG_CHUNK, h, e).transpose(1, 0, 3, 2, 4)


def hgrn2_chunkwise(q, k, v, logf):
    b, s, h, dk = q.shape
    dv = v.shape[-1]
    causal = jnp.tril(jnp.ones((HG_CHUNK, HG_CHUNK), dtype=bool))

    def step(state, inp):
        qc, kc, vc, lf = inp
        cum = jnp.cumsum(lf, axis=2)
        o_inter = jnp.einsum('bhck,bhkv->bhcv', qc * jnp.exp(cum), state)
        diff = cum[:, :, :, None, :] - cum[:, :, None, :, :]
        decay = jnp.exp(jnp.where(causal[None, None, :, :, None], diff, -jnp.inf))
        attn = jnp.einsum('bhtk,bhtsk,bhsk->bhts', qc, decay, kc)
        o = o_inter + jnp.einsum('bhts,bhsv->bhtv', attn, vc)
        last = cum[:, :, -1:, :]
        new_state = jnp.exp(last[:, :, 0, :])[..., None] * state + jnp.einsum(
            'bhsk,bhsv->bhkv', kc * jnp.exp(last - cum), vc)
        return new_state, o

    state0 = jnp.zeros((b, h, dk, dv), jnp.float32)
    _, o = lax.scan(step, state0, (_to_chunks(q), _to_chunks(k), _to_chunks(v), _to_chunks(logf)))
    return o.transpose(1, 0, 3, 2, 4).reshape(b, s, h, dv)


def moba_attention(q, k, v):
    b, s, h, d = q.shape
    nb = -(-s // MB_BLOCK)
    pad = nb * MB_BLOCK - s
    scale = 1.0 / float(np.sqrt(d))
    qt = q.transpose(0, 2, 1, 3)
    kb = jnp.pad(k.transpose(0, 2, 1, 3), ((0, 0), (0, 0), (0, pad), (0, 0))).reshape(b, h, nb, MB_BLOCK, d)
    vb = jnp.pad(v.transpose(0, 2, 1, 3), ((0, 0), (0, 0), (0, pad), (0, 0))).reshape(b, h, nb, MB_BLOCK, d)
    kmean = jnp.mean(kb.astype(jnp.float32), axis=3)

    pos = jnp.arange(s)
    qblk = pos // MB_BLOCK
    gate = jnp.einsum('bhsd,bhnd->bhsn', qt.astype(jnp.float32), kmean)
    fully_past = jnp.arange(nb)[None, :] < qblk[:, None]
    gate = jnp.where(fully_past[None, None], gate, -jnp.inf)
    n_sel = max(1, min(MB_TOPK, nb - 1))
    _, idx = lax.top_k(gate, n_sel)
    valid = jnp.arange(n_sel)[None, :] < qblk[:, None]

    nq = s // MB_QCHUNK
    q_ch = qt.reshape(b, h, nq, MB_QCHUNK, d).transpose(2, 0, 1, 3, 4)
    i_ch = idx.reshape(b, h, nq, MB_QCHUNK, n_sel).transpose(2, 0, 1, 3, 4)
    v_ch = valid.reshape(nq, MB_QCHUNK, n_sel)
    p_ch = pos.reshape(nq, MB_QCHUNK)
    bi = jnp.arange(b)[:, None, None, None]
    hi = jnp.arange(h)[None, :, None, None]

    def attend(inp):
        qc, ic, vc, pc = inp
        kg = kb[bi, hi, ic]
        vg = vb[bi, hi, ic]
        own = pc[0] // MB_BLOCK
        k_own = lax.dynamic_index_in_dim(kb, own, axis=2, keepdims=False)
        v_own = lax.dynamic_index_in_dim(vb, own, axis=2, keepdims=False)
        s_sel = jnp.einsum('bhqd,bhqrkd->bhqrk', qc, kg).astype(jnp.float32) * scale
        s_sel = jnp.where(vc[None, None, :, :, None], s_sel, -jnp.inf)
        s_own = jnp.einsum('bhqd,bhkd->bhqk', qc, k_own).astype(jnp.float32) * scale
        key_pos = own * MB_BLOCK + jnp.arange(MB_BLOCK)
        s_own = jnp.where((key_pos[None, :] <= pc[:, None])[None, None], s_own, -jnp.inf)
        logits = jnp.concatenate([s_sel.reshape(b, h, MB_QCHUNK, n_sel * MB_BLOCK), s_own], axis=-1)
        p = jax.nn.softmax(logits, axis=-1)
        p_sel = p[..., :n_sel * MB_BLOCK].reshape(b, h, MB_QCHUNK, n_sel, MB_BLOCK).astype(vg.dtype)
        p_own = p[..., n_sel * MB_BLOCK:].astype(v_own.dtype)
        return (jnp.einsum('bhqrk,bhqrkd->bhqd', p_sel, vg)
                + jnp.einsum('bhqk,bhkd->bhqd', p_own, v_own))

    o = lax.map(attend, (q_ch, i_ch, v_ch, p_ch))
    return o.transpose(1, 0, 3, 2, 4).reshape(b, s, h, d)


def causal_dwconv(u, w, bias):
    s = u.shape[1]
    up = jnp.pad(u, ((0, 0), (CONV_WIDTH - 1, 0), (0, 0)))
    out = bias
    for j in range(CONV_WIDTH):
        out = out + up[:, j:j + s] * w[j]
    return out


def setup_inputs(seed: int = 0) -> dict:
    key = jax.random.key(seed)
    ks = jax.random.split(key, 16)
    f32 = jnp.float32

    def nrm(k, shape, scale):
        return jax.random.normal(k, shape, f32) * scale

    return {
        "x": nrm(ks[0], (BATCH, SEQ, D_MODEL), 1.0),
        "norm1_g": 1.0 + nrm(ks[1], (DEPTH, D_MODEL), 0.02),
        "w_in": nrm(ks[2], (DEPTH, D_MODEL, D_IN), D_MODEL ** -0.5),
        "hg_lb_logits": nrm(ks[3], (DEPTH + 1, HG_WIDTH), 1.0),
        "hg_onorm_g": 1.0 + nrm(ks[4], (DEPTH, HG_HEADS, HG_DIM), 0.02),
        "q_norm_g": 1.0 + nrm(ks[5], (DEPTH, MB_HEAD_DIM), 0.02),
        "k_norm_g": 1.0 + nrm(ks[6], (DEPTH, MB_HEAD_DIM), 0.02),
        "w_a": nrm(ks[7], (DEPTH, HG_WIDTH, D_MODEL), HG_WIDTH ** -0.5),
        "w_b": nrm(ks[8], (DEPTH, MB_WIDTH, D_MODEL), MB_WIDTH ** -0.5),
        "w_out": nrm(ks[9], (DEPTH, D_MODEL, D_MODEL), D_MODEL ** -0.5),
        "norm2_g": 1.0 + nrm(ks[10], (DEPTH, D_MODEL), 0.02),
        "w_up": nrm(ks[11], (DEPTH, D_MODEL, 2 * D_FF), D_MODEL ** -0.5),
        "conv_w": nrm(ks[12], (DEPTH, CONV_WIDTH, D_FF), CONV_WIDTH ** -0.5),
        "conv_b": nrm(ks[13], (DEPTH, D_FF), 0.01),
        "w_down": nrm(ks[14], (DEPTH, D_FF, D_MODEL), D_FF ** -0.5),
    }


def reference(x, norm1_g, w_in, hg_lb_logits, hg_onorm_g, q_norm_g, k_norm_g, w_a, w_b, w_out,
              norm2_g, w_up, conv_w, conv_b, w_down):
    b, s, _ = x.shape
    pos = jnp.arange(s)
    lower_bounds = jnp.cumsum(jax.nn.softmax(hg_lb_logits.astype(jnp.float32), axis=0), axis=0)
    for l in range(DEPTH):
        h = rms_norm(x, norm1_g[l])
        proj = h @ w_in[l]
        hq, hf, hi, hg, mq, mk, mv, ga, gb = jnp.split(proj, IN_SPLITS, axis=-1)

        lb = lower_bounds[l]
        f = lb + (1.0 - lb) * jax.nn.sigmoid(hf.astype(jnp.float32))
        logf = jnp.log(f)
        k_in = 1.0 - f
        q_a = jax.nn.silu(hq.astype(jnp.float32))
        hd = (b, s, HG_HEADS, HG_DIM)
        o_a = hgrn2_chunkwise(q_a.reshape(hd), k_in.reshape(hd),
                              hi.astype(jnp.float32).reshape(hd), logf.reshape(hd))
        o_a = rms_norm(o_a, hg_onorm_g[l]).reshape(b, s, HG_WIDTH).astype(x.dtype) * jax.nn.silu(hg)

        md = (b, s, MB_HEADS, MB_HEAD_DIM)
        q_b = rope(rms_norm(mq.reshape(md), q_norm_g[l]), pos)
        k_b = rope(rms_norm(mk.reshape(md), k_norm_g[l]), pos)
        o_b = moba_attention(q_b, k_b, mv.reshape(md)).reshape(b, s, MB_WIDTH)

        mix = jax.nn.sigmoid(ga) * (o_a @ w_a[l]) + jax.nn.sigmoid(gb) * (o_b @ w_b[l])
        x = x + mix @ w_out[l]

        h2 = rms_norm(x, norm2_g[l])
        u, v = jnp.split(h2 @ w_up[l], 2, axis=-1)
        u = causal_dwconv(u, conv_w[l], conv_b[l])
        x = x + (jax.nn.gelu(u, approximate=False) * v) @ w_down[l]
    return x
```

```cpp
#include <hip/hip_runtime.h>
#include <hip/hip_cooperative_groups.h>
#include <cstdio>
#include <cstdint>
namespace cg = cooperative_groups;
namespace pg8 {
#define PG8_LAS __attribute__((address_space(3)))
typedef unsigned short bf16_t;
typedef short bf16x8 __attribute__((ext_vector_type(8)));
typedef float f32x4 __attribute__((ext_vector_type(4)));
typedef unsigned u32x4 __attribute__((ext_vector_type(4)));
constexpr int BM = 256, BK = 64, HALF = 128, HTB = HALF * BK * 2  , STAGE_BYTES = 8 * HTB, NXCD = 8, WGM = 8;

__host__ __device__ __forceinline__ int lds_byte(int r, int c) { const int st = (r >> 4) * 2 + (c >> 5), rr = r & 15, cc = c & 31, ob = rr * 64 + cc * 2; return st * 1024 + (ob ^ (((ob >> 9) & 1) << 5)); }
__host__ __device__ __forceinline__ void stage_rc(int b, int& R, int& C) { const int st = b / 1024, sb = b % 1024, swz = sb ^ (((sb >> 9) & 1) << 5); R = (st >> 1) * 16 + swz / 64; C = (st & 1) * 32 + (swz % 64) / 2; }
__host__ __device__ __forceinline__ int perm32(int rho) { const int n = rho >> 4, i = rho & 15; return 8 * (i >> 2) + 4 * n + (i & 3); }

struct Unit { int pm, pn; };
struct Gemm { const bf16_t* A; const bf16_t* Bt; int M, N, K; };

struct StaticOrder {
    int nM, nN, nwg, G, c;
    __host__ __device__ void init(int M, int N, int G_, int c_) { nM = M / BM; nN = N / BM; nwg = nM * nN; G = G_; c = c_; }
    __host__ __device__ bool next(int i, Unit& u) const {
        const long L = (long)i * G + c; if (L >= nwg) return false;
        int wgid = (int)L; { const int q = nwg / NXCD, r = nwg % NXCD, xcd = wgid % NXCD, off = wgid / NXCD; wgid = (xcd < r ? xcd * (q + 1) : r * (q + 1) + (xcd - r) * q) + off; }
        const int nig = WGM * nN, gid = wgid / nig, fm = gid * WGM, gsz = (nM - fm) < WGM ? (nM - fm) : WGM;
        u.pm = fm + ((wgid % nig) % gsz); u.pn = (wgid % nig) / gsz; return true;
    }
    __device__ __forceinline__ void a_ready(const Unit&) const {}
    __device__ __forceinline__ void done(const Unit&) const {}
};

typedef float cvt_f32x2_t __attribute__((ext_vector_type(2))); typedef __bf16 cvt_bf16x2_t __attribute__((ext_vector_type(2)));
__device__ __forceinline__ unsigned cvt_pk_bf16(float lo, float hi) { const cvt_f32x2_t v = {lo, hi}; return __builtin_bit_cast(unsigned, __builtin_convertvector(v, cvt_bf16x2_t)); }
typedef float f32x2 __attribute__((ext_vector_type(2)));
__device__ __forceinline__ f32x2 gelu_pk(f32x2 v) {
    const f32x2 av = __builtin_elementwise_abs(v), d = av * 0.2316418882f + 1.0f;
    f32x2 t; t.x = __builtin_amdgcn_rcpf(d.x); t.y = __builtin_amdgcn_rcpf(d.y);
    f32x2 q = t * 0.5307027145f + (-0.7265760135f); q = q * t + 0.7107068705f; q = q * t + (-0.142248368f); q = q * t + 0.127414796f; q = q * t;
    const f32x2 s = (v * v) * (-0.72134752044f);
    f32x2 e; e.x = __builtin_amdgcn_exp2f(s.x); e.y = __builtin_amdgcn_exp2f(s.y);
    const f32x2 m = v * (q * e), r = v - m;
    f32x2 o; o.x = v.x < 0.f ? m.x : r.x; o.y = v.y < 0.f ? m.y : r.y; return o;
}

template <int ACT  > struct EpiBf16 {
    static constexpr bool PERM = true, AFTER_DRAIN = false; static_assert(ACT == 0 || ACT == 1, "EpiBf16: ACT is 0 (none) or 1 (gelu_pk)");
    bf16_t* O; int ldc; const float* bias; int split_cols; size_t split_stride; float scale0;
    __device__ __forceinline__ void operator()(const f32x4 (&acc)[2][2][4][2], const Unit& u, int wr, int wc, int fr, int fq) const {
        const int row0 = u.pm * BM + wr * 64 + fr; int colt = u.pn * BM; bf16_t* base = O;
        float sc = 1.f; if (split_cols) { const int t = colt / split_cols; base += (size_t)t * split_stride; colt -= t * split_cols; if (t == 0) sc = scale0; }
        const int col0 = colt + wc * 32 + 8 * fq, bcol0 = u.pn * BM + wc * 32 + 8 * fq;
        f32x4 bv[2][2];
#pragma unroll
        for (int bj = 0; bj < 2; ++bj)
#pragma unroll
            for (int n = 0; n < 2; ++n) bv[bj][n] = bias ? *(const f32x4*)(bias + bcol0 + bj * HALF + 4 * n) : (f32x4){0.f, 0.f, 0.f, 0.f};
#pragma unroll
        for (int ai = 0; ai < 2; ++ai)
#pragma unroll
            for (int m = 0; m < 4; ++m) { bf16_t* rowp = base + (size_t)(row0 + ai * HALF + m * 16) * ldc + col0;
#pragma unroll
                for (int bj = 0; bj < 2; ++bj) { f32x4 v0 = acc[ai][bj][m][0] + bv[bj][0], v1 = acc[ai][bj][m][1] + bv[bj][1];
                    if (ACT == 1) { f32x2 a = gelu_pk((f32x2){v0[0], v0[1]}), b = gelu_pk((f32x2){v0[2], v0[3]}), c = gelu_pk((f32x2){v1[0], v1[1]}), d = gelu_pk((f32x2){v1[2], v1[3]});
                        v0 = (f32x4){a.x, a.y, b.x, b.y}; v1 = (f32x4){c.x, c.y, d.x, d.y}; }
                    v0 = v0 * sc; v1 = v1 * sc; u32x4 w; w.x = cvt_pk_bf16(v0[0], v0[1]); w.y = cvt_pk_bf16(v0[2], v0[3]); w.z = cvt_pk_bf16(v1[0], v1[1]); w.w = cvt_pk_bf16(v1[2], v1[3]);
                    *(u32x4*)(rowp + bj * HALF) = w; } }
    }
};
__device__ __forceinline__ float bf2f(unsigned h) { return __uint_as_float(h << 16); }
__device__ __forceinline__ float sigm(float x) { return __builtin_amdgcn_rcpf(1.0f + __expf(-x)); }
struct EpiInProj {
    static constexpr bool PERM = true, AFTER_DRAIN = false;
    bf16_t* HG; bf16_t* QKV; bf16_t* GT; const float* lbl;
    const float* qg; const float* kg; const float* rope; float* kmean;
    __device__ __forceinline__ void operator()(const f32x4 (&acc)[2][2][4][2], const Unit& u, int wr, int wc, int fr, int fq) const {
        const int row0 = u.pm * BM + wr * 64 + fr; const int colt = u.pn * BM; const int seg = colt >> 9;
        bf16_t* base; int ldc, cb, mode;
        if (seg < 4) { base = HG; ldc = 2048; cb = colt; mode = (seg == 1) ? 1 : (seg == 2 ? 2 : 0); }
        else if (seg < 7) { base = QKV; ldc = 1536; cb = colt - 2048; mode = 2; }
        else { base = GT; ldc = 2048; cb = colt - 3584; mode = 3; }
        if (seg == 4 || seg == 5) {
            const bool isq = (seg == 4); const float* gn = isq ? qg : kg; const float sc = isq ? (0.125f * 1.4426950408889634f) : 1.0f;
            float g0[8], g1[8], ks0[8], ks1[8];
#pragma unroll
            for (int e = 0; e < 8; ++e) { g0[e] = gn[8 * fq + e] * sc; g1[e] = gn[32 + 8 * fq + e] * sc; ks0[e] = 0.f; ks1[e] = 0.f; }
            bf16_t* obase = QKV + cb + 64 * wc + 8 * fq;
#pragma unroll
            for (int ai = 0; ai < 2; ++ai)
#pragma unroll
                for (int m = 0; m < 4; ++m) { const int row = row0 + ai * HALF + m * 16; const int pos = row & 2047;
                    const f32x4 a0 = acc[ai][0][m][0], a1 = acc[ai][0][m][1], b0 = acc[ai][1][m][0], b1 = acc[ai][1][m][1];
                    const float v0[8] = {a0[0], a0[1], a0[2], a0[3], a1[0], a1[1], a1[2], a1[3]}, v1[8] = {b0[0], b0[1], b0[2], b0[3], b1[0], b1[1], b1[2], b1[3]};
                    float ss = 0.f;
#pragma unroll
                    for (int e = 0; e < 8; ++e) ss += v0[e] * v0[e] + v1[e] * v1[e];
                    ss += __shfl_xor(ss, 16); ss += __shfl_xor(ss, 32);
                    const float rstd = 1.0f / sqrtf(ss * (1.0f / 64.0f) + 1e-6f);
                    const f32x4* tp = (const f32x4*)(rope + ((size_t)pos * 32 + 8 * fq) * 2);
                    float o0[8], o1[8];
#pragma unroll
                    for (int j = 0; j < 4; ++j) { const f32x4 t = tp[j];
                        { const float y0 = v0[2 * j] * rstd * g0[2 * j], y1 = v1[2 * j] * rstd * g1[2 * j]; o0[2 * j] = y0 * t[0] - y1 * t[1]; o1[2 * j] = y1 * t[0] + y0 * t[1]; }
                        { const float y0 = v0[2 * j + 1] * rstd * g0[2 * j + 1], y1 = v1[2 * j + 1] * rstd * g1[2 * j + 1]; o0[2 * j + 1] = y0 * t[2] - y1 * t[3]; o1[2 * j + 1] = y1 * t[2] + y0 * t[3]; } }
                    if (!isq) {
#pragma unroll
                        for (int e = 0; e < 8; ++e) { ks0[e] += o0[e]; ks1[e] += o1[e]; } }
                    u32x4 w0, w1; w0.x = cvt_pk_bf16(o0[0], o0[1]); w0.y = cvt_pk_bf16(o0[2], o0[3]); w0.z = cvt_pk_bf16(o0[4], o0[5]); w0.w = cvt_pk_bf16(o0[6], o0[7]);
                    w1.x = cvt_pk_bf16(o1[0], o1[1]); w1.y = cvt_pk_bf16(o1[2], o1[3]); w1.z = cvt_pk_bf16(o1[4], o1[5]); w1.w = cvt_pk_bf16(o1[6], o1[7]);
                    *(u32x4*)(obase + (size_t)row * 1536) = w0; *(u32x4*)(obase + (size_t)row * 1536 + 32) = w1; }
            if (!isq) {
                const int head = ((colt - 2560) >> 6) + wc; float* km = kmean + ((size_t)((u.pm >> 3) * 8 + head) * 8 + (u.pm & 7)) * 64 + 8 * fq;
#pragma unroll
                for (int e = 0; e < 8; ++e) { float a = ks0[e], b = ks1[e];
                    a += __shfl_xor(a, 1); a += __shfl_xor(a, 2); a += __shfl_xor(a, 4); a += __shfl_xor(a, 8);
                    b += __shfl_xor(b, 1); b += __shfl_xor(b, 2); b += __shfl_xor(b, 4); b += __shfl_xor(b, 8);
                    if (fr == 0) { atomicAdd(km + e, a * (1.0f / 256.0f)); atomicAdd(km + 32 + e, b * (1.0f / 256.0f)); } } }
            return;
        }
        const int col0 = cb + wc * 32 + 8 * fq;
        if (mode == 0) tile_store<0>(acc, base, ldc, row0, col0, colt, wc, fq);
        else if (mode == 1) tile_store<1>(acc, base, ldc, row0, col0, colt, wc, fq);
        else if (mode == 2) tile_store<2>(acc, base, ldc, row0, col0, colt, wc, fq);
        else tile_store<3>(acc, base, ldc, row0, col0, colt, wc, fq);
    }
    template <int MODE> __device__ __forceinline__ void tile_store(const f32x4 (&acc)[2][2][4][2], bf16_t* base, int ldc, int row0, int col0, int colt, int wc, int fq) const {
        float lb[2][8];
#pragma unroll
        for (int bj = 0; bj < 2; ++bj)
#pragma unroll
            for (int e = 0; e < 8; ++e) lb[bj][e] = 0.f;
        if (MODE == 1) { const int c0 = colt - 512 + wc * 32 + 8 * fq;
#pragma unroll
            for (int bj = 0; bj < 2; ++bj)
#pragma unroll
                for (int e = 0; e < 8; ++e) lb[bj][e] = sigm(lbl[c0 + bj * HALF + e] - lbl[512 + c0 + bj * HALF + e]); }
#pragma unroll
        for (int ai = 0; ai < 2; ++ai)
#pragma unroll
            for (int m = 0; m < 4; ++m) { bf16_t* rowp = base + (size_t)(row0 + ai * HALF + m * 16) * ldc + col0;
#pragma unroll
                for (int bj = 0; bj < 2; ++bj) { const f32x4 a0 = acc[ai][bj][m][0], a1 = acc[ai][bj][m][1];
                    float v[8] = {a0[0], a0[1], a0[2], a0[3], a1[0], a1[1], a1[2], a1[3]};
                    if (MODE == 0) {
#pragma unroll
                        for (int e = 0; e < 8; ++e) v[e] = v[e] * sigm(v[e]);
                    } else if (MODE == 1) {
#pragma unroll
                        for (int e = 0; e < 8; ++e) { const float s = sigm(v[e]); v[e] = __logf(lb[bj][e] + (1.0f - lb[bj][e]) * s); }
                    } else if (MODE == 3) {
#pragma unroll
                        for (int e = 0; e < 8; ++e) v[e] = sigm(v[e]);
                    }
                    u32x4 w; w.x = cvt_pk_bf16(v[0], v[1]); w.y = cvt_pk_bf16(v[2], v[3]); w.z = cvt_pk_bf16(v[4], v[5]); w.w = cvt_pk_bf16(v[6], v[7]);
                    *(u32x4*)(rowp + bj * HALF) = w; } }
    }
};
template <int SECOND> struct EpiGateMix {
    static constexpr bool PERM = true, AFTER_DRAIN = false;
    bf16_t* O; const bf16_t* gate;
    __device__ __forceinline__ void operator()(const f32x4 (&acc)[2][2][4][2], const Unit& u, int wr, int wc, int fr, int fq) const {
        const int row0 = u.pm * BM + wr * 64 + fr; const int col0 = u.pn * BM + wc * 32 + 8 * fq;
#pragma unroll
        for (int ai = 0; ai < 2; ++ai)
#pragma unroll
            for (int m = 0; m < 4; ++m) { const size_t r = (size_t)(row0 + ai * HALF + m * 16);
#pragma unroll
                for (int bj = 0; bj < 2; ++bj) { const int c = col0 + bj * HALF;
                    const u32x4 g = *(const u32x4*)(gate + r * 2048 + c);
                    u32x4 p = (u32x4){0u, 0u, 0u, 0u}; if (SECOND) p = *(const u32x4*)(O + r * 1024 + c);
                    const f32x4 a0 = acc[ai][bj][m][0], a1 = acc[ai][bj][m][1];
                    float v[8] = {a0[0], a0[1], a0[2], a0[3], a1[0], a1[1], a1[2], a1[3]};
#pragma unroll
                    for (int i = 0; i < 4; ++i) { v[2 * i] = v[2 * i] * bf2f(g[i] & 0xffffu) + bf2f(p[i] & 0xffffu); v[2 * i + 1] = v[2 * i + 1] * bf2f(g[i] >> 16) + bf2f(p[i] >> 16); }
                    u32x4 w; w.x = cvt_pk_bf16(v[0], v[1]); w.y = cvt_pk_bf16(v[2], v[3]); w.z = cvt_pk_bf16(v[4], v[5]); w.w = cvt_pk_bf16(v[6], v[7]);
                    *(u32x4*)(O + r * 1024 + c) = w; } }
    }
};
struct EpiResF32 {
    static constexpr bool PERM = false, AFTER_DRAIN = false;
    const float* base; float* out; int ldc;
    __device__ __forceinline__ void operator()(const f32x4 (&acc)[2][2][4][2], const Unit& u, int wr, int wc, int fr, int fq) const {
        const int col0 = u.pn * BM + wc * 32 + 4 * fq;
#pragma unroll
        for (int ai = 0; ai < 2; ++ai)
#pragma unroll
            for (int m = 0; m < 4; ++m) { const size_t off = (size_t)(u.pm * BM + ai * HALF + wr * 64 + m * 16 + fr) * ldc + col0;
#pragma unroll
                for (int bj = 0; bj < 2; ++bj)
#pragma unroll
                    for (int n = 0; n < 2; ++n) { const f32x4 bs = *(const f32x4*)(base + off + bj * HALF + n * 16); *(f32x4*)(out + off + bj * HALF + n * 16) = bs + acc[ai][bj][m][n]; } }
    }
};

struct EpiResNorm {
    static constexpr bool PERM = true, AFTER_DRAIN = false;
    const float* base; float* out; bf16_t* xb; float* rowss;
    __device__ __forceinline__ void operator()(const f32x4 (&acc)[2][2][4][2], const Unit& u, int wr, int wc, int fr, int fq) const {
        const int col0 = u.pn * BM + wc * 32 + 8 * fq;
#pragma unroll
        for (int ai = 0; ai < 2; ++ai)
#pragma unroll
            for (int m = 0; m < 4; ++m) { const int row = u.pm * BM + ai * HALF + wr * 64 + m * 16 + fr; const size_t off = (size_t)row * 1024 + col0; float s = 0.f;
#pragma unroll
                for (int bj = 0; bj < 2; ++bj) { const f32x4 o0 = *(const f32x4*)(base + off + bj * HALF) + acc[ai][bj][m][0], o1 = *(const f32x4*)(base + off + bj * HALF + 4) + acc[ai][bj][m][1];
                    *(f32x4*)(out + off + bj * HALF) = o0; *(f32x4*)(out + off + bj * HALF + 4) = o1;
                    s += (o0[0] * o0[0] + o0[1] * o0[1]) + (o0[2] * o0[2] + o0[3] * o0[3]) + (o1[0] * o1[0] + o1[1] * o1[1]) + (o1[2] * o1[2] + o1[3] * o1[3]);
                    u32x4 w; w.x = cvt_pk_bf16(o0[0], o0[1]); w.y = cvt_pk_bf16(o0[2], o0[3]); w.z = cvt_pk_bf16(o1[0], o1[1]); w.w = cvt_pk_bf16(o1[2], o1[3]);
                    *(u32x4*)(xb + off + bj * HALF) = w; }
                s += __shfl_xor(s, 16); s += __shfl_xor(s, 32);
                if (fq == 0) atomicAdd(rowss + row, s); }
    }
};
__device__ __forceinline__ float dpp_shr1(float v) { return __builtin_bit_cast(float, __builtin_amdgcn_update_dpp(0, __builtin_bit_cast(int, v), 0x111, 0xf, 0xf, true)); }
__device__ __forceinline__ float dpp_shr2(float v) { return __builtin_bit_cast(float, __builtin_amdgcn_update_dpp(0, __builtin_bit_cast(int, v), 0x112, 0xf, 0xf, true)); }
__device__ __forceinline__ float dpp_shr1_old(float oldv, float v) { return __builtin_bit_cast(float, __builtin_amdgcn_update_dpp(__builtin_bit_cast(int, oldv), __builtin_bit_cast(int, v), 0x111, 0xf, 0xf, false)); }
__device__ __forceinline__ float dpp_shr2_old(float oldv, float v) { return __builtin_bit_cast(float, __builtin_amdgcn_update_dpp(__builtin_bit_cast(int, oldv), __builtin_bit_cast(int, v), 0x112, 0xf, 0xf, false)); }
struct EpiUpConv {
    static constexpr bool PERM = true, AFTER_DRAIN = false;
    bf16_t* G; const float* conv_w; const float* conv_b; float* ufirst; float* vfirst; float* ulast; PG8_LAS float* xch; const float* rowss;
    __device__ __forceinline__ void operator()(const f32x4 (&acc0)[2][2][4][2], const Unit& u, int wr, int wc, int fr, int fq) const {
        const int ch0 = u.pn * 128 + wc * 32 + 8 * fq;
        float w0[8], w1[8], w2[8], bb[8];
#pragma unroll
        for (int j = 0; j < 2; ++j) { const f32x4 a = *(const f32x4*)(conv_w + ch0 + 4 * j), b = *(const f32x4*)(conv_w + 2816 + ch0 + 4 * j), c = *(const f32x4*)(conv_w + 5632 + ch0 + 4 * j), d = *(const f32x4*)(conv_b + ch0 + 4 * j);
#pragma unroll
            for (int e = 0; e < 4; ++e) { w0[4 * j + e] = a[e]; w1[4 * j + e] = b[e]; w2[4 * j + e] = c[e]; bb[4 * j + e] = d[e]; } }
        f32x4 acc[2][2][4][2];
#pragma unroll
        for (int ai = 0; ai < 2; ++ai)
#pragma unroll
            for (int m = 0; m < 4; ++m) { const float rs = 1.0f / sqrtf(rowss[u.pm * BM + ai * HALF + wr * 64 + m * 16 + fr] * (1.0f / 1024.0f) + 1e-6f);
#pragma unroll
                for (int bj = 0; bj < 2; ++bj)
#pragma unroll
                    for (int n = 0; n < 2; ++n) acc[ai][bj][m][n] = acc0[ai][bj][m][n] * rs; }
        if (fr >= 14) {
#pragma unroll
            for (int ai = 0; ai < 2; ++ai)
#pragma unroll
                for (int m = 0; m < 4; ++m) { const int g = 4 * (2 * ai + wr) + m; PG8_LAS f32x4* p = (PG8_LAS f32x4*)(xch + (((g * 4 + wc) * 2 + (fr - 14)) * 4 + fq) * 8);
                    p[0] = acc[ai][0][m][0]; p[1] = acc[ai][0][m][1]; }
            if (wr == 1) { float* pl = ulast + (size_t)(u.pm * 2 + (fr - 14)) * 2816 + ch0; *(f32x4*)pl = acc[1][0][3][0]; *(f32x4*)(pl + 4) = acc[1][0][3][1]; }
        }
        if (wr == 0 && fr < 2) { float* pu = ufirst + (size_t)(u.pm * 2 + fr) * 2816 + ch0; *(f32x4*)pu = acc[0][0][0][0]; *(f32x4*)(pu + 4) = acc[0][0][0][1];
            float* pv = vfirst + (size_t)(u.pm * 2 + fr) * 2816 + ch0; *(f32x4*)pv = acc[0][1][0][0]; *(f32x4*)(pv + 4) = acc[0][1][0][1]; }
        asm volatile("s_waitcnt lgkmcnt(0)" ::: "memory"); __builtin_amdgcn_s_barrier(); asm volatile("" ::: "memory");
        const int row0 = u.pm * BM + wr * 64 + fr;
#pragma unroll
        for (int ai = 0; ai < 2; ++ai)
#pragma unroll
            for (int m = 0; m < 4; ++m) { const int g = 4 * (2 * ai + wr) + m; const int gp = (g > 0) ? g - 1 : 0;
                const PG8_LAS f32x4* xp = (const PG8_LAS f32x4*)(xch + (((gp * 4 + wc) * 2) * 4 + fq) * 8);
                const f32x4 xa0 = xp[0], xa1 = xp[1], xb0 = xp[8], xb1 = xp[9];
                const float X0[8] = {xa0[0], xa0[1], xa0[2], xa0[3], xa1[0], xa1[1], xa1[2], xa1[3]}, X1[8] = {xb0[0], xb0[1], xb0[2], xb0[3], xb1[0], xb1[1], xb1[2], xb1[3]};
                const f32x4 u0 = acc[ai][0][m][0], u1 = acc[ai][0][m][1], v0 = acc[ai][1][m][0], v1 = acc[ai][1][m][1];
                const float uu[8] = {u0[0], u0[1], u0[2], u0[3], u1[0], u1[1], u1[2], u1[3]}, vv[8] = {v0[0], v0[1], v0[2], v0[3], v1[0], v1[1], v1[2], v1[3]};
                float r[8];
#pragma unroll
                for (int e = 0; e < 8; e += 2) {
                    const float xs0 = (fr == 0) ? X0[e] : X1[e], xs1 = (fr == 0) ? X0[e + 1] : X1[e + 1];
                    const f32x2 P1 = {dpp_shr1_old(X1[e], uu[e]), dpp_shr1_old(X1[e + 1], uu[e + 1])}, P2 = {dpp_shr2_old(xs0, uu[e]), dpp_shr2_old(xs1, uu[e + 1])};
                    const f32x2 U = {uu[e], uu[e + 1]}, B = {bb[e], bb[e + 1]}, W0 = {w0[e], w0[e + 1]}, W1 = {w1[e], w1[e + 1]}, W2 = {w2[e], w2[e + 1]};
                    const f32x2 rr = B + W0 * P2 + W1 * P1 + W2 * U; r[e] = rr.x; r[e + 1] = rr.y; }
                u32x4 w;
#pragma unroll
                for (int i = 0; i < 4; ++i) { const f32x2 gl = gelu_pk((f32x2){r[2 * i], r[2 * i + 1]}); w[i] = cvt_pk_bf16(gl.x * vv[2 * i], gl.y * vv[2 * i + 1]); }
                *(u32x4*)(G + (size_t)(row0 + ai * HALF + m * 16) * 2816 + ch0) = w; }
    }
};

template <class Epi, class Sched, bool ALIGN_EPI = false, bool SP2 = false>
__device__ __forceinline__ void gemm_phase(PG8_LAS unsigned char* lds, const Gemm g, const Sched& S, const Epi& E) {
    int tid_l = threadIdx.x; asm volatile("" : "+v"(tid_l));
    const int tid = tid_l, wid = __builtin_amdgcn_readfirstlane(tid >> 6), lane = tid & 63, wr = wid >> 2, wc = wid & 3, fr = lane & 15, fq = lane >> 4;
    const int K = g.K, nt = K / BK;
    unsigned voffA[2], voffB[2];
#pragma unroll
    for (int i = 0; i < 2; ++i) { int R, C; stage_rc(tid * 16 + i * 8192, R, C); const int Rb = Epi::PERM ? ((R & ~31) + perm32(R & 31)) : R;
        voffA[i] = (unsigned)(R * K + C) * 2u; voffB[i] = (unsigned)(Rb * K + C) * 2u; }
    const size_t kstep = (size_t)(BK * 2);
    const size_t hstep = (size_t)HALF * K * 2;
    const size_t tstep = 2 * hstep;
    const unsigned ldsw = (unsigned)wid * 1024u;
    const int aoff = lds_byte(wr * 64 + fr, fq * 8), boff = lds_byte(wc * 32 + fr, fq * 8);
#define PG8_SA(b, h) (((b) * 2 + (h)) * HTB)
#define PG8_SB(b, h) ((4 + (b) * 2 + (h)) * HTB)
#define PG8_STAGE(bufoff, gbase, voff) do { _Pragma("unroll") for (int _i = 0; _i < 2; ++_i) \
        __builtin_amdgcn_global_load_lds((const unsigned*)((const char*)(gbase) + (voff)[_i]), (PG8_LAS unsigned*)(lds + (bufoff) + ldsw + _i * 8192), 16, 0, 0); } while (0)
#define PG8_LDA(dst, b, h) do { _Pragma("unroll") for (int m = 0; m < 4; ++m) _Pragma("unroll") for (int k = 0; k < 2; ++k) dst[m][k] = *(const PG8_LAS bf16x8*)(lds + PG8_SA(b, h) + aoff + m * 2048 + k * 1024); } while (0)
#define PG8_LDB(dst, b, h) do { _Pragma("unroll") for (int n = 0; n < 2; ++n) _Pragma("unroll") for (int k = 0; k < 2; ++k) dst[n][k] = *(const PG8_LAS bf16x8*)(lds + PG8_SB(b, h) + boff + n * 2048 + k * 1024); } while (0)
#define PG8_MMA(ai, bj, At, Bt) do { __builtin_amdgcn_s_setprio(1); _Pragma("unroll") for (int m = 0; m < 4; ++m) _Pragma("unroll") for (int n = 0; n < 2; ++n) _Pragma("unroll") for (int k = 0; k < 2; ++k) \
        acc[ai][bj][m][n] = __builtin_amdgcn_mfma_f32_16x16x32_bf16(Bt[n][k], At[m][k], acc[ai][bj][m][n], 0, 0, 0); __builtin_amdgcn_s_setprio(0); } while (0)
#define PG8_WAIT_V(n) asm volatile("s_waitcnt vmcnt(" #n ")" ::: "memory")
#define PG8_WAIT_L(n) asm volatile("s_waitcnt lgkmcnt(" #n ")" ::: "memory")
#define PG8_BAR __builtin_amdgcn_s_barrier()
#define PG8_SCHED __builtin_amdgcn_sched_barrier(0)
    Unit cur, nxt; int ui = 0;
    if (!S.next(0, cur)) return;
    f32x4 acc[2][2][4][2];
#pragma unroll
    for (int a = 0; a < 2; ++a)
#pragma unroll
        for (int b = 0; b < 2; ++b)
#pragma unroll
            for (int m = 0; m < 4; ++m)
#pragma unroll
                for (int n = 0; n < 2; ++n) acc[a][b][m][n] = (f32x4){0.f, 0.f, 0.f, 0.f};
    bf16x8 At[4][2], B0[2][2], B1[2][2];
    const char* cA = (const char*)g.A + (size_t)cur.pm * tstep; const char* cB = (const char*)g.Bt + (size_t)cur.pn * tstep;
    S.a_ready(cur);
    if constexpr (SP2) {
        PG8_STAGE(PG8_SB(0, 0), cB, voffB); PG8_STAGE(PG8_SB(0, 1), cB + hstep, voffB); PG8_STAGE(PG8_SA(0, 0), cA, voffA); PG8_STAGE(PG8_SA(0, 1), cA + hstep, voffA);
        if (wr == 1) PG8_BAR;
        PG8_WAIT_V(2); PG8_BAR;
        PG8_STAGE(PG8_SB(1, 0), cB + kstep, voffB); PG8_STAGE(PG8_SA(1, 0), cA + kstep, voffA); PG8_STAGE(PG8_SB(1, 1), cB + hstep + kstep, voffB);
        PG8_WAIT_V(6); PG8_BAR;
    } else {
        PG8_STAGE(PG8_SB(0, 0), cB, voffB); PG8_STAGE(PG8_SA(0, 0), cA, voffA); PG8_STAGE(PG8_SB(0, 1), cB + hstep, voffB); PG8_STAGE(PG8_SA(0, 1), cA + hstep, voffA);
        if (wr == 1) PG8_BAR;
        PG8_WAIT_V(4); PG8_BAR;
        PG8_STAGE(PG8_SB(1, 0), cB + kstep, voffB); PG8_STAGE(PG8_SA(1, 0), cA + kstep, voffA); PG8_STAGE(PG8_SB(1, 1), cB + hstep + kstep, voffB);
        PG8_WAIT_V(6); PG8_BAR;
    }
    for (;;) {
        const bool has_next = S.next(ui + 1, nxt);
        const char* nA = has_next ? (const char*)g.A + (size_t)nxt.pm * tstep : cA; const char* nB = has_next ? (const char*)g.Bt + (size_t)nxt.pn * tstep : cB;
        for (int t = 0; t < nt; t += 2) {
            const bool last = (t == nt - 2);
            const char* a1 = cA + (size_t)(t + 1) * kstep;
            const char* a2 = last ? nA : cA + (size_t)(t + 2) * kstep; const char* b2 = last ? nB : cB + (size_t)(t + 2) * kstep;
            const char* a3 = a2 + kstep; const char* b3 = b2 + kstep;
            if (last && has_next) S.a_ready(nxt);
            if constexpr (SP2) {
            PG8_LDB(B0, 0, 0); PG8_LDB(B1, 0, 1); PG8_SCHED; PG8_LDA(At, 0, 0); PG8_STAGE(PG8_SA(1, 1), a1 + hstep, voffA);
            PG8_WAIT_V(8); PG8_WAIT_L(0); PG8_BAR; PG8_MMA(0, 0, At, B0); PG8_MMA(0, 1, At, B1); PG8_BAR; PG8_SCHED;
            PG8_LDA(At, 0, 1); PG8_STAGE(PG8_SB(0, 0), b2, voffB); PG8_STAGE(PG8_SB(0, 1), b2 + hstep, voffB); PG8_STAGE(PG8_SA(0, 0), a2, voffA);
            PG8_WAIT_V(8); PG8_WAIT_L(0); PG8_BAR; PG8_MMA(1, 0, At, B0); PG8_MMA(1, 1, At, B1); PG8_BAR; PG8_SCHED;
            PG8_LDB(B0, 1, 0); PG8_LDB(B1, 1, 1); PG8_SCHED; PG8_LDA(At, 1, 0); PG8_STAGE(PG8_SA(0, 1), a2 + hstep, voffA);
            PG8_WAIT_V(8); PG8_WAIT_L(0); PG8_BAR; PG8_MMA(0, 0, At, B0); PG8_MMA(0, 1, At, B1); PG8_BAR; PG8_SCHED;
            PG8_LDA(At, 1, 1); PG8_STAGE(PG8_SB(1, 0), b3, voffB); PG8_STAGE(PG8_SB(1, 1), b3 + hstep, voffB); PG8_STAGE(PG8_SA(1, 0), a3, voffA);
            PG8_WAIT_V(8); PG8_WAIT_L(0); PG8_BAR; PG8_MMA(1, 0, At, B0); PG8_MMA(1, 1, At, B1); PG8_BAR; PG8_SCHED;
            } else {
            PG8_LDB(B0, 0, 0); PG8_SCHED; PG8_LDA(At, 0, 0); PG8_STAGE(PG8_SA(1, 1), a1 + hstep, voffA);
            PG8_WAIT_L(8); PG8_BAR; PG8_WAIT_L(0); PG8_MMA(0, 0, At, B0); PG8_BAR; PG8_SCHED;
            PG8_LDB(B1, 0, 1); PG8_STAGE(PG8_SB(0, 0), b2, voffB);
            PG8_BAR; PG8_WAIT_L(0); PG8_MMA(0, 1, At, B1); PG8_BAR;
            PG8_LDA(At, 0, 1); PG8_STAGE(PG8_SA(0, 0), a2, voffA);
            PG8_BAR; PG8_WAIT_L(0); PG8_MMA(1, 0, At, B0); PG8_BAR; PG8_SCHED;
            PG8_STAGE(PG8_SB(0, 1), b2 + hstep, voffB);
            PG8_WAIT_V(6); PG8_BAR; PG8_MMA(1, 1, At, B1); PG8_BAR;
            PG8_LDB(B0, 1, 0); PG8_SCHED; PG8_LDA(At, 1, 0); PG8_STAGE(PG8_SA(0, 1), a2 + hstep, voffA);
            PG8_WAIT_L(8); PG8_BAR; PG8_WAIT_L(0); PG8_MMA(0, 0, At, B0); PG8_BAR; PG8_SCHED;
            PG8_LDB(B1, 1, 1); PG8_STAGE(PG8_SB(1, 0), b3, voffB);
            PG8_BAR; PG8_WAIT_L(0); PG8_MMA(0, 1, At, B1); PG8_BAR;
            PG8_LDA(At, 1, 1); PG8_STAGE(PG8_SA(1, 0), a3, voffA);
            PG8_BAR; PG8_WAIT_L(0); PG8_MMA(1, 0, At, B0); PG8_BAR; PG8_SCHED;
            PG8_STAGE(PG8_SB(1, 1), b3 + hstep, voffB);
            PG8_WAIT_V(6); PG8_BAR; PG8_MMA(1, 1, At, B1); PG8_BAR;
            }
        }
        if constexpr (ALIGN_EPI) { if (wr == 0) PG8_BAR; }
        if constexpr (!Epi::AFTER_DRAIN) { E(acc, cur, wr, wc, fr, fq); S.done(cur); }
        if (!has_next) break;
#pragma unroll
        for (int a = 0; a < 2; ++a)
#pragma unroll
            for (int b = 0; b < 2; ++b)
#pragma unroll
                for (int m = 0; m < 4; ++m)
#pragma unroll
                    for (int n = 0; n < 2; ++n) acc[a][b][m][n] = (f32x4){0.f, 0.f, 0.f, 0.f};
        cur = nxt; cA = nA; cB = nB; ++ui;
        if constexpr (ALIGN_EPI) { if (wr == 1) PG8_BAR; }
    }
    PG8_WAIT_V(0);
    if constexpr (!ALIGN_EPI) { if (wr == 0) PG8_BAR; }
    PG8_BAR;
    if constexpr (Epi::AFTER_DRAIN) { E.fused(acc, cur, wr, wc, fr, fq, lds, wid, lane); S.done(cur); }
#undef PG8_SA
#undef PG8_SB
#undef PG8_STAGE
#undef PG8_LDA
#undef PG8_LDB
#undef PG8_MMA
#undef PG8_WAIT_V
#undef PG8_WAIT_L
#undef PG8_BAR
#undef PG8_SCHED
}
}

#ifndef PG8_SP2
#define PG8_SP2 true
#endif
#ifndef PG8_ALIGN
#define PG8_ALIGN true
#endif
#include <hip/hip_bf16.h>
#include <cmath>
namespace attn_body {
using bf16=__hip_bfloat16;
using bf16x8=__attribute__((ext_vector_type(8)))short;
using s16x4=__attribute__((ext_vector_type(4)))short;
using f32x16=__attribute__((ext_vector_type(16)))float;
using u32x4=__attribute__((ext_vector_type(4)))unsigned;
constexpr int BATCH=32,NHEAD=8,SEQ=2048,D=64,DM=1536,OPITCH=512;
constexpr int NW=8,QBLK=32,QB=QBLK*NW,KVBLK=64,NQB=SEQ/QB;
constexpr int ATTN_PITCH=DM, ATTN_UNIT_ROWS=QB;
__device__ __forceinline__ int crow(int r,int hi){return (r&3)+8*(r>>2)+4*hi;}
#define SBAR() __builtin_amdgcn_sched_barrier(0)
__device__ __forceinline__ void cmask(f32x16&p0,f32x16&p1,int jb,int qrel,int hi){
  const float NEG=-INFINITY; int kb=64*jb+4*hi;
  #pragma unroll
  for(int r=0;r<16;++r){int kv=kb+(r&3)+8*(r>>2); if(kv>qrel)p0[r]=NEG; if(kv+32>qrel)p1[r]=NEG;}
}

constexpr int NSLOT=3, SLOTB=8192;
constexpr int LDS_K=0, LDS_V=NSLOT*SLOTB, LDS_WS=2*NSLOT*SLOTB, LDS_OST=LDS_WS+NW*64*4, LDS_BYTES=LDS_OST+NW*4096;
constexpr float C2=0.125f*1.4426950408889634f;
__device__ __forceinline__ void glds16(const void*gsrc,unsigned lds_dst){unsigned keep;
  asm volatile("s_mov_b32 %0, m0\n\ts_mov_b32 m0, %2\n\ts_nop 0\n\tglobal_load_lds_dwordx4 %1, off\n\ts_mov_b32 m0, %0":"=&s"(keep):"v"(gsrc),"s"(lds_dst):"memory");}
__device__ __forceinline__ float max3f(float a,float b,float c){float r;asm("v_max3_f32 %0, %1, %2, %3":"=v"(r):"v"(a),"v"(b),"v"(c));return r;}
__device__ __forceinline__ float max2f(float a,float b){float r;asm("v_max_f32_e32 %0, %1, %2":"=v"(r):"v"(a),"v"(b));return r;}
__device__ __forceinline__ float fadd_s(float a,float b){float r;asm("v_add_f32_e32 %0, %1, %2":"=v"(r):"v"(a),"v"(b));return r;}
__device__ __forceinline__ float fsub_s(float a,float b){float r;asm("v_sub_f32_e32 %0, %1, %2":"=v"(r):"v"(a),"v"(b));return r;}
typedef float f32x2_t __attribute__((ext_vector_type(2))); typedef __bf16 bf16x2_t __attribute__((ext_vector_type(2)));
__device__ __forceinline__ unsigned cvtpk_s(float lo,float hi){f32x2_t v={lo,hi};bf16x2_t b=__builtin_convertvector(v,bf16x2_t);return __builtin_bit_cast(unsigned,b);}
#define WAIT_BAR(N) asm volatile("s_waitcnt vmcnt(" #N ") lgkmcnt(0)\n\ts_barrier":::"memory")

__device__ __forceinline__ void qkt(f32x16&p0,f32x16&p1,const char*Kslot,const bf16x8*qr,const f32x16&negm,int r32,int hi){
  const char*kb=Kslot+hi*1024+r32*16;
  #pragma unroll
  for(int d0=0;d0<4;++d0){
    const bf16x8 b0=*reinterpret_cast<const bf16x8*>(kb+d0*2048);
    const bf16x8 b1=*reinterpret_cast<const bf16x8*>(kb+d0*2048+512);
    if(d0==0){p0=__builtin_amdgcn_mfma_f32_32x32x16_bf16(b0,qr[0],negm,0,0,0);p1=__builtin_amdgcn_mfma_f32_32x32x16_bf16(b1,qr[0],negm,0,0,0);}
    else{p0=__builtin_amdgcn_mfma_f32_32x32x16_bf16(b0,qr[d0],p0,0,0,0);p1=__builtin_amdgcn_mfma_f32_32x32x16_bf16(b1,qr[d0],p1,0,0,0);}}
}
typedef __attribute__((address_space(3))) const char* lds_cptr;
typedef short v4i16_t __attribute__((ext_vector_type(4)));
__device__ __forceinline__ void kload8(bf16x8*kf,lds_cptr kp){
  kf[0]=*(const __attribute__((address_space(3))) bf16x8*)(kp);      kf[1]=*(const __attribute__((address_space(3))) bf16x8*)(kp+512);
  kf[2]=*(const __attribute__((address_space(3))) bf16x8*)(kp+2048); kf[3]=*(const __attribute__((address_space(3))) bf16x8*)(kp+2560);
  kf[4]=*(const __attribute__((address_space(3))) bf16x8*)(kp+4096); kf[5]=*(const __attribute__((address_space(3))) bf16x8*)(kp+4608);
  kf[6]=*(const __attribute__((address_space(3))) bf16x8*)(kp+6144); kf[7]=*(const __attribute__((address_space(3))) bf16x8*)(kp+6656);
}
__device__ __forceinline__ void kload2(bf16x8*kf,lds_cptr kp,int j){ kf[2*j]=*(const __attribute__((address_space(3))) bf16x8*)(kp+j*2048); kf[2*j+1]=*(const __attribute__((address_space(3))) bf16x8*)(kp+j*2048+512); }
__device__ __forceinline__ s16x4 vtr(lds_cptr p){ return __builtin_bit_cast(s16x4,__builtin_amdgcn_ds_read_tr16_b64_v4i16((__attribute__((address_space(3))) v4i16_t*)p)); }
__device__ __forceinline__ float rowmax(const f32x16&p0,const f32x16&p1){
  float a=max3f(p0[0],p0[1],p1[0]),b=max3f(p0[2],p0[3],p1[1]);a=max3f(a,p1[2],p1[3]);
  #pragma unroll
  for(int r=4;r<16;r+=4){a=max3f(a,p0[r],p0[r+1]);b=max3f(b,p0[r+2],p0[r+3]);a=max3f(a,p1[r],p1[r+1]);b=max3f(b,p1[r+2],p1[r+3]);}
  const float m=max2f(a,b);
  auto rr=__builtin_amdgcn_permlane32_swap(__float_as_uint(m),__float_as_uint(m),false,false);
  return max2f(__uint_as_float(rr[0]),__uint_as_float(rr[1]));
}
__device__ __forceinline__ void pv(f32x16*o,int vb,bf16x8 pa0,bf16x8 pa1,bf16x8 pa2,bf16x8 pa3){
  #pragma unroll
  for(int d0=0;d0<2;++d0){s16x4 lo[4],hi[4];
    #pragma unroll
    for(int ks=0;ks<4;++ks){
      asm volatile("ds_read_b64_tr_b16 %0,%1 offset:%c2":"=&v"(lo[ks]):"v"(vb),"i"(d0*4096+ks*1024):"memory");
      asm volatile("ds_read_b64_tr_b16 %0,%1 offset:%c2":"=&v"(hi[ks]):"v"(vb),"i"(d0*4096+ks*1024+512):"memory");}
    asm volatile("s_waitcnt lgkmcnt(0)":::"memory");SBAR();
    #define PK(k) (bf16x8){lo[k][0],lo[k][1],lo[k][2],lo[k][3],hi[k][0],hi[k][1],hi[k][2],hi[k][3]}
    o[d0]=__builtin_amdgcn_mfma_f32_32x32x16_bf16(pa0,PK(0),o[d0],0,0,0);
    o[d0]=__builtin_amdgcn_mfma_f32_32x32x16_bf16(pa1,PK(1),o[d0],0,0,0);
    o[d0]=__builtin_amdgcn_mfma_f32_32x32x16_bf16(pa2,PK(2),o[d0],0,0,0);
    o[d0]=__builtin_amdgcn_mfma_f32_32x32x16_bf16(pa3,PK(3),o[d0],0,0,0);
    #undef PK
  }
}

#ifndef ATTN_STORE16
#define ATTN_STORE16(p,v) (*(u32x4*)(p)=(v))
#endif
template<int THRL> __device__ __forceinline__ void attn_unit(int b,int h,int qb,const bf16*Q,const bf16*__restrict__ K,const bf16*__restrict__ V,bf16*O,const float*kmean,char*shm){
  int tid_l=threadIdx.x; asm volatile("":"+v"(tid_l)); const int tid=tid_l,lane=tid&63,r32=lane&31,hi=lane>>5; const int wid=__builtin_amdgcn_readfirstlane(tid>>6);
  const long rowbase=(long)b*SEQ; const int q0=qb*QB;
  const bf16*Qw=Q+(rowbase+q0+wid*QBLK)*DM+h*D;
  const bf16*Kh=K+rowbase*DM+h*D,*Vh=V+rowbase*DM+h*D;
  const unsigned lds0=(unsigned)(uintptr_t)shm;
  float*wsf=(float*)(shm+LDS_WS)+wid*64;
  const bf16*ksrc=Kh+(long)lane*DM+wid*8;
  const bf16*vsrc=Vh+(long)(16*(wid&3)+(lane>>2))*DM+(wid>>2)*32+(lane&3)*8;
  const unsigned kdst=lds0+LDS_K+wid*1024, vdst=lds0+LDS_V+wid*1024;
  #define DMA_K(t,slot) glds16(ksrc+(long)(t)*KVBLK*DM,(unsigned)__builtin_amdgcn_readfirstlane(kdst+(slot)))
  #define DMA_V(t,slot) glds16(vsrc+(long)(t)*KVBLK*DM,(unsigned)__builtin_amdgcn_readfirstlane(vdst+(slot)))
  const int vb0=(int)(lds0+LDS_V)+((lane>>4)&1)*32+(lane&3)*8+(4*hi+((lane&15)>>2))*64;
  const char*Kbase=shm+LDS_K; bf16x8 kf[8];
  const lds_cptr shm3=(lds_cptr)shm; const lds_cptr kp0=shm3+LDS_K+hi*1024+r32*16; const lds_cptr vp0=shm3+LDS_V+((lane>>4)&1)*32+(lane&3)*8+(4*hi+((lane&15)>>2))*64;
  const int NT=(q0+QB)/KVBLK;
  DMA_K(0,0);DMA_V(0,0);DMA_K(1,SLOTB);
  bf16x8 qr[4];
  #pragma unroll
  for(int d0=0;d0<4;++d0)qr[d0]=*reinterpret_cast<const bf16x8*>(&Qw[(long)r32*DM+d0*16+hi*8]);
  unsigned selm=0xffu;
  if(qb>=4){ float gsc[7]; const float*km=kmean+((long)(b*NHEAD+h)*8)*64;
    #pragma unroll
    for(int n=0;n<7;++n){ float s=-INFINITY;
      if(n<qb){ s=0.f;
        #pragma unroll
        for(int d0=0;d0<4;++d0){ const float4 k0=*reinterpret_cast<const float4*>(km+n*64+d0*16+hi*8),k1=*reinterpret_cast<const float4*>(km+n*64+d0*16+hi*8+4);
          const bf16x8 qq=qr[d0];
          s+=__uint_as_float((unsigned)(unsigned short)qq[0]<<16)*k0.x+__uint_as_float((unsigned)(unsigned short)qq[1]<<16)*k0.y+__uint_as_float((unsigned)(unsigned short)qq[2]<<16)*k0.z+__uint_as_float((unsigned)(unsigned short)qq[3]<<16)*k0.w
            +__uint_as_float((unsigned)(unsigned short)qq[4]<<16)*k1.x+__uint_as_float((unsigned)(unsigned short)qq[5]<<16)*k1.y+__uint_as_float((unsigned)(unsigned short)qq[6]<<16)*k1.z+__uint_as_float((unsigned)(unsigned short)qq[7]<<16)*k1.w; }
        s+=__shfl_xor(s,32); }
      gsc[n]=s; }
    selm=1u<<qb;
    #pragma unroll
    for(int n=0;n<7;++n){ int rank=0;
      #pragma unroll
      for(int m2=0;m2<7;++m2){ if(m2!=n){ if(gsc[m2]>gsc[n]||(gsc[m2]==gsc[n]&&m2<n))++rank; } }
      if(n<qb&&rank<3)selm|=1u<<n; } }
  float mhat=0.f,l_reg=0.f;f32x16 o[2];o[0]=f32x16{};o[1]=f32x16{};const f32x16 zero16=f32x16{};
  const bf16x8 kones=__builtin_bit_cast(bf16x8,(u32x4){hi==0?0x3F803F80u:0u,0u,0u,0u});
  const int qrel=wid*QBLK+r32;
  #define CMASK0(P0,P1,t) do{int jb_=(t)-(NT-4); if(jb_>=0)cmask(P0,P1,jb_,qrel,hi); else if(!((selm>>((t)>>2))&1u)){ _Pragma("unroll") for(int r_=0;r_<16;++r_){P0[r_]=-INFINITY;P1[r_]=-INFINITY;} } }while(0)
  #define CMASK(P0,P1,t) do{int jb_=(t)-(NT-4); if(jb_>=0)cmask(P0,P1,jb_,qrel,hi);}while(0)
  bool resc=false;
  #define START(P0,P1) do{ const float rm=rowmax(P0,P1); resc=false; \
    { const float dl=__builtin_ceilf(__builtin_fmaxf(rm,-30.f)); mhat=fadd_s(mhat,dl); \
      _Pragma("unroll") for(int r=0;r<16;++r){P0[r]=fsub_s(P0[r],dl);P1[r]=fsub_s(P1[r],dl);} \
      } \
    _Pragma("unroll") for(int r=0;r<16;++r)P0[r]=__builtin_amdgcn_exp2f(P0[r]); }while(0)
  #define RESC() do{ if(resc){ asm volatile("s_waitcnt lgkmcnt(0)":::"memory"); \
      _Pragma("unroll") for(int d_=0;d_<2;++d_) _Pragma("unroll") for(int r=0;r<16;++r)o[d_][r]*=wsf[crow(r,hi)]; } }while(0)
  f32x16 pA0,pA1,pB0,pB1;
  int sl_prev=0,sl_cur=0,sl_next=SLOTB;
  #define ROT() do{sl_prev=sl_cur;sl_cur=sl_next;sl_next=(sl_next==(NSLOT-1)*SLOTB)?0:sl_next+SLOTB;}while(0)
  DMA_K(2,2*SLOTB);
  WAIT_BAR(3);
  qkt(pA0,pA1,Kbase,qr,zero16,r32,hi);asm volatile("s_nop 15\n\ts_nop 7":"+v"(pA0),"+v"(pA1));CMASK0(pA0,pA1,0);
  START(pA0,pA1);
  _Pragma("unroll") for(int r=0;r<16;++r)pA1[r]=__builtin_amdgcn_exp2f(pA1[r]);
  WAIT_BAR(0);
  DMA_K(3,0);DMA_V(1,SLOTB);
  ROT();
  kload8(kf,kp0+sl_cur);
  WAIT_BAR(2);
  s16x4 vlo[8],vhi[8]; u32x4 pw0,pw1,pw2,pw3;
  #define PKW(P,B) cvtpk_s(P[B],P[B+1])
  #define PAF(k) __builtin_bit_cast(bf16x8,pw##k)
  #define VFR(i) (bf16x8){vlo[i][0],vlo[i][1],vlo[i][2],vlo[i][3],vhi[i][0],vhi[i][1],vhi[i][2],vhi[i][3]}
  #define PIN(x) asm volatile("":"+v"(x))
  #define MX3(a,b,c) __builtin_fmaxf(__builtin_fmaxf((a),(b)),(c))
  #define GAPA(MF,A0,A1,A2,A3,W0,W1,PW) do{ MF; sacc+=A0; sacc+=A1; sacc+=A2; sacc+=A3; PIN(sacc); W0; W1; PIN(PW); SBAR(); }while(0)
  #define EX(v) __builtin_amdgcn_exp2f(v)
  #define GAPB(MF,X,B) do{ MF; X[B]=EX(X[B]); X[B+1]=EX(X[B+1]); X[B+2]=EX(X[B+2]); X[B+3]=EX(X[B+3]); PIN(X); SBAR(); }while(0)
  #define VRD(i) do{ vlo[i]=vtr(vp_+(((i)>>2)*4096+((i)&3)*1024)); vhi[i]=vtr(vp_+(((i)>>2)*4096+((i)&3)*1024+512)); }while(0)
  #define KRD(G,j) do{ if(G){ kload2(kf,kp0+sl_next,j); SBAR(); } }while(0)
  #define STEP(C0,C1,P0,P1,t,GK,GV,GL) do{ SBAR(); \
    const lds_cptr vp_=vp0+sl_prev; \
    { const unsigned w_=(hi==0)?((__float_as_uint(-mhat)>>16)|(((selm>>((t)>>2))&1u)?0u:0xC6000000u)):0u; const bf16x8 qaug=__builtin_bit_cast(bf16x8,(u32x4){w_,0u,0u,0u}); \
      C0=__builtin_amdgcn_mfma_f32_32x32x16_bf16(kones,qaug,zero16,0,0,0); C1=__builtin_amdgcn_mfma_f32_32x32x16_bf16(kones,qaug,zero16,0,0,0); } \
    VRD(0); SBAR(); float sacc=(P0[0]+P0[1]); \
    GAPA(C0=__builtin_amdgcn_mfma_f32_32x32x16_bf16(kf[0],qr[0],C0,0,0,0), P0[2],P0[3],P0[4],P0[5],     pw0[0]=PKW(P0,0), pw0[1]=PKW(P0,2), pw0); \
    VRD(4); SBAR(); GAPA(C1=__builtin_amdgcn_mfma_f32_32x32x16_bf16(kf[1],qr[0],C1,0,0,0), P0[6],P0[7],P0[8],P0[9],     pw0[2]=PKW(P0,4), pw0[3]=PKW(P0,6), pw0); \
    VRD(1); SBAR(); GAPA(C0=__builtin_amdgcn_mfma_f32_32x32x16_bf16(kf[2],qr[1],C0,0,0,0),   P0[10],P0[11],P0[12],P0[13], pw1[0]=PKW(P0,8), pw1[1]=PKW(P0,10), pw1); \
    VRD(5); SBAR(); GAPA(C1=__builtin_amdgcn_mfma_f32_32x32x16_bf16(kf[3],qr[1],C1,0,0,0),   P0[14],P0[15],P1[0],P1[1],   pw1[2]=PKW(P0,12),pw1[3]=PKW(P0,14), pw1); \
    VRD(2); SBAR(); GAPA(C0=__builtin_amdgcn_mfma_f32_32x32x16_bf16(kf[4],qr[2],C0,0,0,0),   P1[2],P1[3],P1[4],P1[5],     pw2[0]=PKW(P1,0), pw2[1]=PKW(P1,2), pw2); \
    VRD(6); SBAR(); GAPA(C1=__builtin_amdgcn_mfma_f32_32x32x16_bf16(kf[5],qr[2],C1,0,0,0),   P1[6],P1[7],P1[8],P1[9],     pw2[2]=PKW(P1,4), pw2[3]=PKW(P1,6), pw2); \
    VRD(3); SBAR(); GAPA(C0=__builtin_amdgcn_mfma_f32_32x32x16_bf16(kf[6],qr[3],C0,0,0,0),   P1[10],P1[11],P1[12],P1[13], pw3[0]=PKW(P1,8), pw3[1]=PKW(P1,10), pw3); \
    VRD(7); SBAR(); GAPA(C1=__builtin_amdgcn_mfma_f32_32x32x16_bf16(kf[7],qr[3],C1,0,0,0),   P1[14],P1[15],0.f,0.f,       pw3[2]=PKW(P1,12),pw3[3]=PKW(P1,14), pw3); \
    l_reg+=sacc; \
    if(GK){DMA_K((t)+3,sl_cur);} if(GV){DMA_V((t)+1,sl_next);} \
    CMASK(C0,C1,t); \
    { float a=MX3(C0[0],C0[1],C1[0]),b=MX3(C0[2],C0[3],C1[1]); a=MX3(a,C1[2],C1[3]); \
      _Pragma("unroll") for(int r=4;r<16;r+=4){a=MX3(a,C0[r],C0[r+1]);b=MX3(b,C0[r+2],C0[r+3]);a=MX3(a,C1[r],C1[r+1]);b=MX3(b,C1[r+2],C1[r+3]);} \
      float rm=__builtin_fmaxf(a,b); { auto rr=__builtin_amdgcn_permlane32_swap(__float_as_uint(rm),__float_as_uint(rm),false,false); rm=__builtin_fmaxf(__uint_as_float(rr[0]),__uint_as_float(rr[1])); } \
      resc=false; \
      if(__builtin_expect(__any(rm>(float)THRL),0)){ const float dl=__builtin_ceilf(__builtin_fmaxf(rm,0.f)); mhat+=dl; \
        _Pragma("unroll") for(int r=0;r<16;++r){C0[r]-=dl;C1[r]-=dl;} \
        const float f=__builtin_amdgcn_exp2f(-dl); l_reg*=f; if(hi==0)wsf[r32]=f; resc=true; } } \
    SBAR(); \
    GAPB(o[0]=__builtin_amdgcn_mfma_f32_32x32x16_bf16(PAF(0),VFR(0),o[0],0,0,0), C0,0); \
    GAPB(o[1]=__builtin_amdgcn_mfma_f32_32x32x16_bf16(PAF(0),VFR(4),o[1],0,0,0), C0,4); \
    KRD(GL,0); GAPB(o[0]=__builtin_amdgcn_mfma_f32_32x32x16_bf16(PAF(1),VFR(1),o[0],0,0,0), C0,8); \
    KRD(GL,1); GAPB(o[1]=__builtin_amdgcn_mfma_f32_32x32x16_bf16(PAF(1),VFR(5),o[1],0,0,0), C0,12); \
    KRD(GL,2); GAPB(o[0]=__builtin_amdgcn_mfma_f32_32x32x16_bf16(PAF(2),VFR(2),o[0],0,0,0), C1,0); \
    KRD(GL,3); GAPB(o[1]=__builtin_amdgcn_mfma_f32_32x32x16_bf16(PAF(2),VFR(6),o[1],0,0,0), C1,4); \
    GAPB(o[0]=__builtin_amdgcn_mfma_f32_32x32x16_bf16(PAF(3),VFR(3),o[0],0,0,0), C1,8); \
    GAPB(o[1]=__builtin_amdgcn_mfma_f32_32x32x16_bf16(PAF(3),VFR(7),o[1],0,0,0), C1,12); \
    }while(0)
  int t=1;
  #undef CMASK
  #define CMASK(P0,P1,t) do{}while(0)
  for(;t+5<NT;t+=2){
    STEP(pB0,pB1,pA0,pA1,t,true,true,true);     WAIT_BAR(2); RESC(); ROT();
    STEP(pA0,pA1,pB0,pB1,t+1,true,true,true);   WAIT_BAR(2); RESC(); ROT();
  }
  #undef CMASK
  #define CMASK(P0,P1,t) do{int jb_=(t)-(NT-4); if(jb_>=0)cmask(P0,P1,jb_,qrel,hi);}while(0)
  #define ENDW(tt) do{ if((tt)+3<NT){WAIT_BAR(2);} else if((tt)+2<NT){WAIT_BAR(1);} else {WAIT_BAR(0);} }while(0)
  for(;t+1<NT;t+=2){
    STEP(pB0,pB1,pA0,pA1,t,(t+3<NT),(t+1<NT),(t+1<NT));       ENDW(t);   RESC(); ROT();
    STEP(pA0,pA1,pB0,pB1,t+1,(t+4<NT),(t+2<NT),(t+2<NT));     ENDW(t+1); RESC(); ROT();
  }
  STEP(pB0,pB1,pA0,pA1,NT-1,false,false,false); RESC();
  { float sacc=pB0[0]+pB0[1]; _Pragma("unroll") for(int r=2;r<16;++r)sacc+=pB0[r]; _Pragma("unroll") for(int r=0;r<16;++r)sacc+=pB1[r]; l_reg+=sacc;
    pw0=(u32x4){PKW(pB0,0),PKW(pB0,2),PKW(pB0,4),PKW(pB0,6)};pw1=(u32x4){PKW(pB0,8),PKW(pB0,10),PKW(pB0,12),PKW(pB0,14)};pw2=(u32x4){PKW(pB1,0),PKW(pB1,2),PKW(pB1,4),PKW(pB1,6)};pw3=(u32x4){PKW(pB1,8),PKW(pB1,10),PKW(pB1,12),PKW(pB1,14)};
    SBAR(); pv(o,vb0+sl_cur,PAF(0),PAF(1),PAF(2),PAF(3)); }
  #undef PKW
  #undef PAF
  #undef VFR
  #undef PIN
  #undef MX3
  #undef GAPA
  #undef GAPB
  #undef EX
  #undef VRD
  #undef KRD
  #undef STEP
  #undef ENDW
  {auto rr=__builtin_amdgcn_permlane32_swap(__float_as_uint(l_reg),__float_as_uint(l_reg),false,false);l_reg=__uint_as_float(rr[0])+__uint_as_float(rr[1]);}
  if(hi==0)wsf[32+r32]=l_reg;asm volatile("s_waitcnt lgkmcnt(0)":::"memory");
  float rli[16];
  #pragma unroll
  for(int r=0;r<16;++r)rli[r]=__builtin_amdgcn_rcpf(wsf[32+crow(r,hi)]);
  bf16*Ow=O+(rowbase+q0+wid*QBLK)*OPITCH+h*D;
  { bf16*stg=(bf16*)(shm+LDS_OST)+wid*2048;
    #pragma unroll
    for(int r=0;r<16;++r){const int orow=crow(r,hi);
      #pragma unroll
      for(int d0=0;d0<2;++d0)stg[orow*64+d0*32+r32]=__float2bfloat16(o[d0][r]*rli[r]);}
    asm volatile("s_waitcnt lgkmcnt(0)":::"memory");
    #pragma unroll
    for(int i=0;i<4;++i){const int row=i*8+(lane>>3),ch=lane&7; const u32x4 v=*(const u32x4*)(stg+row*64+ch*8); ATTN_STORE16(Ow+(long)row*OPITCH+ch*8,v);} }
  asm volatile("s_waitcnt lgkmcnt(0)\n\ts_barrier":::"memory");
  #undef DMA_K
  #undef DMA_V
  #undef CMASK
  #undef START
  #undef RESC
  #undef ROT
}
#undef SBAR
#undef WAIT_BAR
}
#define LAS __attribute__((address_space(3)))
typedef unsigned short bf16u;
typedef unsigned v4u __attribute__((ext_vector_type(4)));
typedef float f32x4g __attribute__((ext_vector_type(4)));
typedef short bf16x8g __attribute__((ext_vector_type(8)));
typedef float f32x16g __attribute__((ext_vector_type(16)));

constexpr int MTOK = 65536, SEQL = 2048, DMODEL = 1024, DIN = 5632, DFF = 2816;
constexpr float NEPS = 1e-6f;
constexpr size_t MiB = 1u << 20;
constexpr size_t WS_CTL = 0, WS_ROPE = 1 * MiB, WS_KMEAN = 1 * MiB + 512 * 1024, WS_WIN = 2 * MiB, WS_WA = 13 * MiB, WS_WB = 14 * MiB, WS_WOUT = 15 * MiB, WS_WUP = 17 * MiB, WS_WDN = 28 * MiB;
constexpr size_t WS_XN = 34 * MiB, WS_OA = 34 * MiB, WS_OB = 98 * MiB, WS_BIG = 162 * MiB;
constexpr size_t WS_HG = WS_BIG, WS_QKV = WS_BIG + 256 * MiB, WS_GT = WS_BIG + 448 * MiB, WS_MIX = WS_BIG, WS_UV = WS_BIG, WS_G = WS_BIG + 352 * MiB, WS_END = WS_BIG + 704 * MiB + 24 * MiB;
constexpr size_t WS_UFIRST = WS_BIG + 704 * MiB, WS_VFIRST = WS_UFIRST + 8 * MiB, WS_ULAST = WS_UFIRST + 16 * MiB;
constexpr int RING_BYTES = 131072, MISC_OFF = RING_BYTES + 320, LDS_BYTES = 149504, XCH_OFF = RING_BYTES + 512;
constexpr int NWAVES = 8;
constexpr int CW_BAR = 4096;
constexpr size_t WS_ROWSS = 512 * 1024;

__device__ __forceinline__ unsigned f2bf(float f) { unsigned u = __builtin_bit_cast(unsigned, f); return (u + 0x7fffu + ((u >> 16) & 1u)) >> 16; }
__device__ __forceinline__ unsigned pk2(float lo, float hi) { return pg8::cvt_pk_bf16(lo, hi); }
__device__ __forceinline__ float b2f(unsigned h) { return __uint_as_float(h << 16); }
__device__ __forceinline__ float wave_sum(float v) {
#pragma unroll
    for (int o = 1; o < 64; o <<= 1) v += __shfl_xor(v, o);
    return v;
}
#define LDS_WAIT() asm volatile("s_waitcnt lgkmcnt(0)" ::: "memory")

template <int REMAP> __device__ __forceinline__ void p0_transpose_item(const float* W, int K, int N, bf16u* WT, LAS float* scr, int item, int lane, const float* kscale = nullptr) {
    const int nblk = N / 32, kb = item / nblk, nb = item % nblk, k0 = 64 * kb, n0 = 32 * nb;
    int nr = n0;
    if (REMAP == 2) { if (n0 >= 2048 && n0 < 3072) { const int o = n0 - 2048; nr = 2048 + (o & ~255) + 128 * ((o >> 5) & 1) + 32 * ((o >> 6) & 3); } }
    else if (REMAP) { nr = (n0 < DFF) ? ((n0 >> 7) * 256 + (n0 & 127)) : (((n0 - DFF) >> 7) * 256 + 128 + ((n0 - DFF) & 127)); }
    float wv_[32];
#pragma unroll
    for (int i = 0; i < 32; ++i) { const int kk = 2 * i + (lane >> 5); wv_[i] = W[(size_t)(k0 + kk) * N + n0 + (lane & 31)] * (kscale ? kscale[k0 + kk] : 1.0f); }
#pragma unroll
    for (int i = 0; i < 32; ++i) { const int kk = 2 * i + (lane >> 5); scr[kk * 33 + (lane & 31)] = wv_[i]; }
    LDS_WAIT(); asm volatile("" ::: "memory");
    const int c = lane & 7;
#pragma unroll
    for (int j = 0; j < 4; ++j) { const int n = (lane >> 3) + 8 * j; const LAS float* s = scr + (8 * c) * 33 + n;
        v4u o; o.x = pk2(s[0 * 33], s[1 * 33]); o.y = pk2(s[2 * 33], s[3 * 33]); o.z = pk2(s[4 * 33], s[5 * 33]); o.w = pk2(s[6 * 33], s[7 * 33]);
        *(v4u*)(WT + (size_t)(nr + n) * K + k0 + 8 * c) = o; }
    LDS_WAIT(); asm volatile("" ::: "memory");
}
template <int R> __device__ __forceinline__ void rms_rows_to_bf16(const float* xrow, const float* g, bf16u* orow, int lane) {
    const f32x4g* gr = (const f32x4g*)g + lane;
    f32x4g v[R][4]; float s[R];
#pragma unroll
    for (int r = 0; r < R; ++r) { const f32x4g* xr = (const f32x4g*)(xrow + (size_t)r * DMODEL) + lane;
#pragma unroll
        for (int j = 0; j < 4; ++j) v[r][j] = xr[64 * j]; }
#pragma unroll
    for (int r = 0; r < R; ++r) { float a = 0.f;
#pragma unroll
        for (int j = 0; j < 4; ++j) a += (v[r][j].x * v[r][j].x + v[r][j].y * v[r][j].y) + (v[r][j].z * v[r][j].z + v[r][j].w * v[r][j].w);
        s[r] = 1.0f / sqrtf(wave_sum(a) * (1.f / DMODEL) + NEPS); }
#pragma unroll
    for (int j = 0; j < 4; ++j) { const f32x4g gg = gr[64 * j];
#pragma unroll
        for (int r = 0; r < R; ++r) { unsigned long long* o8 = (unsigned long long*)(orow + (size_t)r * DMODEL) + lane;
            o8[64 * j] = (unsigned long long)pk2(v[r][j].x * s[r] * gg.x, v[r][j].y * s[r] * gg.y) | ((unsigned long long)pk2(v[r][j].z * s[r] * gg.z, v[r][j].w * s[r] * gg.w) << 32); } }
}

__device__ __forceinline__ void qk_one(v4u raw, const float (&g)[8], const float (&cs)[8], const float (&sn)[8], int c, float scale, float (&out)[8]) {
    float x[8];
#pragma unroll
    for (int i = 0; i < 4; ++i) { x[2 * i] = b2f(raw[i] & 0xffffu); x[2 * i + 1] = b2f(raw[i] >> 16); }
    float ss = 0.f;
#pragma unroll
    for (int e = 0; e < 8; ++e) ss += x[e] * x[e];
    ss += __shfl_xor(ss, 1); ss += __shfl_xor(ss, 2); ss += __shfl_xor(ss, 4);
    const float rstd = 1.0f / sqrtf(ss * (1.f / 64.f) + NEPS);
#pragma unroll
    for (int e = 0; e < 8; ++e) { const float y = x[e] * rstd * g[e]; const float py = __shfl_xor(y, 4);
        out[e] = ((c < 4) ? (y * cs[e] - py * sn[e]) : (y * cs[e] + py * sn[e])) * scale; }
}
__device__ __forceinline__ void qk_prep_item(int b, int kb, bf16u* QKV, const float* qg, const float* kg, const float* rope, float* kmean, LAS float* scr, int tid) {
    const int r8 = tid >> 6, cc = tid & 63, hh = cc >> 3, c = cc & 7;
    float gq[8], gk[8], ks[8];
#pragma unroll
    for (int e = 0; e < 8; ++e) { gq[e] = qg[8 * c + e]; gk[e] = kg[8 * c + e]; ks[e] = 0.f; }
    const size_t rowbase = (size_t)b * SEQL + (size_t)kb * 256;
    for (int i = 0; i < 32; ++i) {
        const int rl = i * 8 + r8, pos = kb * 256 + rl;
        bf16u* prow = QKV + (rowbase + rl) * 1536 + hh * 64 + 8 * c;
        const v4u qv = *(const v4u*)prow; const v4u kv = *(const v4u*)(prow + 512);
        const f32x4g* tp = (const f32x4g*)(rope + ((size_t)pos * 32 + 8 * (c & 3)) * 2);
        float cs[8], sn[8];
#pragma unroll
        for (int j = 0; j < 4; ++j) { const f32x4g t = tp[j]; cs[2 * j] = t.x; sn[2 * j] = t.y; cs[2 * j + 1] = t.z; sn[2 * j + 1] = t.w; }
        float oq[8], ok[8];
        qk_one(qv, gq, cs, sn, c, 0.125f * 1.4426950408889634f, oq);
        qk_one(kv, gk, cs, sn, c, 1.0f, ok);
#pragma unroll
        for (int e = 0; e < 8; ++e) ks[e] += ok[e];
        v4u wq, wk;
#pragma unroll
        for (int j = 0; j < 4; ++j) { wq[j] = pk2(oq[2 * j], oq[2 * j + 1]); wk[j] = pk2(ok[2 * j], ok[2 * j + 1]); }
        *(v4u*)prow = wq; *(v4u*)(prow + 512) = wk;
    }
#pragma unroll
    for (int e = 0; e < 8; ++e) scr[(r8 * 64 + cc) * 8 + e] = ks[e];
    __syncthreads();
    { const int col = tid; float s = 0.f;
#pragma unroll
      for (int r = 0; r < 8; ++r) s += scr[(r * 64 + (col >> 3)) * 8 + (col & 7)];
      kmean[(((size_t)b * 8 + (col >> 6)) * 8 + kb) * 64 + (col & 63)] = s * (1.f / 256.f); }
    __syncthreads();
}

constexpr int H_QS = 136, H_SS = 72;
constexpr int L_QE = 0, L_KE = 17408, L_KET = 34816, L_VT = 53248, L_STP = 71680, L_A = 106496, L_TOT = 115712, L_SSB = 117760;
__device__ __forceinline__ int crowg(int r, int hi) { return (r & 3) + 8 * (r >> 2) + 4 * hi; }
#define MFMA32(a, b, c) __builtin_amdgcn_mfma_f32_32x32x16_bf16((a), (b), (c), 0, 0, 0)
#define HBAR() asm volatile("s_waitcnt lgkmcnt(0)\n\ts_barrier" ::: "memory")
__device__ __forceinline__ void hgrn_unit(int item, const bf16u* HG, const float* onorm_g, bf16u* OA, LAS unsigned char* lds, int tid) {
    asm volatile("" : "+v"(tid));
    const int b = item >> 2, h = item & 3;
    const int lane = tid & 63, w = __builtin_amdgcn_readfirstlane(tid >> 6), l31 = lane & 31, hi = lane >> 5;
    const int k = tid & 127, seg = tid >> 7;
    const int vb = w >> 1, tb = w & 1;
    LAS bf16u* QE = (LAS bf16u*)(lds + L_QE); LAS bf16u* KE = (LAS bf16u*)(lds + L_KE); LAS bf16u* KET = (LAS bf16u*)(lds + L_KET);
    LAS bf16u* VT = (LAS bf16u*)(lds + L_VT); LAS bf16u* STP = (LAS bf16u*)(lds + L_STP); LAS bf16u* AL = (LAS bf16u*)(lds + L_A);
    LAS float* TOT = (LAS float*)(lds + L_TOT); LAS float* SSB = (LAS float*)(lds + L_SSB);
    f32x16g st[2];
#pragma unroll
    for (int j = 0; j < 2; ++j)
#pragma unroll
        for (int r = 0; r < 16; ++r) st[j][r] = 0.f;
    unsigned rq[16], rl[16]; v4u rv[2];
#define HLOAD(cc) do { const size_t r0_ = (size_t)b * SEQL + (size_t)(cc) * 64; const bf16u* pq_ = HG + (r0_ + seg * 16) * 2048 + h * 128 + k; \
        _Pragma("unroll") for (int i = 0; i < 16; ++i) { rq[i] = pq_[(size_t)i * 2048]; rl[i] = pq_[(size_t)i * 2048 + 512]; } \
        _Pragma("unroll") for (int j = 0; j < 2; ++j) { const int id_ = tid + 512 * j; rv[j] = *(const v4u*)(HG + (r0_ + (id_ >> 4)) * 2048 + 1024 + h * 128 + (id_ & 15) * 8); } } while (0)
    HLOAD(0);
    for (int c = 0; c < 32; ++c) {
        const size_t row0 = (size_t)b * SEQL + (size_t)c * 64;
        v4u gvv[2];
#pragma unroll
        for (int j = 0; j < 2; ++j) { const int id = tid + 512 * j; gvv[j] = *(const v4u*)(HG + (row0 + (id >> 4)) * 2048 + 1536 + h * 128 + (id & 15) * 8); }
        float lf[16], qv[16], cs[16];
#pragma unroll
        for (int i = 0; i < 16; ++i) { qv[i] = b2f(rq[i]); lf[i] = b2f(rl[i]); }
        { float run = 0.f;
#pragma unroll
          for (int i = 0; i < 16; ++i) { run += lf[i]; cs[i] = run; }
          TOT[seg * 128 + k] = run; }
#pragma unroll
        for (int j = 0; j < 2; ++j) { const int id = tid + 512 * j, s = id >> 4, v0 = (id & 15) * 8; const v4u vv = rv[j];
            *(LAS v4u*)(VT + s * H_QS + v0) = vv; }
        if (c + 1 < 32) HLOAD(c + 1);
        HBAR();
        { const float t0 = TOT[k], t1 = TOT[128 + k], t2 = TOT[256 + k];
          const float mm = t0 + t1; const float p = (seg == 0) ? 0.f : (seg == 1) ? t0 : (seg == 2) ? mm : (mm + t2);
          unsigned kt[8];
#pragma unroll
          for (int ip = 0; ip < 8; ++ip) { const int s = seg * 16 + 2 * ip; const float c0 = p + cs[2 * ip], c1 = p + cs[2 * ip + 1];
              const float f0 = __expf(lf[2 * ip]), f1 = __expf(lf[2 * ip + 1]);
              const float qe0 = qv[2 * ip] * __expf(c0 - mm), qe1 = qv[2 * ip + 1] * __expf(c1 - mm), ke0 = (1.0f - f0) * __expf(mm - c0), ke1 = (1.0f - f1) * __expf(mm - c1);
              const unsigned pq = pk2(qe0, qe1), pk = pk2(ke0, ke1);
              QE[s * H_QS + k] = (bf16u)pq; QE[(s + 1) * H_QS + k] = (bf16u)(pq >> 16); KE[s * H_QS + k] = (bf16u)pk; KE[(s + 1) * H_QS + k] = (bf16u)(pk >> 16);
              kt[ip] = pk; }
          *(LAS v4u*)(KET + k * H_SS + seg * 16) = (v4u){kt[0], kt[1], kt[2], kt[3]};
          *(LAS v4u*)(KET + k * H_SS + seg * 16 + 8) = (v4u){kt[4], kt[5], kt[6], kt[7]}; }
#pragma unroll
        for (int j = 0; j < 2; ++j) { const int kk = (2 * (w & 1) + j) * 32 + l31; const float em = __expf(TOT[kk] + TOT[128 + kk]);
#pragma unroll
            for (int r = 0; r < 16; r += 2) { const unsigned pp = pk2(st[j][r] * em, st[j][r + 1] * em); const int v = vb * 32 + crowg(r, hi); STP[v * H_QS + kk] = (bf16u)pp; STP[(v + 1) * H_QS + kk] = (bf16u)(pp >> 16); } }
        HBAR();
        f32x16g o;
#pragma unroll
        for (int r = 0; r < 16; ++r) o[r] = 0.f;
#pragma unroll
        for (int ks = 0; ks < 8; ++ks) { const bf16x8g a = *(const LAS bf16x8g*)(STP + (vb * 32 + l31) * H_QS + ks * 16 + 8 * hi);
            const bf16x8g bq = *(const LAS bf16x8g*)(QE + (tb * 32 + l31) * H_QS + ks * 16 + 8 * hi); o = MFMA32(a, bq, o); }
        if (w < 4) { const int sb = vb; f32x16g A;
#pragma unroll
            for (int r = 0; r < 16; ++r) A[r] = 0.f;
            if (!(sb == 1 && tb == 0)) {
#pragma unroll
                for (int ks = 0; ks < 8; ++ks) { const bf16x8g a = *(const LAS bf16x8g*)(KE + (sb * 32 + l31) * H_QS + ks * 16 + 8 * hi);
                    const bf16x8g bq = *(const LAS bf16x8g*)(QE + (tb * 32 + l31) * H_QS + ks * 16 + 8 * hi); A = MFMA32(a, bq, A); } }
            const int t = tb * 32 + l31;
#pragma unroll
            for (int g = 0; g < 4; ++g) { const int s0 = sb * 32 + 8 * g + 4 * hi;
                const float a0 = (s0 + 0 <= t) ? A[4 * g + 0] : 0.f, a1 = (s0 + 1 <= t) ? A[4 * g + 1] : 0.f, a2 = (s0 + 2 <= t) ? A[4 * g + 2] : 0.f, a3 = (s0 + 3 <= t) ? A[4 * g + 3] : 0.f;
                typedef unsigned u2v __attribute__((ext_vector_type(2)));
                *(LAS u2v*)(AL + t * H_SS + s0) = (u2v){pk2(a0, a1), pk2(a2, a3)}; } }
        HBAR();
        { bf16x8g av[4];
#pragma unroll
          for (int ss = 0; ss < 4; ++ss)
#pragma unroll
              for (int e = 0; e < 8; ++e) av[ss][e] = (short)VT[(ss * 16 + 8 * hi + e) * H_QS + vb * 32 + l31];
#pragma unroll
          for (int ss = 0; ss < 4; ++ss) { const bf16x8g ba = *(const LAS bf16x8g*)(AL + (tb * 32 + l31) * H_SS + ss * 16 + 8 * hi); o = MFMA32(av[ss], ba, o); }
#pragma unroll
          for (int j = 0; j < 2; ++j) { const int kk = (2 * (w & 1) + j) * 32 + l31; f32x16g W;
#pragma unroll
              for (int r = 0; r < 16; ++r) W[r] = 0.f;
#pragma unroll
              for (int ss = 0; ss < 4; ++ss) { const bf16x8g bk = *(const LAS bf16x8g*)(KET + kk * H_SS + ss * 16 + 8 * hi); W = MFMA32(av[ss], bk, W); }
              const float mk = TOT[kk] + TOT[128 + kk], lastk = mk + TOT[256 + kk] + TOT[384 + kk];
              const float el = __expf(lastk), elm = __expf(lastk - mk);
#pragma unroll
              for (int r = 0; r < 16; ++r) st[j][r] = el * st[j][r] + elm * W[r]; } }
        { float q = 0.f;
#pragma unroll
          for (int r = 0; r < 16; ++r) q += o[r] * o[r];
          q += __shfl_xor(q, 32);
          if (hi == 0) SSB[vb * 64 + tb * 32 + l31] = q; }
        HBAR();
        { const int t = tb * 32 + l31; const float tot = (SSB[t] + SSB[64 + t]) + (SSB[128 + t] + SSB[192 + t]);
          const float rstd = 1.0f / sqrtf(tot * (1.f / 128.f) + NEPS);
#pragma unroll
          for (int g = 0; g < 4; ++g) { typedef unsigned u2w __attribute__((ext_vector_type(2)));
              *(LAS u2w*)(QE + t * H_QS + vb * 32 + 8 * g + 4 * hi) = (u2w){pk2(o[4 * g] * rstd, o[4 * g + 1] * rstd), pk2(o[4 * g + 2] * rstd, o[4 * g + 3] * rstd)}; } }
        HBAR();
#pragma unroll
        for (int j = 0; j < 2; ++j) { const int id = tid + 512 * j, t = id >> 4, v0 = (id & 15) * 8;
            const v4u ov = *(const LAS v4u*)(QE + t * H_QS + v0);
            const v4u gv = gvv[j];
            const f32x4g g0 = *(const f32x4g*)(onorm_g + h * 128 + v0), g1 = *(const f32x4g*)(onorm_g + h * 128 + v0 + 4);
            const float gn[8] = {g0.x, g0.y, g0.z, g0.w, g1.x, g1.y, g1.z, g1.w};
            v4u wv;
#pragma unroll
            for (int i = 0; i < 4; ++i) wv[i] = pk2(b2f(ov[i] & 0xffffu) * gn[2 * i] * b2f(gv[i] & 0xffffu), b2f(ov[i] >> 16) * gn[2 * i + 1] * b2f(gv[i] >> 16));
            *(v4u*)(OA + (row0 + t) * 512 + h * 128 + v0) = wv; }
        HBAR();
    }
}

#undef HLOAD
#define GAS __attribute__((address_space(1)))
typedef GAS unsigned gu32;
#define XB_TMO      128
#define XB_XCNT(j)  (256  + 64 * (j))
#define XB_XSUB(j)  (1280 + 64 * (j))
#define XB_XGEN(j)  (2304 + 64 * (j))
#define XB_TOP      3328
#define XB_TOPGEN   3392
#define XCD_BAR_WORDS 3456
#define XB_SPIN_CAP (1u << 18)

__device__ __forceinline__ unsigned xb_ld(unsigned* p)              { return __hip_atomic_load(p, __ATOMIC_RELAXED, __HIP_MEMORY_SCOPE_AGENT); }
__device__ __forceinline__ unsigned xb_add(unsigned* p, unsigned v) { return __hip_atomic_fetch_add(p, v, __ATOMIC_RELAXED, __HIP_MEMORY_SCOPE_AGENT); }
__device__ __forceinline__ unsigned xb_xcc_id() { return (unsigned)__builtin_amdgcn_s_getreg((3 << 11) | 20) & 0xFu; }
#define XB_SPIN(cond, bar) do { unsigned _sp = 0; while (cond) { __builtin_amdgcn_s_sleep(1); \
    if ((++_sp & 255u) == 0u) { if (xb_ld(&(bar)[XB_TMO])) break; if (_sp > XB_SPIN_CAP) { atomicAdd(&(bar)[XB_TMO], 1u); break; } } } } while (0)

struct XcdBarrier {
    unsigned* bar; unsigned x;
    volatile LAS unsigned* st;
};

__device__ __forceinline__ XcdBarrier xcd_barrier_post(unsigned* bar, volatile LAS unsigned* st) {
    XcdBarrier b; b.bar = bar; b.x = xb_xcc_id(); b.st = st;
    if (threadIdx.x == 0) (void)xb_add(&bar[XB_XCNT(b.x)], 1u);
    return b;
}
__device__ __forceinline__ void xcd_barrier_complete(unsigned* bar, unsigned x, unsigned& nloc, unsigned& nx) {
    const unsigned G = gridDim.x * gridDim.y * gridDim.z;
    unsigned sum, cnt, mine, sp = 0u;
    for (;;) {
        sum = 0u; cnt = 0u; mine = 0u;
#pragma unroll
        for (unsigned j = 0; j < 16; ++j) { const unsigned c = xb_ld(&bar[XB_XCNT(j)]); sum += c; cnt += (c > 0u) ? 1u : 0u; mine = (j == x) ? c : mine; }
        if (sum == G) break;
        __builtin_amdgcn_s_sleep(1);
        if ((++sp & 255u) == 0u) { if (xb_ld(&bar[XB_TMO])) break; if (sp > XB_SPIN_CAP) { atomicAdd(&bar[XB_TMO], 1u); break; } }
    }
    nloc = mine > 0u ? mine : 1u; nx = cnt > 0u ? cnt : 1u;
}

__device__ __forceinline__ void xcd_barrier(const XcdBarrier& b) {
    asm volatile("s_waitcnt vmcnt(0)" ::: "memory");
    __syncthreads();
    if (threadIdx.x == 0) {
        unsigned* bar = b.bar;
        __builtin_amdgcn_s_waitcnt(0);
        unsigned nloc = b.st[0], nx = b.st[1];
        if (nloc == 0u) { xcd_barrier_complete(bar, b.x, nloc, nx); b.st[0] = nloc; b.st[1] = nx; }
        const unsigned old = xb_add(&bar[XB_XSUB(b.x)], 1u);
        const unsigned gen = old / nloc;
        if (old + 1u == (gen + 1u) * nloc) {
            __builtin_amdgcn_fence(__ATOMIC_RELEASE, "agent");
            asm volatile("s_waitcnt vmcnt(0)" ::: "memory");
            const unsigned og = xb_add(&bar[XB_TOP], 1u);
            const unsigned tg = og / nx;
            if (og + 1u == (tg + 1u) * nx) xb_add(&bar[XB_TOPGEN], 1u);
            else XB_SPIN(xb_ld(&bar[XB_TOPGEN]) == tg, bar);
            __builtin_amdgcn_fence(__ATOMIC_ACQUIRE, "agent");
            xb_add(&bar[XB_XGEN(b.x)], 1u);
            asm volatile("s_waitcnt vmcnt(0)" ::: "memory");
        } else {
            XB_SPIN(xb_ld(&bar[XB_XGEN(b.x)]) == gen, bar);
            __builtin_amdgcn_fence(__ATOMIC_ACQUIRE, "agent");
            asm volatile("s_waitcnt vmcnt(0)" ::: "memory");
        }
    }
    __syncthreads();
}

struct Args { const float* in[15]; float* out; unsigned char* ws; };
__global__ void __launch_bounds__(NWAVES * 64, 2) fwd_kernel(Args args) {
    extern __shared__ __attribute__((aligned(16))) unsigned char lds_raw[];
    cg::grid_group grid = cg::this_grid();
    LAS unsigned char* lds = (LAS unsigned char*)lds_raw;
    const int G = gridDim.x, bx = blockIdx.x;
    if (threadIdx.x < 32) ((volatile LAS unsigned*)(lds + MISC_OFF))[threadIdx.x] = 0u;
    __syncthreads();
#define PHASE_IDS int tid = threadIdx.x; asm volatile("" : "+v"(tid)); const int lane = tid & 63, wave = __builtin_amdgcn_readfirstlane(tid >> 6); const int gw = bx * NWAVES + wave, NGW = G * NWAVES; const int gt = bx * (NWAVES * 64) + tid, NGT = G * NWAVES * 64; (void)lane; (void)gw; (void)NGW; (void)gt; (void)NGT;
#define ws (args.ws)
#define X_IN (args.in[0])
#define norm1_g (args.in[1])
#define w_in (args.in[2])
#define lb_logits (args.in[3])
#define onorm_g (args.in[4])
#define qn_g (args.in[5])
#define kn_g (args.in[6])
#define w_a (args.in[7])
#define w_b (args.in[8])
#define w_out (args.in[9])
#define norm2_g (args.in[10])
#define w_up (args.in[11])
#define conv_w (args.in[12])
#define conv_b (args.in[13])
#define w_down (args.in[14])
#define OUT_P (args.out)
#define ctl ((unsigned*)(ws + WS_CTL))
#define rope ((float*)(ws + WS_ROPE))
#define kmean ((float*)(ws + WS_KMEAN))
#define Win_t ((bf16u*)(ws + WS_WIN))
#define Wa_t ((bf16u*)(ws + WS_WA))
#define Wb_t ((bf16u*)(ws + WS_WB))
#define Wout_t ((bf16u*)(ws + WS_WOUT))
#define Wup_t ((bf16u*)(ws + WS_WUP))
#define Wdn_t ((bf16u*)(ws + WS_WDN))
#define XN ((bf16u*)(ws + WS_XN))
#define OA ((bf16u*)(ws + WS_OA))
#define OB ((bf16u*)(ws + WS_OB))
#define HG ((bf16u*)(ws + WS_HG))
#define QKV ((bf16u*)(ws + WS_QKV))
#define GT ((bf16u*)(ws + WS_GT))
#define MIX ((bf16u*)(ws + WS_MIX))
#define UV ((bf16u*)(ws + WS_UV))
#define GB ((bf16u*)(ws + WS_G))

    { PHASE_IDS
        LAS float* scr = (LAS float*)(lds + wave * 16384);
        constexpr int I_IN = (DMODEL / 64) * (DIN / 32), I_A = (512 / 64) * (DMODEL / 32), I_OUT = (DMODEL / 64) * (DMODEL / 32), I_DN = (DFF / 64) * (DMODEL / 32);
        constexpr int NITEMS = 2 * I_IN + 2 * I_A + I_OUT + I_DN;
        for (int it = gw; it < NITEMS; it += NGW) {
            int r = it;
            if (r < I_IN) { p0_transpose_item<2>(w_in, DMODEL, DIN, Win_t, scr, r, lane); continue; } r -= I_IN;
            if (r < I_IN) { p0_transpose_item<1>(w_up, DMODEL, DIN, Wup_t, scr, r, lane, norm2_g); continue; } r -= I_IN;
            if (r < I_A) { p0_transpose_item<0>(w_a, 512, DMODEL, Wa_t, scr, r, lane); continue; } r -= I_A;
            if (r < I_A) { p0_transpose_item<0>(w_b, 512, DMODEL, Wb_t, scr, r, lane); continue; } r -= I_A;
            if (r < I_OUT) { p0_transpose_item<0>(w_out, DMODEL, DMODEL, Wout_t, scr, r, lane); continue; } r -= I_OUT;
            p0_transpose_item<0>(w_down, DFF, DMODEL, Wdn_t, scr, r, lane);
        }
        for (int m = gw * 4; m < MTOK; m += NGW * 4) rms_rows_to_bf16<4>(X_IN + (size_t)m * DMODEL, norm1_g, XN + (size_t)m * DMODEL, lane);
        for (int e = gt; e < SEQL * 32; e += NGT) { const int pos = e >> 5, i = e & 31;
            const float inv = 1.0f / exp2f((float)i * (13.287712379549449f / 32.0f));
            const float ang = (float)pos * inv; float rv = ang * 0.15915494309189535f; rv -= floorf(rv);
            rope[2 * e] = __builtin_amdgcn_cosf(rv); rope[2 * e + 1] = __builtin_amdgcn_sinf(rv); }
        if (gt == 0) ctl[0] = 0u;
        for (int e = gt; e < MTOK; e += NGT) ((float*)(ws + WS_ROWSS))[e] = 0.f;
        for (int e = gt; e < 32 * 8 * 8 * 64; e += NGT) kmean[e] = 0.f;
        if (bx == 0) for (int i = tid; i < XCD_BAR_WORDS; i += NWAVES * 64) ctl[CW_BAR + i] = 0u;
    }
    grid.sync();
    XcdBarrier xbar = xcd_barrier_post(ctl + CW_BAR, (volatile LAS unsigned*)(lds + MISC_OFF) + 8);

    {
        pg8::Gemm g{XN, Win_t, MTOK, DIN, DMODEL}; pg8::StaticOrder S; S.init(MTOK, DIN, G, bx);
        pg8::EpiInProj E{HG, QKV, GT, lb_logits, qn_g, kn_g, rope, kmean};
        pg8::gemm_phase<pg8::EpiInProj, pg8::StaticOrder, PG8_ALIGN, PG8_SP2>(lds, g, S, E);
    }
    xcd_barrier(xbar);

    { PHASE_IDS
        volatile LAS unsigned* MISC = (volatile LAS unsigned*)(lds + MISC_OFF);
        for (;;) {
            if (tid == 0) MISC[0] = __hip_atomic_fetch_add(ctl, 1u, __ATOMIC_RELAXED, __HIP_MEMORY_SCOPE_AGENT);
            __syncthreads();
            const int item = (int)MISC[0];
            __syncthreads();
            if (item >= 128 + 2048) break;
            if (item < 128) hgrn_unit(item, HG, onorm_g, OA, lds, tid);
            else { const int j = item - 128, qb = 7 - (j >> 8), bh = j & 255;
                attn_body::attn_unit<8>(bh >> 3, bh & 7, qb, (const attn_body::bf16*)QKV, (const attn_body::bf16*)(QKV + 512), (const attn_body::bf16*)(QKV + 1024), (attn_body::bf16*)OB, kmean, (char*)lds_raw); }
        }
    }
    xcd_barrier(xbar);

    {
        pg8::Gemm g{OA, Wa_t, MTOK, DMODEL, 512}; pg8::StaticOrder S; S.init(MTOK, DMODEL, G, bx);
        pg8::EpiGateMix<0> E{MIX, GT};
        pg8::gemm_phase<pg8::EpiGateMix<0>, pg8::StaticOrder, PG8_ALIGN, PG8_SP2>(lds, g, S, E);
    }
    {
        pg8::Gemm g{OB, Wb_t, MTOK, DMODEL, 512}; pg8::StaticOrder S; S.init(MTOK, DMODEL, G, bx);
        pg8::EpiGateMix<1> E{MIX, GT + 1024};
        pg8::gemm_phase<pg8::EpiGateMix<1>, pg8::StaticOrder, PG8_ALIGN, PG8_SP2>(lds, g, S, E);
    }
    xcd_barrier(xbar);

    {
        pg8::Gemm g{MIX, Wout_t, MTOK, DMODEL, DMODEL}; pg8::StaticOrder S; S.init(MTOK, DMODEL, G, bx);
        pg8::EpiResNorm E{X_IN, OUT_P, XN, (float*)(ws + WS_ROWSS)};
        pg8::gemm_phase<pg8::EpiResNorm, pg8::StaticOrder, PG8_ALIGN, PG8_SP2>(lds, g, S, E);
    }
    xcd_barrier(xbar);

    {
        pg8::Gemm g{XN, Wup_t, MTOK, DIN, DMODEL}; pg8::StaticOrder S; S.init(MTOK, DIN, G, bx);
        pg8::EpiUpConv E{GB, conv_w, conv_b, (float*)(ws + WS_UFIRST), (float*)(ws + WS_VFIRST), (float*)(ws + WS_ULAST), (LAS float*)(lds + XCH_OFF), (const float*)(ws + WS_ROWSS)};
        pg8::gemm_phase<pg8::EpiUpConv, pg8::StaticOrder, true, PG8_SP2>(lds, g, S, E);
    }
    xcd_barrier(xbar);
    { PHASE_IDS
        const float* ufirst = (const float*)(ws + WS_UFIRST); const float* vfirst = (const float*)(ws + WS_VFIRST); const float* ulast = (const float*)(ws + WS_ULAST);
        for (int idx = gt; idx < 256 * 2 * 352; idx += NGT) {
            const int pm = idx / 704, rem = idx - pm * 704, j = rem / 352, c0 = (rem - j * 352) * 8; const bool seq0 = (pm & 7) == 0;
            v4u wv;
#pragma unroll
            for (int i = 0; i < 4; ++i) { float rr[2];
#pragma unroll
                for (int hh = 0; hh < 2; ++hh) { const int c = c0 + 2 * i + hh;
                    const float uc = ufirst[(size_t)(pm * 2 + j) * DFF + c];
                    float um1, um2;
                    if (j == 0) { um1 = seq0 ? 0.f : ulast[(size_t)((pm - 1) * 2 + 1) * DFF + c]; um2 = seq0 ? 0.f : ulast[(size_t)((pm - 1) * 2 + 0) * DFF + c]; }
                    else { um1 = ufirst[(size_t)(pm * 2 + 0) * DFF + c]; um2 = seq0 ? 0.f : ulast[(size_t)((pm - 1) * 2 + 1) * DFF + c]; }
                    rr[hh] = conv_b[c] + conv_w[c] * um2 + conv_w[DFF + c] * um1 + conv_w[2 * DFF + c] * uc; }
                const pg8::f32x2 gl = pg8::gelu_pk((pg8::f32x2){rr[0], rr[1]});
                wv[i] = pk2(gl.x * vfirst[(size_t)(pm * 2 + j) * DFF + c0 + 2 * i], gl.y * vfirst[(size_t)(pm * 2 + j) * DFF + c0 + 2 * i + 1]); }
            *(v4u*)(GB + (size_t)(pm * 256 + j) * DFF + c0) = wv;
        }
    }
    xcd_barrier(xbar);

    {
        pg8::Gemm g{GB, Wdn_t, MTOK, DMODEL, DFF}; pg8::StaticOrder S; S.init(MTOK, DMODEL, G, bx);
        pg8::EpiResF32 E{OUT_P, OUT_P, DMODEL};
        pg8::gemm_phase<pg8::EpiResF32, pg8::StaticOrder, PG8_ALIGN, PG8_SP2>(lds, g, S, E);
    }
}

#undef ws
#undef X_IN
#undef norm1_g
#undef w_in
#undef lb_logits
#undef onorm_g
#undef qn_g
#undef kn_g
#undef w_a
#undef w_b
#undef w_out
#undef norm2_g
#undef w_up
#undef conv_w
#undef conv_b
#undef w_down
#undef OUT_P
#undef ctl
#undef rope
#undef kmean
#undef Win_t
#undef Wa_t
#undef Wb_t
#undef Wout_t
#undef Wup_t
#undef Wdn_t
#undef XN
#undef OA
#undef OB
#undef HG
#undef QKV
#undef GT
#undef MIX
#undef UV
#undef GB
extern "C" void kernel_launch(void* const* d_in, const int* in_sizes, int n_in, void* d_out, int out_size, void* d_ws, size_t ws_size, hipStream_t stream) {
    static int grid = 0;
    if (grid == 0) {
        if (n_in != 15 || out_size != MTOK * DMODEL || ws_size < WS_END) { fprintf(stderr, "kernel_launch: unexpected shapes (n_in %d out %d ws %zu)\n", n_in, out_size, ws_size); grid = -1; return; }
        int dev = 0, cus = 0, per_cu = 0;
        (void)hipGetDevice(&dev); (void)hipDeviceGetAttribute(&cus, hipDeviceAttributeMultiprocessorCount, dev);
        if (hipFuncSetAttribute((const void*)fwd_kernel, hipFuncAttributeMaxDynamicSharedMemorySize, LDS_BYTES) != hipSuccess) { fprintf(stderr, "kernel_launch: hipFuncSetAttribute failed\n"); grid = -1; return; }
        if (hipOccupancyMaxActiveBlocksPerMultiprocessor(&per_cu, (const void*)fwd_kernel, NWAVES * 64, LDS_BYTES) != hipSuccess || per_cu < 1) per_cu = 1;
        (void)hipGetLastError();
        grid = cus * 1;
        if (grid <= 0) grid = 256;
    }
    if (grid < 0) return;
    Args a{};
    for (int i = 0; i < 15; ++i) a.in[i] = (const float*)d_in[i];
    a.out = (float*)d_out; a.ws = (unsigned char*)d_ws;
    void* kargs[] = {&a};
    hipError_t e = hipLaunchCooperativeKernel((const void*)fwd_kernel, dim3(grid), dim3(NWAVES * 64), kargs, LDS_BYTES, stream);
    if (e != hipSuccess) fprintf(stderr, "kernel_launch: cooperative launch failed: %s (grid %d)\n", hipGetErrorString(e), grid);
}
```

```cpp
#include <hip/hip_runtime.h>
#include <hip/hip_cooperative_groups.h>
#include <cstdio>
#include <cstdint>
namespace cg = cooperative_groups;
namespace pg8 {
#define PG8_LAS __attribute__((address_space(3)))
typedef unsigned short bf16_t;
typedef short bf16x8 __attribute__((ext_vector_type(8)));
typedef float f32x4 __attribute__((ext_vector_type(4)));
typedef unsigned u32x4 __attribute__((ext_vector_type(4)));
constexpr int BM = 256, BK = 64, HALF = 128, HTB = HALF * BK * 2  , STAGE_BYTES = 8 * HTB, NXCD = 8, WGM = 8;

__host__ __device__ __forceinline__ int lds_byte(int r, int c) { const int st = (r >> 4) * 2 + (c >> 5), rr = r & 15, cc = c & 31, ob = rr * 64 + cc * 2; return st * 1024 + (ob ^ (((ob >> 9) & 1) << 5)); }
__host__ __device__ __forceinline__ void stage_rc(int b, int& R, int& C) { const int st = b / 1024, sb = b % 1024, swz = sb ^ (((sb >> 9) & 1) << 5); R = (st >> 1) * 16 + swz / 64; C = (st & 1) * 32 + (swz % 64) / 2; }
__host__ __device__ __forceinline__ int perm32(int rho) { const int n = rho >> 4, i = rho & 15; return 8 * (i >> 2) + 4 * n + (i & 3); }

struct Unit { int pm, pn; };
struct Gemm { const bf16_t* A; const bf16_t* Bt; int M, N, K; };

struct StaticOrder {
    int nM, nN, nwg, G, c;
    __host__ __device__ void init(int M, int N, int G_, int c_) { nM = M / BM; nN = N / BM; nwg = nM * nN; G = G_; c = c_; }
    __host__ __device__ bool next(int i, Unit& u) const {
        const long L = (long)i * G + c; if (L >= nwg) return false;
        int wgid = (int)L; { const int q = nwg / NXCD, r = nwg % NXCD, xcd = wgid % NXCD, off = wgid / NXCD; wgid = (xcd < r ? xcd * (q + 1) : r * (q + 1) + (xcd - r) * q) + off; }
        const int nig = WGM * nN, gid = wgid / nig, fm = gid * WGM, gsz = (nM - fm) < WGM ? (nM - fm) : WGM;
        u.pm = fm + ((wgid % nig) % gsz); u.pn = (wgid % nig) / gsz; return true;
    }
    __device__ __forceinline__ void a_ready(const Unit&) const {}
    __device__ __forceinline__ void done(const Unit&) const {}
};

typedef float cvt_f32x2_t __attribute__((ext_vector_type(2))); typedef __bf16 cvt_bf16x2_t __attribute__((ext_vector_type(2)));
__device__ __forceinline__ unsigned cvt_pk_bf16(float lo, float hi) { const cvt_f32x2_t v = {lo, hi}; return __builtin_bit_cast(unsigned, __builtin_convertvector(v, cvt_bf16x2_t)); }
typedef float f32x2 __attribute__((ext_vector_type(2)));
__device__ __forceinline__ f32x2 gelu_pk(f32x2 v) {
    const f32x2 av = __builtin_elementwise_abs(v), d = av * 0.2316418882f + 1.0f;
    f32x2 t; t.x = __builtin_amdgcn_rcpf(d.x); t.y = __builtin_amdgcn_rcpf(d.y);
    f32x2 q = t * 0.5307027145f + (-0.7265760135f); q = q * t + 0.7107068705f; q = q * t + (-0.142248368f); q = q * t + 0.127414796f; q = q * t;
    const f32x2 s = (v * v) * (-0.72134752044f);
    f32x2 e; e.x = __builtin_amdgcn_exp2f(s.x); e.y = __builtin_amdgcn_exp2f(s.y);
    const f32x2 m = v * (q * e), r = v - m;
    f32x2 o; o.x = v.x < 0.f ? m.x : r.x; o.y = v.y < 0.f ? m.y : r.y; return o;
}

template <int ACT  > struct EpiBf16 {
    static constexpr bool PERM = true, AFTER_DRAIN = false; static_assert(ACT == 0 || ACT == 1, "EpiBf16: ACT is 0 (none) or 1 (gelu_pk)");
    bf16_t* O; int ldc; const float* bias; int split_cols; size_t split_stride; float scale0;
    __device__ __forceinline__ void operator()(const f32x4 (&acc)[2][2][4][2], const Unit& u, int wr, int wc, int fr, int fq) const {
        const int row0 = u.pm * BM + wr * 64 + fr; int colt = u.pn * BM; bf16_t* base = O;
        float sc = 1.f; if (split_cols) { const int t = colt / split_cols; base += (size_t)t * split_stride; colt -= t * split_cols; if (t == 0) sc = scale0; }
        const int col0 = colt + wc * 32 + 8 * fq, bcol0 = u.pn * BM + wc * 32 + 8 * fq;
        f32x4 bv[2][2];
#pragma unroll
        for (int bj = 0; bj < 2; ++bj)
#pragma unroll
            for (int n = 0; n < 2; ++n) bv[bj][n] = bias ? *(const f32x4*)(bias + bcol0 + bj * HALF + 4 * n) : (f32x4){0.f, 0.f, 0.f, 0.f};
#pragma unroll
        for (int ai = 0; ai < 2; ++ai)
#pragma unroll
            for (int m = 0; m < 4; ++m) { bf16_t* rowp = base + (size_t)(row0 + ai * HALF + m * 16) * ldc + col0;
#pragma unroll
                for (int bj = 0; bj < 2; ++bj) { f32x4 v0 = acc[ai][bj][m][0] + bv[bj][0], v1 = acc[ai][bj][m][1] + bv[bj][1];
                    if (ACT == 1) { f32x2 a = gelu_pk((f32x2){v0[0], v0[1]}), b = gelu_pk((f32x2){v0[2], v0[3]}), c = gelu_pk((f32x2){v1[0], v1[1]}), d = gelu_pk((f32x2){v1[2], v1[3]});
                        v0 = (f32x4){a.x, a.y, b.x, b.y}; v1 = (f32x4){c.x, c.y, d.x, d.y}; }
                    v0 = v0 * sc; v1 = v1 * sc; u32x4 w; w.x = cvt_pk_bf16(v0[0], v0[1]); w.y = cvt_pk_bf16(v0[2], v0[3]); w.z = cvt_pk_bf16(v1[0], v1[1]); w.w = cvt_pk_bf16(v1[2], v1[3]);
                    *(u32x4*)(rowp + bj * HALF) = w; } }
    }
};
__device__ __forceinline__ float bf2f(unsigned h) { return __uint_as_float(h << 16); }
__device__ __forceinline__ float sigm(float x) { return __builtin_amdgcn_rcpf(1.0f + __expf(-x)); }
struct EpiInProj {
    static constexpr bool PERM = true, AFTER_DRAIN = false;
    bf16_t* HG; bf16_t* QKV; bf16_t* GT; const float* lbl;
    const float* qg; const float* kg; const float* rope; float* kmean;
    __device__ __forceinline__ void operator()(const f32x4 (&acc)[2][2][4][2], const Unit& u, int wr, int wc, int fr, int fq) const {
        const int row0 = u.pm * BM + wr * 64 + fr; const int colt = u.pn * BM; const int seg = colt >> 9;
        bf16_t* base; int ldc, cb, mode;
        if (seg < 4) { base = HG; ldc = 2048; cb = colt; mode = (seg == 1) ? 1 : (seg == 2 ? 2 : 0); }
        else if (seg < 7) { base = QKV; ldc = 1536; cb = colt - 2048; mode = 2; }
        else { base = GT; ldc = 2048; cb = colt - 3584; mode = 3; }
        if (seg == 4 || seg == 5) {
            const bool isq = (seg == 4); const float* gn = isq ? qg : kg; const float sc = isq ? (0.125f * 1.4426950408889634f) : 1.0f;
            float g0[8], g1[8], ks0[8], ks1[8];
#pragma unroll
            for (int e = 0; e < 8; ++e) { g0[e] = gn[8 * fq + e] * sc; g1[e] = gn[32 + 8 * fq + e] * sc; ks0[e] = 0.f; ks1[e] = 0.f; }
            bf16_t* obase = QKV + cb + 64 * wc + 8 * fq;
#pragma unroll
            for (int ai = 0; ai < 2; ++ai)
#pragma unroll
                for (int m = 0; m < 4; ++m) { const int row = row0 + ai * HALF + m * 16; const int pos = row & 2047;
                    const f32x4 a0 = acc[ai][0][m][0], a1 = acc[ai][0][m][1], b0 = acc[ai][1][m][0], b1 = acc[ai][1][m][1];
                    const float v0[8] = {a0[0], a0[1], a0[2], a0[3], a1[0], a1[1], a1[2], a1[3]}, v1[8] = {b0[0], b0[1], b0[2], b0[3], b1[0], b1[1], b1[2], b1[3]};
                    float ss = 0.f;
#pragma unroll
                    for (int e = 0; e < 8; ++e) ss += v0[e] * v0[e] + v1[e] * v1[e];
                    ss += __shfl_xor(ss, 16); ss += __shfl_xor(ss, 32);
                    const float rstd = 1.0f / sqrtf(ss * (1.0f / 64.0f) + 1e-6f);
                    const f32x4* tp = (const f32x4*)(rope + ((size_t)pos * 32 + 8 * fq) * 2);
                    float o0[8], o1[8];
#pragma unroll
                    for (int j = 0; j < 4; ++j) { const f32x4 t = tp[j];
                        { const float y0 = v0[2 * j] * rstd * g0[2 * j], y1 = v1[2 * j] * rstd * g1[2 * j]; o0[2 * j] = y0 * t[0] - y1 * t[1]; o1[2 * j] = y1 * t[0] + y0 * t[1]; }
                        { const float y0 = v0[2 * j + 1] * rstd * g0[2 * j + 1], y1 = v1[2 * j + 1] * rstd * g1[2 * j + 1]; o0[2 * j + 1] = y0 * t[2] - y1 * t[3]; o1[2 * j + 1] = y1 * t[2] + y0 * t[3]; } }
                    if (!isq) {
#pragma unroll
                        for (int e = 0; e < 8; ++e) { ks0[e] += o0[e]; ks1[e] += o1[e]; } }
                    u32x4 w0, w1; w0.x = cvt_pk_bf16(o0[0], o0[1]); w0.y = cvt_pk_bf16(o0[2], o0[3]); w0.z = cvt_pk_bf16(o0[4], o0[5]); w0.w = cvt_pk_bf16(o0[6], o0[7]);
                    w1.x = cvt_pk_bf16(o1[0], o1[1]); w1.y = cvt_pk_bf16(o1[2], o1[3]); w1.z = cvt_pk_bf16(o1[4], o1[5]); w1.w = cvt_pk_bf16(o1[6], o1[7]);
                    *(u32x4*)(obase + (size_t)row * 1536) = w0; *(u32x4*)(obase + (size_t)row * 1536 + 32) = w1; }
            if (!isq) {
                const int head = ((colt - 2560) >> 6) + wc; float* km = kmean + ((size_t)((u.pm >> 3) * 8 + head) * 8 + (u.pm & 7)) * 64 + 8 * fq;
#pragma unroll
                for (int e = 0; e < 8; ++e) { float a = ks0[e], b = ks1[e];
                    a += __shfl_xor(a, 1); a += __shfl_xor(a, 2); a += __shfl_xor(a, 4); a += __shfl_xor(a, 8);
                    b += __shfl_xor(b, 1); b += __shfl_xor(b, 2); b += __shfl_xor(b, 4); b += __shfl_xor(b, 8);
                    if (fr == 0) { atomicAdd(km + e, a * (1.0f / 256.0f)); atomicAdd(km + 32 + e, b * (1.0f / 256.0f)); } } }
            return;
        }
        const int col0 = cb + wc * 32 + 8 * fq;
        if (mode == 0) tile_store<0>(acc, base, ldc, row0, col0, colt, wc, fq);
        else if (mode == 1) tile_store<1>(acc, base, ldc, row0, col0, colt, wc, fq);
        else if (mode == 2) tile_store<2>(acc, base, ldc, row0, col0, colt, wc, fq);
        else tile_store<3>(acc, base, ldc, row0, col0, colt, wc, fq);
    }
    template <int MODE> __device__ __forceinline__ void tile_store(const f32x4 (&acc)[2][2][4][2], bf16_t* base, int ldc, int row0, int col0, int colt, int wc, int fq) const {
        float lb[2][8];
#pragma unroll
        for (int bj = 0; bj < 2; ++bj)
#pragma unroll
            for (int e = 0; e < 8; ++e) lb[bj][e] = 0.f;
        if (MODE == 1) { const int c0 = colt - 512 + wc * 32 + 8 * fq;
#pragma unroll
            for (int bj = 0; bj < 2; ++bj)
#pragma unroll
                for (int e = 0; e < 8; ++e) lb[bj][e] = sigm(lbl[c0 + bj * HALF + e] - lbl[512 + c0 + bj * HALF + e]); }
#pragma unroll
        for (int ai = 0; ai < 2; ++ai)
#pragma unroll
            for (int m = 0; m < 4; ++m) { bf16_t* rowp = base + (size_t)(row0 + ai * HALF + m * 16) * ldc + col0;
#pragma unroll
                for (int bj = 0; bj < 2; ++bj) { const f32x4 a0 = acc[ai][bj][m][0], a1 = acc[ai][bj][m][1];
                    float v[8] = {a0[0], a0[1], a0[2], a0[3], a1[0], a1[1], a1[2], a1[3]};
                    if (MODE == 0) {
#pragma unroll
                        for (int e = 0; e < 8; ++e) v[e] = v[e] * sigm(v[e]);
                    } else if (MODE == 1) {
#pragma unroll
                        for (int e = 0; e < 8; ++e) { const float s = sigm(v[e]); v[e] = __logf(lb[bj][e] + (1.0f - lb[bj][e]) * s); }
                    } else if (MODE == 3) {
#pragma unroll
                        for (int e = 0; e < 8; ++e) v[e] = sigm(v[e]);
                    }
                    u32x4 w; w.x = cvt_pk_bf16(v[0], v[1]); w.y = cvt_pk_bf16(v[2], v[3]); w.z = cvt_pk_bf16(v[4], v[5]); w.w = cvt_pk_bf16(v[6], v[7]);
                    *(u32x4*)(rowp + bj * HALF) = w; } }
    }
};
template <int SECOND> struct EpiGateMix {
    static constexpr bool PERM = true, AFTER_DRAIN = false;
    bf16_t* O; const bf16_t* gate;
    __device__ __forceinline__ void operator()(const f32x4 (&acc)[2][2][4][2], const Unit& u, int wr, int wc, int fr, int fq) const {
        const int row0 = u.pm * BM + wr * 64 + fr; const int col0 = u.pn * BM + wc * 32 + 8 * fq;
#pragma unroll
        for (int ai = 0; ai < 2; ++ai)
#pragma unroll
            for (int m = 0; m < 4; ++m) { const size_t r = (size_t)(row0 + ai * HALF + m * 16);
#pragma unroll
                for (int bj = 0; bj < 2; ++bj) { const int c = col0 + bj * HALF;
                    const u32x4 g = *(const u32x4*)(gate + r * 2048 + c);
                    u32x4 p = (u32x4){0u, 0u, 0u, 0u}; if (SECOND) p = *(const u32x4*)(O + r * 1024 + c);
                    const f32x4 a0 = acc[ai][bj][m][0], a1 = acc[ai][bj][m][1];
                    float v[8] = {a0[0], a0[1], a0[2], a0[3], a1[0], a1[1], a1[2], a1[3]};
#pragma unroll
                    for (int i = 0; i < 4; ++i) { v[2 * i] = v[2 * i] * bf2f(g[i] & 0xffffu) + bf2f(p[i] & 0xffffu); v[2 * i + 1] = v[2 * i + 1] * bf2f(g[i] >> 16) + bf2f(p[i] >> 16); }
                    u32x4 w; w.x = cvt_pk_bf16(v[0], v[1]); w.y = cvt_pk_bf16(v[2], v[3]); w.z = cvt_pk_bf16(v[4], v[5]); w.w = cvt_pk_bf16(v[6], v[7]);
                    *(u32x4*)(O + r * 1024 + c) = w; } }
    }
};
struct EpiResF32 {
    static constexpr bool PERM = false, AFTER_DRAIN = false;
    const float* base; float* out; int ldc;
    __device__ __forceinline__ void operator()(const f32x4 (&acc)[2][2][4][2], const Unit& u, int wr, int wc, int fr, int fq) const {
        const int col0 = u.pn * BM + wc * 32 + 4 * fq;
#pragma unroll
        for (int ai = 0; ai < 2; ++ai)
#pragma unroll
            for (int m = 0; m < 4; ++m) { const size_t off = (size_t)(u.pm * BM + ai * HALF + wr * 64 + m * 16 + fr) * ldc + col0;
#pragma unroll
                for (int bj = 0; bj < 2; ++bj)
#pragma unroll
                    for (int n = 0; n < 2; ++n) { const f32x4 bs = *(const f32x4*)(base + off + bj * HALF + n * 16); *(f32x4*)(out + off + bj * HALF + n * 16) = bs + acc[ai][bj][m][n]; } }
    }
};

struct EpiResNorm {
    static constexpr bool PERM = true, AFTER_DRAIN = false;
    const float* base; float* out; bf16_t* xb; float* rowss;
    __device__ __forceinline__ void operator()(const f32x4 (&acc)[2][2][4][2], const Unit& u, int wr, int wc, int fr, int fq) const {
        const int col0 = u.pn * BM + wc * 32 + 8 * fq;
#pragma unroll
        for (int ai = 0; ai < 2; ++ai)
#pragma unroll
            for (int m = 0; m < 4; ++m) { const int row = u.pm * BM + ai * HALF + wr * 64 + m * 16 + fr; const size_t off = (size_t)row * 1024 + col0; float s = 0.f;
#pragma unroll
                for (int bj = 0; bj < 2; ++bj) { const f32x4 o0 = *(const f32x4*)(base + off + bj * HALF) + acc[ai][bj][m][0], o1 = *(const f32x4*)(base + off + bj * HALF + 4) + acc[ai][bj][m][1];
                    *(f32x4*)(out + off + bj * HALF) = o0; *(f32x4*)(out + off + bj * HALF + 4) = o1;
                    s += (o0[0] * o0[0] + o0[1] * o0[1]) + (o0[2] * o0[2] + o0[3] * o0[3]) + (o1[0] * o1[0] + o1[1] * o1[1]) + (o1[2] * o1[2] + o1[3] * o1[3]);
                    u32x4 w; w.x = cvt_pk_bf16(o0[0], o0[1]); w.y = cvt_pk_bf16(o0[2], o0[3]); w.z = cvt_pk_bf16(o1[0], o1[1]); w.w = cvt_pk_bf16(o1[2], o1[3]);
                    *(u32x4*)(xb + off + bj * HALF) = w; }
                s += __shfl_xor(s, 16); s += __shfl_xor(s, 32);
                if (fq == 0) atomicAdd(rowss + row, s); }
    }
};
__device__ __forceinline__ float dpp_shr1(float v) { return __builtin_bit_cast(float, __builtin_amdgcn_update_dpp(0, __builtin_bit_cast(int, v), 0x111, 0xf, 0xf, true)); }
__device__ __forceinline__ float dpp_shr2(float v) { return __builtin_bit_cast(float, __builtin_amdgcn_update_dpp(0, __builtin_bit_cast(int, v), 0x112, 0xf, 0xf, true)); }
__device__ __forceinline__ float dpp_shr1_old(float oldv, float v) { return __builtin_bit_cast(float, __builtin_amdgcn_update_dpp(__builtin_bit_cast(int, oldv), __builtin_bit_cast(int, v), 0x111, 0xf, 0xf, false)); }
__device__ __forceinline__ float dpp_shr2_old(float oldv, float v) { return __builtin_bit_cast(float, __builtin_amdgcn_update_dpp(__builtin_bit_cast(int, oldv), __builtin_bit_cast(int, v), 0x112, 0xf, 0xf, false)); }
struct EpiUpConv {
    static constexpr bool PERM = true, AFTER_DRAIN = false;
    bf16_t* G; const float* conv_w; const float* conv_b; float* ufirst; float* vfirst; float* ulast; PG8_LAS float* xch; const float* rowss;
    __device__ __forceinline__ void operator()(const f32x4 (&acc0)[2][2][4][2], const Unit& u, int wr, int wc, int fr, int fq) const {
        const int ch0 = u.pn * 128 + wc * 32 + 8 * fq;
        float w0[8], w1[8], w2[8], bb[8];
#pragma unroll
        for (int j = 0; j < 2; ++j) { const f32x4 a = *(const f32x4*)(conv_w + ch0 + 4 * j), b = *(const f32x4*)(conv_w + 2816 + ch0 + 4 * j), c = *(const f32x4*)(conv_w + 5632 + ch0 + 4 * j), d = *(const f32x4*)(conv_b + ch0 + 4 * j);
#pragma unroll
            for (int e = 0; e < 4; ++e) { w0[4 * j + e] = a[e]; w1[4 * j + e] = b[e]; w2[4 * j + e] = c[e]; bb[4 * j + e] = d[e]; } }
        f32x4 acc[2][2][4][2];
#pragma unroll
        for (int ai = 0; ai < 2; ++ai)
#pragma unroll
            for (int m = 0; m < 4; ++m) { const float rs = 1.0f / sqrtf(rowss[u.pm * BM + ai * HALF + wr * 64 + m * 16 + fr] * (1.0f / 1024.0f) + 1e-6f);
#pragma unroll
                for (int bj = 0; bj < 2; ++bj)
#pragma unroll
                    for (int n = 0; n < 2; ++n) acc[ai][bj][m][n] = acc0[ai][bj][m][n] * rs; }
        if (fr >= 14) {
#pragma unroll
            for (int ai = 0; ai < 2; ++ai)
#pragma unroll
                for (int m = 0; m < 4; ++m) { const int g = 4 * (2 * ai + wr) + m; PG8_LAS f32x4* p = (PG8_LAS f32x4*)(xch + (((g * 4 + wc) * 2 + (fr - 14)) * 4 + fq) * 8);
                    p[0] = acc[ai][0][m][0]; p[1] = acc[ai][0][m][1]; }
            if (wr == 1) { float* pl = ulast + (size_t)(u.pm * 2 + (fr - 14)) * 2816 + ch0; *(f32x4*)pl = acc[1][0][3][0]; *(f32x4*)(pl + 4) = acc[1][0][3][1]; }
        }
        if (wr == 0 && fr < 2) { float* pu = ufirst + (size_t)(u.pm * 2 + fr) * 2816 + ch0; *(f32x4*)pu = acc[0][0][0][0]; *(f32x4*)(pu + 4) = acc[0][0][0][1];
            float* pv = vfirst + (size_t)(u.pm * 2 + fr) * 2816 + ch0; *(f32x4*)pv = acc[0][1][0][0]; *(f32x4*)(pv + 4) = acc[0][1][0][1]; }
        asm volatile("s_waitcnt lgkmcnt(0)" ::: "memory"); __builtin_amdgcn_s_barrier(); asm volatile("" ::: "memory");
        const int row0 = u.pm * BM + wr * 64 + fr;
#pragma unroll
        for (int ai = 0; ai < 2; ++ai)
#pragma unroll
            for (int m = 0; m < 4; ++m) { const int g = 4 * (2 * ai + wr) + m; const int gp = (g > 0) ? g - 1 : 0;
                const PG8_LAS f32x4* xp = (const PG8_LAS f32x4*)(xch + (((gp * 4 + wc) * 2) * 4 + fq) * 8);
                const f32x4 xa0 = xp[0], xa1 = xp[1], xb0 = xp[8], xb1 = xp[9];
                const float X0[8] = {xa0[0], xa0[1], xa0[2], xa0[3], xa1[0], xa1[1], xa1[2], xa1[3]}, X1[8] = {xb0[0], xb0[1], xb0[2], xb0[3], xb1[0], xb1[1], xb1[2], xb1[3]};
                const f32x4 u0 = acc[ai][0][m][0], u1 = acc[ai][0][m][1], v0 = acc[ai][1][m][0], v1 = acc[ai][1][m][1];
                const float uu[8] = {u0[0], u0[1], u0[2], u0[3], u1[0], u1[1], u1[2], u1[3]}, vv[8] = {v0[0], v0[1], v0[2], v0[3], v1[0], v1[1], v1[2], v1[3]};
                float r[8];
#pragma unroll
                for (int e = 0; e < 8; e += 2) {
                    const float xs0 = (fr == 0) ? X0[e] : X1[e], xs1 = (fr == 0) ? X0[e + 1] : X1[e + 1];
                    const f32x2 P1 = {dpp_shr1_old(X1[e], uu[e]), dpp_shr1_old(X1[e + 1], uu[e + 1])}, P2 = {dpp_shr2_old(xs0, uu[e]), dpp_shr2_old(xs1, uu[e + 1])};
                    const f32x2 U = {uu[e], uu[e + 1]}, B = {bb[e], bb[e + 1]}, W0 = {w0[e], w0[e + 1]}, W1 = {w1[e], w1[e + 1]}, W2 = {w2[e], w2[e + 1]};
                    const f32x2 rr = B + W0 * P2 + W1 * P1 + W2 * U; r[e] = rr.x; r[e + 1] = rr.y; }
                u32x4 w;
#pragma unroll
                for (int i = 0; i < 4; ++i) { const f32x2 gl = gelu_pk((f32x2){r[2 * i], r[2 * i + 1]}); w[i] = cvt_pk_bf16(gl.x * vv[2 * i], gl.y * vv[2 * i + 1]); }
                *(u32x4*)(G + (size_t)(row0 + ai * HALF + m * 16) * 2816 + ch0) = w; }
    }
};

template <class Epi, class Sched, bool ALIGN_EPI = false, bool SP2 = false, bool TL = false>
__device__ __forceinline__ void gemm_phase(PG8_LAS unsigned char* lds, const Gemm g, const Sched& S, const Epi& E) {
    int tid_l = threadIdx.x; asm volatile("" : "+v"(tid_l));
    const int tid = tid_l, wid = __builtin_amdgcn_readfirstlane(tid >> 6), lane = tid & 63, wr = wid >> 2, wc = wid & 3, fr = lane & 15, fq = lane >> 4;
    const int K = g.K, nt = K / BK;
    unsigned voffA[2], voffB[2];
#pragma unroll
    for (int i = 0; i < 2; ++i) { int R, C; stage_rc(tid * 16 + i * 8192, R, C); const int Rb = Epi::PERM ? ((R & ~31) + perm32(R & 31)) : R;
        voffA[i] = (unsigned)(R * (TL ? BK : K) + C) * 2u; voffB[i] = (unsigned)(Rb * (TL ? BK : K) + C) * 2u; }
    const size_t kstep = TL ? (size_t)(BM * BK * 2) : (size_t)(BK * 2);
    const size_t hstep = TL ? (size_t)(HALF * BK * 2) : (size_t)HALF * K * 2;
    const size_t tstep = (size_t)BM * K * 2;
    const unsigned ldsw = (unsigned)wid * 1024u;
    const int aoff = lds_byte(wr * 64 + fr, fq * 8), boff = lds_byte(wc * 32 + fr, fq * 8);
#define PG8_SA(b, h) (((b) * 2 + (h)) * HTB)
#define PG8_SB(b, h) ((4 + (b) * 2 + (h)) * HTB)
#define PG8_STAGE(bufoff, gbase, voff) do { _Pragma("unroll") for (int _i = 0; _i < 2; ++_i) \
        __builtin_amdgcn_global_load_lds((const unsigned*)((const char*)(gbase) + (voff)[_i]), (PG8_LAS unsigned*)(lds + (bufoff) + ldsw + _i * 8192), 16, 0, 0); } while (0)
#define PG8_LDA(dst, b, h) do { _Pragma("unroll") for (int m = 0; m < 4; ++m) _Pragma("unroll") for (int k = 0; k < 2; ++k) dst[m][k] = *(const PG8_LAS bf16x8*)(lds + PG8_SA(b, h) + aoff + m * 2048 + k * 1024); } while (0)
#define PG8_LDB(dst, b, h) do { _Pragma("unroll") for (int n = 0; n < 2; ++n) _Pragma("unroll") for (int k = 0; k < 2; ++k) dst[n][k] = *(const PG8_LAS bf16x8*)(lds + PG8_SB(b, h) + boff + n * 2048 + k * 1024); } while (0)
#define PG8_MMA(ai, bj, At, Bt) do { __builtin_amdgcn_s_setprio(1); _Pragma("unroll") for (int m = 0; m < 4; ++m) _Pragma("unroll") for (int n = 0; n < 2; ++n) _Pragma("unroll") for (int k = 0; k < 2; ++k) \
        acc[ai][bj][m][n] = __builtin_amdgcn_mfma_f32_16x16x32_bf16(Bt[n][k], At[m][k], acc[ai][bj][m][n], 0, 0, 0); __builtin_amdgcn_s_setprio(0); } while (0)
#define PG8_WAIT_V(n) asm volatile("s_waitcnt vmcnt(" #n ")" ::: "memory")
#define PG8_WAIT_L(n) asm volatile("s_waitcnt lgkmcnt(" #n ")" ::: "memory")
#define PG8_BAR __builtin_amdgcn_s_barrier()
#define PG8_SCHED __builtin_amdgcn_sched_barrier(0)
    Unit cur, nxt; int ui = 0;
    if (!S.next(0, cur)) return;
    f32x4 acc[2][2][4][2];
#pragma unroll
    for (int a = 0; a < 2; ++a)
#pragma unroll
        for (int b = 0; b < 2; ++b)
#pragma unroll
            for (int m = 0; m < 4; ++m)
#pragma unroll
                for (int n = 0; n < 2; ++n) acc[a][b][m][n] = (f32x4){0.f, 0.f, 0.f, 0.f};
    bf16x8 At[4][2], B0[2][2], B1[2][2];
    const char* cA = (const char*)g.A + (size_t)cur.pm * tstep; const char* cB = (const char*)g.Bt + (size_t)cur.pn * tstep;
    S.a_ready(cur);
    if constexpr (SP2) {
        PG8_STAGE(PG8_SB(0, 0), cB, voffB); PG8_STAGE(PG8_SB(0, 1), cB + hstep, voffB); PG8_STAGE(PG8_SA(0, 0), cA, voffA); PG8_STAGE(PG8_SA(0, 1), cA + hstep, voffA);
        if (wr == 1) PG8_BAR;
        PG8_WAIT_V(2); PG8_BAR;
        PG8_STAGE(PG8_SB(1, 0), cB + kstep, voffB); PG8_STAGE(PG8_SA(1, 0), cA + kstep, voffA); PG8_STAGE(PG8_SB(1, 1), cB + hstep + kstep, voffB);
        PG8_WAIT_V(6); PG8_BAR;
    } else {
        PG8_STAGE(PG8_SB(0, 0), cB, voffB); PG8_STAGE(PG8_SA(0, 0), cA, voffA); PG8_STAGE(PG8_SB(0, 1), cB + hstep, voffB); PG8_STAGE(PG8_SA(0, 1), cA + hstep, voffA);
        if (wr == 1) PG8_BAR;
        PG8_WAIT_V(4); PG8_BAR;
        PG8_STAGE(PG8_SB(1, 0), cB + kstep, voffB); PG8_STAGE(PG8_SA(1, 0), cA + kstep, voffA); PG8_STAGE(PG8_SB(1, 1), cB + hstep + kstep, voffB);
        PG8_WAIT_V(6); PG8_BAR;
    }
    for (;;) {
        const bool has_next = S.next(ui + 1, nxt);
        const char* nA = has_next ? (const char*)g.A + (size_t)nxt.pm * tstep : cA; const char* nB = has_next ? (const char*)g.Bt + (size_t)nxt.pn * tstep : cB;
        for (int t = 0; t < nt; t += 2) {
            const bool last = (t == nt - 2);
            const char* a1 = cA + (size_t)(t + 1) * kstep;
            const char* a2 = last ? nA : cA + (size_t)(t + 2) * kstep; const char* b2 = last ? nB : cB + (size_t)(t + 2) * kstep;
            const char* a3 = a2 + kstep; const char* b3 = b2 + kstep;
            if (last && has_next) S.a_ready(nxt);
            if constexpr (SP2) {
            PG8_LDB(B0, 0, 0); PG8_LDB(B1, 0, 1); PG8_SCHED; PG8_LDA(At, 0, 0); PG8_STAGE(PG8_SA(1, 1), a1 + hstep, voffA);
            PG8_WAIT_V(8); PG8_WAIT_L(0); PG8_BAR; PG8_MMA(0, 0, At, B0); PG8_MMA(0, 1, At, B1); PG8_BAR; PG8_SCHED;
            PG8_LDA(At, 0, 1); PG8_STAGE(PG8_SB(0, 0), b2, voffB); PG8_STAGE(PG8_SB(0, 1), b2 + hstep, voffB); PG8_STAGE(PG8_SA(0, 0), a2, voffA);
            PG8_WAIT_V(8); PG8_WAIT_L(0); PG8_BAR; PG8_MMA(1, 0, At, B0); PG8_MMA(1, 1, At, B1); PG8_BAR; PG8_SCHED;
            PG8_LDB(B0, 1, 0); PG8_LDB(B1, 1, 1); PG8_SCHED; PG8_LDA(At, 1, 0); PG8_STAGE(PG8_SA(0, 1), a2 + hstep, voffA);
            PG8_WAIT_V(8); PG8_WAIT_L(0); PG8_BAR; PG8_MMA(0, 0, At, B0); PG8_MMA(0, 1, At, B1); PG8_BAR; PG8_SCHED;
            PG8_LDA(At, 1, 1); PG8_STAGE(PG8_SB(1, 0), b3, voffB); PG8_STAGE(PG8_SB(1, 1), b3 + hstep, voffB); PG8_STAGE(PG8_SA(1, 0), a3, voffA);
            PG8_WAIT_V(8); PG8_WAIT_L(0); PG8_BAR; PG8_MMA(1, 0, At, B0); PG8_MMA(1, 1, At, B1); PG8_BAR; PG8_SCHED;
            } else {
            PG8_LDB(B0, 0, 0); PG8_SCHED; PG8_LDA(At, 0, 0); PG8_STAGE(PG8_SA(1, 1), a1 + hstep, voffA);
            PG8_WAIT_L(8); PG8_BAR; PG8_WAIT_L(0); PG8_MMA(0, 0, At, B0); PG8_BAR; PG8_SCHED;
            PG8_LDB(B1, 0, 1); PG8_STAGE(PG8_SB(0, 0), b2, voffB);
            PG8_BAR; PG8_WAIT_L(0); PG8_MMA(0, 1, At, B1); PG8_BAR;
            PG8_LDA(At, 0, 1); PG8_STAGE(PG8_SA(0, 0), a2, voffA);
            PG8_BAR; PG8_WAIT_L(0); PG8_MMA(1, 0, At, B0); PG8_BAR; PG8_SCHED;
            PG8_STAGE(PG8_SB(0, 1), b2 + hstep, voffB);
            PG8_WAIT_V(6); PG8_BAR; PG8_MMA(1, 1, At, B1); PG8_BAR;
            PG8_LDB(B0, 1, 0); PG8_SCHED; PG8_LDA(At, 1, 0); PG8_STAGE(PG8_SA(0, 1), a2 + hstep, voffA);
            PG8_WAIT_L(8); PG8_BAR; PG8_WAIT_L(0); PG8_MMA(0, 0, At, B0); PG8_BAR; PG8_SCHED;
            PG8_LDB(B1, 1, 1); PG8_STAGE(PG8_SB(1, 0), b3, voffB);
            PG8_BAR; PG8_WAIT_L(0); PG8_MMA(0, 1, At, B1); PG8_BAR;
            PG8_LDA(At, 1, 1); PG8_STAGE(PG8_SA(1, 0), a3, voffA);
            PG8_BAR; PG8_WAIT_L(0); PG8_MMA(1, 0, At, B0); PG8_BAR; PG8_SCHED;
            PG8_STAGE(PG8_SB(1, 1), b3 + hstep, voffB);
            PG8_WAIT_V(6); PG8_BAR; PG8_MMA(1, 1, At, B1); PG8_BAR;
            }
        }
        if constexpr (ALIGN_EPI) { if (wr == 0) PG8_BAR; }
        if constexpr (!Epi::AFTER_DRAIN) { E(acc, cur, wr, wc, fr, fq); S.done(cur); }
        if (!has_next) break;
#pragma unroll
        for (int a = 0; a < 2; ++a)
#pragma unroll
            for (int b = 0; b < 2; ++b)
#pragma unroll
                for (int m = 0; m < 4; ++m)
#pragma unroll
                    for (int n = 0; n < 2; ++n) acc[a][b][m][n] = (f32x4){0.f, 0.f, 0.f, 0.f};
        cur = nxt; cA = nA; cB = nB; ++ui;
        if constexpr (ALIGN_EPI) { if (wr == 1) PG8_BAR; }
    }
    PG8_WAIT_V(0);
    if constexpr (!ALIGN_EPI) { if (wr == 0) PG8_BAR; }
    PG8_BAR;
    if constexpr (Epi::AFTER_DRAIN) { E.fused(acc, cur, wr, wc, fr, fq, lds, wid, lane); S.done(cur); }
#undef PG8_SA
#undef PG8_SB
#undef PG8_STAGE
#undef PG8_LDA
#undef PG8_LDB
#undef PG8_MMA
#undef PG8_WAIT_V
#undef PG8_WAIT_L
#undef PG8_BAR
#undef PG8_SCHED
}
}

#ifndef PG8_SP2
#define PG8_SP2 true
#endif
#ifndef PG8_ALIGN
#define PG8_ALIGN true
#endif
#include <hip/hip_bf16.h>
#include <cmath>
namespace attn_body {
using bf16=__hip_bfloat16;
using bf16x8=__attribute__((ext_vector_type(8)))short;
using s16x4=__attribute__((ext_vector_type(4)))short;
using f32x16=__attribute__((ext_vector_type(16)))float;
using u32x4=__attribute__((ext_vector_type(4)))unsigned;
constexpr int BATCH=32,NHEAD=8,SEQ=2048,D=64,DM=1536,OPITCH=512;
constexpr int NW=8,QBLK=32,QB=QBLK*NW,KVBLK=64,NQB=SEQ/QB;
constexpr int ATTN_PITCH=DM, ATTN_UNIT_ROWS=QB;
__device__ __forceinline__ int crow(int r,int hi){return (r&3)+8*(r>>2)+4*hi;}
#define SBAR() __builtin_amdgcn_sched_barrier(0)
__device__ __forceinline__ void cmask(f32x16&p0,f32x16&p1,int jb,int qrel,int hi){
  const float NEG=-INFINITY; int kb=64*jb+4*hi;
  #pragma unroll
  for(int r=0;r<16;++r){int kv=kb+(r&3)+8*(r>>2); if(kv>qrel)p0[r]=NEG; if(kv+32>qrel)p1[r]=NEG;}
}

constexpr int NSLOT=3, SLOTB=8192;
constexpr int LDS_K=0, LDS_V=NSLOT*SLOTB, LDS_WS=2*NSLOT*SLOTB, LDS_OST=LDS_WS+NW*64*4, LDS_BYTES=LDS_OST+NW*4096;
constexpr float C2=0.125f*1.4426950408889634f;
__device__ __forceinline__ void glds16(const void*gsrc,unsigned lds_dst){unsigned keep;
  asm volatile("s_mov_b32 %0, m0\n\ts_mov_b32 m0, %2\n\ts_nop 0\n\tglobal_load_lds_dwordx4 %1, off\n\ts_mov_b32 m0, %0":"=&s"(keep):"v"(gsrc),"s"(lds_dst):"memory");}
__device__ __forceinline__ float max3f(float a,float b,float c){float r;asm("v_max3_f32 %0, %1, %2, %3":"=v"(r):"v"(a),"v"(b),"v"(c));return r;}
__device__ __forceinline__ float max2f(float a,float b){float r;asm("v_max_f32_e32 %0, %1, %2":"=v"(r):"v"(a),"v"(b));return r;}
__device__ __forceinline__ float fadd_s(float a,float b){float r;asm("v_add_f32_e32 %0, %1, %2":"=v"(r):"v"(a),"v"(b));return r;}
__device__ __forceinline__ float fsub_s(float a,float b){float r;asm("v_sub_f32_e32 %0, %1, %2":"=v"(r):"v"(a),"v"(b));return r;}
typedef float f32x2_t __attribute__((ext_vector_type(2))); typedef __bf16 bf16x2_t __attribute__((ext_vector_type(2)));
__device__ __forceinline__ unsigned cvtpk_s(float lo,float hi){f32x2_t v={lo,hi};bf16x2_t b=__builtin_convertvector(v,bf16x2_t);return __builtin_bit_cast(unsigned,b);}
#define WAIT_BAR(N) asm volatile("s_waitcnt vmcnt(" #N ") lgkmcnt(0)\n\ts_barrier":::"memory")

__device__ __forceinline__ void qkt(f32x16&p0,f32x16&p1,const char*Kslot,const bf16x8*qr,const f32x16&negm,int r32,int hi){
  const char*kb=Kslot+hi*1024+r32*16;
  #pragma unroll
  for(int d0=0;d0<4;++d0){
    const bf16x8 b0=*reinterpret_cast<const bf16x8*>(kb+d0*2048);
    const bf16x8 b1=*reinterpret_cast<const bf16x8*>(kb+d0*2048+512);
    if(d0==0){p0=__builtin_amdgcn_mfma_f32_32x32x16_bf16(b0,qr[0],negm,0,0,0);p1=__builtin_amdgcn_mfma_f32_32x32x16_bf16(b1,qr[0],negm,0,0,0);}
    else{p0=__builtin_amdgcn_mfma_f32_32x32x16_bf16(b0,qr[d0],p0,0,0,0);p1=__builtin_amdgcn_mfma_f32_32x32x16_bf16(b1,qr[d0],p1,0,0,0);}}
}
typedef __attribute__((address_space(3))) const char* lds_cptr;
typedef short v4i16_t __attribute__((ext_vector_type(4)));
__device__ __forceinline__ void kload8(bf16x8*kf,lds_cptr kp){
  kf[0]=*(const __attribute__((address_space(3))) bf16x8*)(kp);      kf[1]=*(const __attribute__((address_space(3))) bf16x8*)(kp+512);
  kf[2]=*(const __attribute__((address_space(3))) bf16x8*)(kp+2048); kf[3]=*(const __attribute__((address_space(3))) bf16x8*)(kp+2560);
  kf[4]=*(const __attribute__((address_space(3))) bf16x8*)(kp+4096); kf[5]=*(const __attribute__((address_space(3))) bf16x8*)(kp+4608);
  kf[6]=*(const __attribute__((address_space(3))) bf16x8*)(kp+6144); kf[7]=*(const __attribute__((address_space(3))) bf16x8*)(kp+6656);
}
__device__ __forceinline__ void kload2(bf16x8*kf,lds_cptr kp,int j){ kf[2*j]=*(const __attribute__((address_space(3))) bf16x8*)(kp+j*2048); kf[2*j+1]=*(const __attribute__((address_space(3))) bf16x8*)(kp+j*2048+512); }
__device__ __forceinline__ s16x4 vtr(lds_cptr p){ return __builtin_bit_cast(s16x4,__builtin_amdgcn_ds_read_tr16_b64_v4i16((__attribute__((address_space(3))) v4i16_t*)p)); }
__device__ __forceinline__ float rowmax(const f32x16&p0,const f32x16&p1){
  float a=max3f(p0[0],p0[1],p1[0]),b=max3f(p0[2],p0[3],p1[1]);a=max3f(a,p1[2],p1[3]);
  #pragma unroll
  for(int r=4;r<16;r+=4){a=max3f(a,p0[r],p0[r+1]);b=max3f(b,p0[r+2],p0[r+3]);a=max3f(a,p1[r],p1[r+1]);b=max3f(b,p1[r+2],p1[r+3]);}
  const float m=max2f(a,b);
  auto rr=__builtin_amdgcn_permlane32_swap(__float_as_uint(m),__float_as_uint(m),false,false);
  return max2f(__uint_as_float(rr[0]),__uint_as_float(rr[1]));
}
__device__ __forceinline__ void pv(f32x16*o,int vb,bf16x8 pa0,bf16x8 pa1,bf16x8 pa2,bf16x8 pa3){
  #pragma unroll
  for(int d0=0;d0<2;++d0){s16x4 lo[4],hi[4];
    #pragma unroll
    for(int ks=0;ks<4;++ks){
      asm volatile("ds_read_b64_tr_b16 %0,%1 offset:%c2":"=&v"(lo[ks]):"v"(vb),"i"(d0*4096+ks*1024):"memory");
      asm volatile("ds_read_b64_tr_b16 %0,%1 offset:%c2":"=&v"(hi[ks]):"v"(vb),"i"(d0*4096+ks*1024+512):"memory");}
    asm volatile("s_waitcnt lgkmcnt(0)":::"memory");SBAR();
    #define PK(k) (bf16x8){lo[k][0],lo[k][1],lo[k][2],lo[k][3],hi[k][0],hi[k][1],hi[k][2],hi[k][3]}
    o[d0]=__builtin_amdgcn_mfma_f32_32x32x16_bf16(pa0,PK(0),o[d0],0,0,0);
    o[d0]=__builtin_amdgcn_mfma_f32_32x32x16_bf16(pa1,PK(1),o[d0],0,0,0);
    o[d0]=__builtin_amdgcn_mfma_f32_32x32x16_bf16(pa2,PK(2),o[d0],0,0,0);
    o[d0]=__builtin_amdgcn_mfma_f32_32x32x16_bf16(pa3,PK(3),o[d0],0,0,0);
    #undef PK
  }
}

#ifndef ATTN_STORE16
#define ATTN_STORE16(p,v) (*(u32x4*)(p)=(v))
#endif
template<int THRL> __device__ __forceinline__ void attn_unit(int b,int h,int qb,const bf16*Q,const bf16*__restrict__ K,const bf16*__restrict__ V,bf16*O,const float*kmean,char*shm){
  int tid_l=threadIdx.x; asm volatile("":"+v"(tid_l)); const int tid=tid_l,lane=tid&63,r32=lane&31,hi=lane>>5; const int wid=__builtin_amdgcn_readfirstlane(tid>>6);
  const long rowbase=(long)b*SEQ; const int q0=qb*QB;
  const bf16*Qw=Q+(rowbase+q0+wid*QBLK)*DM+h*D;
  const bf16*Kh=K+rowbase*DM+h*D,*Vh=V+rowbase*DM+h*D;
  const unsigned lds0=(unsigned)(uintptr_t)shm;
  float*wsf=(float*)(shm+LDS_WS)+wid*64;
  const bf16*ksrc=Kh+(long)lane*DM+wid*8;
  const bf16*vsrc=Vh+(long)(16*(wid&3)+(lane>>2))*DM+(wid>>2)*32+(lane&3)*8;
  const unsigned kdst=lds0+LDS_K+wid*1024, vdst=lds0+LDS_V+wid*1024;
  #define DMA_K(t,slot) glds16(ksrc+(long)(t)*KVBLK*DM,(unsigned)__builtin_amdgcn_readfirstlane(kdst+(slot)))
  #define DMA_V(t,slot) glds16(vsrc+(long)(t)*KVBLK*DM,(unsigned)__builtin_amdgcn_readfirstlane(vdst+(slot)))
  const int vb0=(int)(lds0+LDS_V)+((lane>>4)&1)*32+(lane&3)*8+(4*hi+((lane&15)>>2))*64;
  const char*Kbase=shm+LDS_K; bf16x8 kf[8];
  const lds_cptr shm3=(lds_cptr)shm; const lds_cptr kp0=shm3+LDS_K+hi*1024+r32*16; const lds_cptr vp0=shm3+LDS_V+((lane>>4)&1)*32+(lane&3)*8+(4*hi+((lane&15)>>2))*64;
  const int NT=(q0+QB)/KVBLK;
  DMA_K(0,0);DMA_V(0,0);DMA_K(1,SLOTB);
  bf16x8 qr[4];
  #pragma unroll
  for(int d0=0;d0<4;++d0)qr[d0]=*reinterpret_cast<const bf16x8*>(&Qw[(long)r32*DM+d0*16+hi*8]);
  unsigned selm=0xffu;
  if(qb>=4){ float gsc[7]; const float*km=kmean+((long)(b*NHEAD+h)*8)*64;
    #pragma unroll
    for(int n=0;n<7;++n){ float s=-INFINITY;
      if(n<qb){ s=0.f;
        #pragma unroll
        for(int d0=0;d0<4;++d0){ const float4 k0=*reinterpret_cast<const float4*>(km+n*64+d0*16+hi*8),k1=*reinterpret_cast<const float4*>(km+n*64+d0*16+hi*8+4);
          const bf16x8 qq=qr[d0];
          s+=__uint_as_float((unsigned)(unsigned short)qq[0]<<16)*k0.x+__uint_as_float((unsigned)(unsigned short)qq[1]<<16)*k0.y+__uint_as_float((unsigned)(unsigned short)qq[2]<<16)*k0.z+__uint_as_float((unsigned)(unsigned short)qq[3]<<16)*k0.w
            +__uint_as_float((unsigned)(unsigned short)qq[4]<<16)*k1.x+__uint_as_float((unsigned)(unsigned short)qq[5]<<16)*k1.y+__uint_as_float((unsigned)(unsigned short)qq[6]<<16)*k1.z+__uint_as_float((unsigned)(unsigned short)qq[7]<<16)*k1.w; }
        s+=__shfl_xor(s,32); }
      gsc[n]=s; }
    selm=1u<<qb;
    #pragma unroll
    for(int n=0;n<7;++n){ int rank=0;
      #pragma unroll
      for(int m2=0;m2<7;++m2){ if(m2!=n){ if(gsc[m2]>gsc[n]||(gsc[m2]==gsc[n]&&m2<n))++rank; } }
      if(n<qb&&rank<3)selm|=1u<<n; } }
  float mhat=0.f,l_reg=0.f;f32x16 o[2];o[0]=f32x16{};o[1]=f32x16{};const f32x16 zero16=f32x16{};
  const bf16x8 kones=__builtin_bit_cast(bf16x8,(u32x4){hi==0?0x3F803F80u:0u,0u,0u,0u});
  const int qrel=wid*QBLK+r32;
  #define CMASK0(P0,P1,t) do{int jb_=(t)-(NT-4); if(jb_>=0)cmask(P0,P1,jb_,qrel,hi); else if(!((selm>>((t)>>2))&1u)){ _Pragma("unroll") for(int r_=0;r_<16;++r_){P0[r_]=-INFINITY;P1[r_]=-INFINITY;} } }while(0)
  #define CMASK(P0,P1,t) do{int jb_=(t)-(NT-4); if(jb_>=0)cmask(P0,P1,jb_,qrel,hi);}while(0)
  bool resc=false;
  #define START(P0,P1) do{ const float rm=rowmax(P0,P1); resc=false; \
    { const float dl=__builtin_ceilf(__builtin_fmaxf(rm,-30.f)); mhat=fadd_s(mhat,dl); \
      _Pragma("unroll") for(int r=0;r<16;++r){P0[r]=fsub_s(P0[r],dl);P1[r]=fsub_s(P1[r],dl);} \
      } \
    _Pragma("unroll") for(int r=0;r<16;++r)P0[r]=__builtin_amdgcn_exp2f(P0[r]); }while(0)
  #define RESC() do{ if(resc){ asm volatile("s_waitcnt lgkmcnt(0)":::"memory"); \
      _Pragma("unroll") for(int d_=0;d_<2;++d_) _Pragma("unroll") for(int r=0;r<16;++r)o[d_][r]*=wsf[crow(r,hi)]; } }while(0)
  f32x16 pA0,pA1,pB0,pB1;
  int sl_prev=0,sl_cur=0,sl_next=SLOTB;
  #define ROT() do{sl_prev=sl_cur;sl_cur=sl_next;sl_next=(sl_next==(NSLOT-1)*SLOTB)?0:sl_next+SLOTB;}while(0)
  DMA_K(2,2*SLOTB);
  WAIT_BAR(3);
  qkt(pA0,pA1,Kbase,qr,zero16,r32,hi);asm volatile("s_nop 15\n\ts_nop 7":"+v"(pA0),"+v"(pA1));CMASK0(pA0,pA1,0);
  START(pA0,pA1);
  _Pragma("unroll") for(int r=0;r<16;++r)pA1[r]=__builtin_amdgcn_exp2f(pA1[r]);
  WAIT_BAR(0);
  DMA_K(3,0);DMA_V(1,SLOTB);
  ROT();
  kload8(kf,kp0+sl_cur);
  WAIT_BAR(2);
  s16x4 vlo[8],vhi[8]; u32x4 pw0,pw1,pw2,pw3;
  #define PKW(P,B) cvtpk_s(P[B],P[B+1])
  #define PAF(k) __builtin_bit_cast(bf16x8,pw##k)
  #define VFR(i) (bf16x8){vlo[i][0],vlo[i][1],vlo[i][2],vlo[i][3],vhi[i][0],vhi[i][1],vhi[i][2],vhi[i][3]}
  #define PIN(x) asm volatile("":"+v"(x))
  #define MX3(a,b,c) __builtin_fmaxf(__builtin_fmaxf((a),(b)),(c))
  #define GAPA(MF,A0,A1,A2,A3,W0,W1,PW) do{ MF; sacc+=A0; sacc+=A1; sacc+=A2; sacc+=A3; PIN(sacc); W0; W1; PIN(PW); SBAR(); }while(0)
  #define EX(v) __builtin_amdgcn_exp2f(v)
  #define GAPB(MF,X,B) do{ MF; X[B]=EX(X[B]); X[B+1]=EX(X[B+1]); X[B+2]=EX(X[B+2]); X[B+3]=EX(X[B+3]); PIN(X); SBAR(); }while(0)
  #define VRD(i) do{ vlo[i]=vtr(vp_+(((i)>>2)*4096+((i)&3)*1024)); vhi[i]=vtr(vp_+(((i)>>2)*4096+((i)&3)*1024+512)); }while(0)
  #define KRD(G,j) do{ if(G){ kload2(kf,kp0+sl_next,j); SBAR(); } }while(0)
  #define STEP(C0,C1,P0,P1,t,GK,GV,GL) do{ SBAR(); \
    const lds_cptr vp_=vp0+sl_prev; \
    { const unsigned w_=(hi==0)?((__float_as_uint(-mhat)>>16)|(((selm>>((t)>>2))&1u)?0u:0xC6000000u)):0u; const bf16x8 qaug=__builtin_bit_cast(bf16x8,(u32x4){w_,0u,0u,0u}); \
      C0=__builtin_amdgcn_mfma_f32_32x32x16_bf16(kones,qaug,zero16,0,0,0); C1=__builtin_amdgcn_mfma_f32_32x32x16_bf16(kones,qaug,zero16,0,0,0); } \
    VRD(0); SBAR(); float sacc=(P0[0]+P0[1]); \
    GAPA(C0=__builtin_amdgcn_mfma_f32_32x32x16_bf16(kf[0],qr[0],C0,0,0,0), P0[2],P0[3],P0[4],P0[5],     pw0[0]=PKW(P0,0), pw0[1]=PKW(P0,2), pw0); \
    VRD(4); SBAR(); GAPA(C1=__builtin_amdgcn_mfma_f32_32x32x16_bf16(kf[1],qr[0],C1,0,0,0), P0[6],P0[7],P0[8],P0[9],     pw0[2]=PKW(P0,4), pw0[3]=PKW(P0,6), pw0); \
    VRD(1); SBAR(); GAPA(C0=__builtin_amdgcn_mfma_f32_32x32x16_bf16(kf[2],qr[1],C0,0,0,0),   P0[10],P0[11],P0[12],P0[13], pw1[0]=PKW(P0,8), pw1[1]=PKW(P0,10), pw1); \
    VRD(5); SBAR(); GAPA(C1=__builtin_amdgcn_mfma_f32_32x32x16_bf16(kf[3],qr[1],C1,0,0,0),   P0[14],P0[15],P1[0],P1[1],   pw1[2]=PKW(P0,12),pw1[3]=PKW(P0,14), pw1); \
    VRD(2); SBAR(); GAPA(C0=__builtin_amdgcn_mfma_f32_32x32x16_bf16(kf[4],qr[2],C0,0,0,0),   P1[2],P1[3],P1[4],P1[5],     pw2[0]=PKW(P1,0), pw2[1]=PKW(P1,2), pw2); \
    VRD(6); SBAR(); GAPA(C1=__builtin_amdgcn_mfma_f32_32x32x16_bf16(kf[5],qr[2],C1,0,0,0),   P1[6],P1[7],P1[8],P1[9],     pw2[2]=PKW(P1,4), pw2[3]=PKW(P1,6), pw2); \
    VRD(3); SBAR(); GAPA(C0=__builtin_amdgcn_mfma_f32_32x32x16_bf16(kf[6],qr[3],C0,0,0,0),   P1[10],P1[11],P1[12],P1[13], pw3[0]=PKW(P1,8), pw3[1]=PKW(P1,10), pw3); \
    VRD(7); SBAR(); GAPA(C1=__builtin_amdgcn_mfma_f32_32x32x16_bf16(kf[7],qr[3],C1,0,0,0),   P1[14],P1[15],0.f,0.f,       pw3[2]=PKW(P1,12),pw3[3]=PKW(P1,14), pw3); \
    l_reg+=sacc; \
    if(GK){DMA_K((t)+3,sl_cur);} if(GV){DMA_V((t)+1,sl_next);} \
    CMASK(C0,C1,t); \
    { float a=MX3(C0[0],C0[1],C1[0]),b=MX3(C0[2],C0[3],C1[1]); a=MX3(a,C1[2],C1[3]); \
      _Pragma("unroll") for(int r=4;r<16;r+=4){a=MX3(a,C0[r],C0[r+1]);b=MX3(b,C0[r+2],C0[r+3]);a=MX3(a,C1[r],C1[r+1]);b=MX3(b,C1[r+2],C1[r+3]);} \
      float rm=__builtin_fmaxf(a,b); { auto rr=__builtin_amdgcn_permlane32_swap(__float_as_uint(rm),__float_as_uint(rm),false,false); rm=__builtin_fmaxf(__uint_as_float(rr[0]),__uint_as_float(rr[1])); } \
      resc=false; \
      if(__builtin_expect(__any(rm>(float)THRL),0)){ const float dl=__builtin_ceilf(__builtin_fmaxf(rm,0.f)); mhat+=dl; \
        _Pragma("unroll") for(int r=0;r<16;++r){C0[r]-=dl;C1[r]-=dl;} \
        const float f=__builtin_amdgcn_exp2f(-dl); l_reg*=f; if(hi==0)wsf[r32]=f; resc=true; } } \
    SBAR(); \
    GAPB(o[0]=__builtin_amdgcn_mfma_f32_32x32x16_bf16(PAF(0),VFR(0),o[0],0,0,0), C0,0); \
    GAPB(o[1]=__builtin_amdgcn_mfma_f32_32x32x16_bf16(PAF(0),VFR(4),o[1],0,0,0), C0,4); \
    KRD(GL,0); GAPB(o[0]=__builtin_amdgcn_mfma_f32_32x32x16_bf16(PAF(1),VFR(1),o[0],0,0,0), C0,8); \
    KRD(GL,1); GAPB(o[1]=__builtin_amdgcn_mfma_f32_32x32x16_bf16(PAF(1),VFR(5),o[1],0,0,0), C0,12); \
    KRD(GL,2); GAPB(o[0]=__builtin_amdgcn_mfma_f32_32x32x16_bf16(PAF(2),VFR(2),o[0],0,0,0), C1,0); \
    KRD(GL,3); GAPB(o[1]=__builtin_amdgcn_mfma_f32_32x32x16_bf16(PAF(2),VFR(6),o[1],0,0,0), C1,4); \
    GAPB(o[0]=__builtin_amdgcn_mfma_f32_32x32x16_bf16(PAF(3),VFR(3),o[0],0,0,0), C1,8); \
    GAPB(o[1]=__builtin_amdgcn_mfma_f32_32x32x16_bf16(PAF(3),VFR(7),o[1],0,0,0), C1,12); \
    }while(0)
  int t=1;
  #undef CMASK
  #define CMASK(P0,P1,t) do{}while(0)
  for(;t+5<NT;t+=2){
    STEP(pB0,pB1,pA0,pA1,t,true,true,true);     WAIT_BAR(2); RESC(); ROT();
    STEP(pA0,pA1,pB0,pB1,t+1,true,true,true);   WAIT_BAR(2); RESC(); ROT();
  }
  #undef CMASK
  #define CMASK(P0,P1,t) do{int jb_=(t)-(NT-4); if(jb_>=0)cmask(P0,P1,jb_,qrel,hi);}while(0)
  #define ENDW(tt) do{ if((tt)+3<NT){WAIT_BAR(2);} else if((tt)+2<NT){WAIT_BAR(1);} else {WAIT_BAR(0);} }while(0)
  for(;t+1<NT;t+=2){
    STEP(pB0,pB1,pA0,pA1,t,(t+3<NT),(t+1<NT),(t+1<NT));       ENDW(t);   RESC(); ROT();
    STEP(pA0,pA1,pB0,pB1,t+1,(t+4<NT),(t+2<NT),(t+2<NT));     ENDW(t+1); RESC(); ROT();
  }
  STEP(pB0,pB1,pA0,pA1,NT-1,false,false,false); RESC();
  { float sacc=pB0[0]+pB0[1]; _Pragma("unroll") for(int r=2;r<16;++r)sacc+=pB0[r]; _Pragma("unroll") for(int r=0;r<16;++r)sacc+=pB1[r]; l_reg+=sacc;
    pw0=(u32x4){PKW(pB0,0),PKW(pB0,2),PKW(pB0,4),PKW(pB0,6)};pw1=(u32x4){PKW(pB0,8),PKW(pB0,10),PKW(pB0,12),PKW(pB0,14)};pw2=(u32x4){PKW(pB1,0),PKW(pB1,2),PKW(pB1,4),PKW(pB1,6)};pw3=(u32x4){PKW(pB1,8),PKW(pB1,10),PKW(pB1,12),PKW(pB1,14)};
    SBAR(); pv(o,vb0+sl_cur,PAF(0),PAF(1),PAF(2),PAF(3)); }
  #undef PKW
  #undef PAF
  #undef VFR
  #undef PIN
  #undef MX3
  #undef GAPA
  #undef GAPB
  #undef EX
  #undef VRD
  #undef KRD
  #undef STEP
  #undef ENDW
  {auto rr=__builtin_amdgcn_permlane32_swap(__float_as_uint(l_reg),__float_as_uint(l_reg),false,false);l_reg=__uint_as_float(rr[0])+__uint_as_float(rr[1]);}
  if(hi==0)wsf[32+r32]=l_reg;asm volatile("s_waitcnt lgkmcnt(0)":::"memory");
  float rli[16];
  #pragma unroll
  for(int r=0;r<16;++r)rli[r]=__builtin_amdgcn_rcpf(wsf[32+crow(r,hi)]);
  bf16*Ow=O+(rowbase+q0+wid*QBLK)*OPITCH+h*D;
  { bf16*stg=(bf16*)(shm+LDS_OST)+wid*2048;
    #pragma unroll
    for(int r=0;r<16;++r){const int orow=crow(r,hi);
      #pragma unroll
      for(int d0=0;d0<2;++d0)stg[orow*64+d0*32+r32]=__float2bfloat16(o[d0][r]*rli[r]);}
    asm volatile("s_waitcnt lgkmcnt(0)":::"memory");
    #pragma unroll
    for(int i=0;i<4;++i){const int row=i*8+(lane>>3),ch=lane&7; const u32x4 v=*(const u32x4*)(stg+row*64+ch*8); ATTN_STORE16(Ow+(long)row*OPITCH+ch*8,v);} }
  asm volatile("s_waitcnt lgkmcnt(0)\n\ts_barrier":::"memory");
  #undef DMA_K
  #undef DMA_V
  #undef CMASK
  #undef START
  #undef RESC
  #undef ROT
}
#undef SBAR
#undef WAIT_BAR
}
#define LAS __attribute__((address_space(3)))
typedef unsigned short bf16u;
typedef unsigned v4u __attribute__((ext_vector_type(4)));
typedef float f32x4g __attribute__((ext_vector_type(4)));
typedef short bf16x8g __attribute__((ext_vector_type(8)));
typedef float f32x16g __attribute__((ext_vector_type(16)));

constexpr int MTOK = 65536, SEQL = 2048, DMODEL = 1024, DIN = 5632, DFF = 2816;
constexpr float NEPS = 1e-6f;
constexpr size_t MiB = 1u << 20;
constexpr size_t WS_CTL = 0, WS_ROPE = 1 * MiB, WS_KMEAN = 1 * MiB + 512 * 1024, WS_WIN = 2 * MiB, WS_WA = 13 * MiB, WS_WB = 14 * MiB, WS_WOUT = 15 * MiB, WS_WUP = 17 * MiB, WS_WDN = 28 * MiB;
constexpr size_t WS_XN = 34 * MiB, WS_OA = 34 * MiB, WS_OB = 98 * MiB, WS_BIG = 162 * MiB;
constexpr size_t WS_HG = WS_BIG, WS_QKV = WS_BIG + 256 * MiB, WS_GT = WS_BIG + 448 * MiB, WS_MIX = WS_BIG, WS_UV = WS_BIG, WS_G = WS_BIG + 352 * MiB, WS_END = WS_BIG + 704 * MiB + 24 * MiB;
constexpr size_t WS_UFIRST = WS_BIG + 704 * MiB, WS_VFIRST = WS_UFIRST + 8 * MiB, WS_ULAST = WS_UFIRST + 16 * MiB;
constexpr int RING_BYTES = 131072, MISC_OFF = RING_BYTES + 320, LDS_BYTES = 149504, XCH_OFF = RING_BYTES + 512;
constexpr int NWAVES = 8;
constexpr int CW_BAR = 4096;
constexpr size_t WS_ROWSS = 512 * 1024;

__device__ __forceinline__ unsigned f2bf(float f) { unsigned u = __builtin_bit_cast(unsigned, f); return (u + 0x7fffu + ((u >> 16) & 1u)) >> 16; }
__device__ __forceinline__ unsigned pk2(float lo, float hi) { return pg8::cvt_pk_bf16(lo, hi); }
__device__ __forceinline__ float b2f(unsigned h) { return __uint_as_float(h << 16); }
__device__ __forceinline__ float wave_sum(float v) {
#pragma unroll
    for (int o = 1; o < 64; o <<= 1) v += __shfl_xor(v, o);
    return v;
}
#define LDS_WAIT() asm volatile("s_waitcnt lgkmcnt(0)" ::: "memory")

template <int REMAP, int TILED = 0> __device__ __forceinline__ void p0_transpose_item(const float* W, int K, int N, bf16u* WT, LAS float* scr, int item, int lane, const float* kscale = nullptr) {
    const int nblk = N / 32, kb = item / nblk, nb = item % nblk, k0 = 64 * kb, n0 = 32 * nb;
    int nr = n0;
    if (REMAP == 2) { if (n0 >= 2048 && n0 < 3072) { const int o = n0 - 2048; nr = 2048 + (o & ~255) + 128 * ((o >> 5) & 1) + 32 * ((o >> 6) & 3); } }
    else if (REMAP) { nr = (n0 < DFF) ? ((n0 >> 7) * 256 + (n0 & 127)) : (((n0 - DFF) >> 7) * 256 + 128 + ((n0 - DFF) & 127)); }
    float wv_[32];
#pragma unroll
    for (int i = 0; i < 32; ++i) { const int kk = 2 * i + (lane >> 5); wv_[i] = W[(size_t)(k0 + kk) * N + n0 + (lane & 31)] * (kscale ? kscale[k0 + kk] : 1.0f); }
#pragma unroll
    for (int i = 0; i < 32; ++i) { const int kk = 2 * i + (lane >> 5); scr[kk * 33 + (lane & 31)] = wv_[i]; }
    LDS_WAIT(); asm volatile("" ::: "memory");
    const int c = lane & 7;
#pragma unroll
    for (int j = 0; j < 4; ++j) { const int n = (lane >> 3) + 8 * j; const LAS float* s = scr + (8 * c) * 33 + n;
        v4u o; o.x = pk2(s[0 * 33], s[1 * 33]); o.y = pk2(s[2 * 33], s[3 * 33]); o.z = pk2(s[4 * 33], s[5 * 33]); o.w = pk2(s[6 * 33], s[7 * 33]);
        const int row_ = nr + n;
        if (TILED) *(v4u*)(WT + (size_t)(row_ >> 8) * 256 * K + (size_t)kb * 16384 + (row_ & 255) * 64 + 8 * c) = o;
        else *(v4u*)(WT + (size_t)row_ * K + k0 + 8 * c) = o; }
    LDS_WAIT(); asm volatile("" ::: "memory");
}
template <int R, int TILED = 0> __device__ __forceinline__ void rms_rows_to_bf16(const float* xrow, const float* g, bf16u* orow, int lane, int row0 = 0) {
    const f32x4g* gr = (const f32x4g*)g + lane;
    f32x4g v[R][4]; float s[R];
#pragma unroll
    for (int r = 0; r < R; ++r) { const f32x4g* xr = (const f32x4g*)(xrow + (size_t)r * DMODEL) + lane;
#pragma unroll
        for (int j = 0; j < 4; ++j) v[r][j] = xr[64 * j]; }
#pragma unroll
    for (int r = 0; r < R; ++r) { float a = 0.f;
#pragma unroll
        for (int j = 0; j < 4; ++j) a += (v[r][j].x * v[r][j].x + v[r][j].y * v[r][j].y) + (v[r][j].z * v[r][j].z + v[r][j].w * v[r][j].w);
        s[r] = 1.0f / sqrtf(wave_sum(a) * (1.f / DMODEL) + NEPS); }
#pragma unroll
    for (int j = 0; j < 4; ++j) { const f32x4g gg = gr[64 * j];
#pragma unroll
        for (int r = 0; r < R; ++r) { unsigned long long* o8 = (unsigned long long*)(orow + (size_t)r * DMODEL) + lane;
            if (TILED) { const int m_ = row0 + r; o8 = (unsigned long long*)(orow + (size_t)(m_ >> 8) * 256 * DMODEL + (size_t)(4 * j + (lane >> 4)) * 16384 + (m_ & 255) * 64 + 4 * (lane & 15)) - 64 * j; }
            o8[64 * j] = (unsigned long long)pk2(v[r][j].x * s[r] * gg.x, v[r][j].y * s[r] * gg.y) | ((unsigned long long)pk2(v[r][j].z * s[r] * gg.z, v[r][j].w * s[r] * gg.w) << 32); } }
}

__device__ __forceinline__ void qk_one(v4u raw, const float (&g)[8], const float (&cs)[8], const float (&sn)[8], int c, float scale, float (&out)[8]) {
    float x[8];
#pragma unroll
    for (int i = 0; i < 4; ++i) { x[2 * i] = b2f(raw[i] & 0xffffu); x[2 * i + 1] = b2f(raw[i] >> 16); }
    float ss = 0.f;
#pragma unroll
    for (int e = 0; e < 8; ++e) ss += x[e] * x[e];
    ss += __shfl_xor(ss, 1); ss += __shfl_xor(ss, 2); ss += __shfl_xor(ss, 4);
    const float rstd = 1.0f / sqrtf(ss * (1.f / 64.f) + NEPS);
#pragma unroll
    for (int e = 0; e < 8; ++e) { const float y = x[e] * rstd * g[e]; const float py = __shfl_xor(y, 4);
        out[e] = ((c < 4) ? (y * cs[e] - py * sn[e]) : (y * cs[e] + py * sn[e])) * scale; }
}
__device__ __forceinline__ void qk_prep_item(int b, int kb, bf16u* QKV, const float* qg, const float* kg, const float* rope, float* kmean, LAS float* scr, int tid) {
    const int r8 = tid >> 6, cc = tid & 63, hh = cc >> 3, c = cc & 7;
    float gq[8], gk[8], ks[8];
#pragma unroll
    for (int e = 0; e < 8; ++e) { gq[e] = qg[8 * c + e]; gk[e] = kg[8 * c + e]; ks[e] = 0.f; }
    const size_t rowbase = (size_t)b * SEQL + (size_t)kb * 256;
    for (int i = 0; i < 32; ++i) {
        const int rl = i * 8 + r8, pos = kb * 256 + rl;
        bf16u* prow = QKV + (rowbase + rl) * 1536 + hh * 64 + 8 * c;
        const v4u qv = *(const v4u*)prow; const v4u kv = *(const v4u*)(prow + 512);
        const f32x4g* tp = (const f32x4g*)(rope + ((size_t)pos * 32 + 8 * (c & 3)) * 2);
        float cs[8], sn[8];
#pragma unroll
        for (int j = 0; j < 4; ++j) { const f32x4g t = tp[j]; cs[2 * j] = t.x; sn[2 * j] = t.y; cs[2 * j + 1] = t.z; sn[2 * j + 1] = t.w; }
        float oq[8], ok[8];
        qk_one(qv, gq, cs, sn, c, 0.125f * 1.4426950408889634f, oq);
        qk_one(kv, gk, cs, sn, c, 1.0f, ok);
#pragma unroll
        for (int e = 0; e < 8; ++e) ks[e] += ok[e];
        v4u wq, wk;
#pragma unroll
        for (int j = 0; j < 4; ++j) { wq[j] = pk2(oq[2 * j], oq[2 * j + 1]); wk[j] = pk2(ok[2 * j], ok[2 * j + 1]); }
        *(v4u*)prow = wq; *(v4u*)(prow + 512) = wk;
    }
#pragma unroll
    for (int e = 0; e < 8; ++e) scr[(r8 * 64 + cc) * 8 + e] = ks[e];
    __syncthreads();
    { const int col = tid; float s = 0.f;
#pragma unroll
      for (int r = 0; r < 8; ++r) s += scr[(r * 64 + (col >> 3)) * 8 + (col & 7)];
      kmean[(((size_t)b * 8 + (col >> 6)) * 8 + kb) * 64 + (col & 63)] = s * (1.f / 256.f); }
    __syncthreads();
}

constexpr int H_QS = 136, H_SS = 72;
constexpr int L_QE = 0, L_KE = 17408, L_KET = 34816, L_VT = 53248, L_STP = 71680, L_A = 106496, L_TOT = 115712, L_SSB = 117760;
__device__ __forceinline__ int crowg(int r, int hi) { return (r & 3) + 8 * (r >> 2) + 4 * hi; }
#define MFMA32(a, b, c) __builtin_amdgcn_mfma_f32_32x32x16_bf16((a), (b), (c), 0, 0, 0)
#define HBAR() asm volatile("s_waitcnt lgkmcnt(0)\n\ts_barrier" ::: "memory")
__device__ __forceinline__ void hgrn_unit(int item, const bf16u* HG, const float* onorm_g, bf16u* OA, LAS unsigned char* lds, int tid) {
    asm volatile("" : "+v"(tid));
    const int b = item >> 2, h = item & 3;
    const int lane = tid & 63, w = __builtin_amdgcn_readfirstlane(tid >> 6), l31 = lane & 31, hi = lane >> 5;
    const int k = tid & 127, seg = tid >> 7;
    const int vb = w >> 1, tb = w & 1;
    LAS bf16u* QE = (LAS bf16u*)(lds + L_QE); LAS bf16u* KE = (LAS bf16u*)(lds + L_KE); LAS bf16u* KET = (LAS bf16u*)(lds + L_KET);
    LAS bf16u* VT = (LAS bf16u*)(lds + L_VT); LAS bf16u* STP = (LAS bf16u*)(lds + L_STP); LAS bf16u* AL = (LAS bf16u*)(lds + L_A);
    LAS float* TOT = (LAS float*)(lds + L_TOT); LAS float* SSB = (LAS float*)(lds + L_SSB);
    f32x16g st[2];
#pragma unroll
    for (int j = 0; j < 2; ++j)
#pragma unroll
        for (int r = 0; r < 16; ++r) st[j][r] = 0.f;
    unsigned rq[16], rl[16]; v4u rv[2];
#define HLOAD(cc) do { const size_t r0_ = (size_t)b * SEQL + (size_t)(cc) * 64; const bf16u* pq_ = HG + (r0_ + seg * 16) * 2048 + h * 128 + k; \
        _Pragma("unroll") for (int i = 0; i < 16; ++i) { rq[i] = pq_[(size_t)i * 2048]; rl[i] = pq_[(size_t)i * 2048 + 512]; } \
        _Pragma("unroll") for (int j = 0; j < 2; ++j) { const int id_ = tid + 512 * j; rv[j] = *(const v4u*)(HG + (r0_ + (id_ >> 4)) * 2048 + 1024 + h * 128 + (id_ & 15) * 8); } } while (0)
    HLOAD(0);
    for (int c = 0; c < 32; ++c) {
        const size_t row0 = (size_t)b * SEQL + (size_t)c * 64;
        v4u gvv[2];
#pragma unroll
        for (int j = 0; j < 2; ++j) { const int id = tid + 512 * j; gvv[j] = *(const v4u*)(HG + (row0 + (id >> 4)) * 2048 + 1536 + h * 128 + (id & 15) * 8); }
        float lf[16], qv[16], cs[16];
#pragma unroll
        for (int i = 0; i < 16; ++i) { qv[i] = b2f(rq[i]); lf[i] = b2f(rl[i]); }
        { float run = 0.f;
#pragma unroll
          for (int i = 0; i < 16; ++i) { run += lf[i]; cs[i] = run; }
          TOT[seg * 128 + k] = run; }
#pragma unroll
        for (int j = 0; j < 2; ++j) { const int id = tid + 512 * j, s = id >> 4, v0 = (id & 15) * 8; const v4u vv = rv[j];
            *(LAS v4u*)(VT + s * H_QS + v0) = vv; }
        if (c + 1 < 32) HLOAD(c + 1);
        HBAR();
        { const float t0 = TOT[k], t1 = TOT[128 + k], t2 = TOT[256 + k];
          const float mm = t0 + t1; const float p = (seg == 0) ? 0.f : (seg == 1) ? t0 : (seg == 2) ? mm : (mm + t2);
          unsigned kt[8];
#pragma unroll
          for (int ip = 0; ip < 8; ++ip) { const int s = seg * 16 + 2 * ip; const float c0 = p + cs[2 * ip], c1 = p + cs[2 * ip + 1];
              const float f0 = __expf(lf[2 * ip]), f1 = __expf(lf[2 * ip + 1]);
              const float qe0 = qv[2 * ip] * __expf(c0 - mm), qe1 = qv[2 * ip + 1] * __expf(c1 - mm), ke0 = (1.0f - f0) * __expf(mm - c0), ke1 = (1.0f - f1) * __expf(mm - c1);
              const unsigned pq = pk2(qe0, qe1), pk = pk2(ke0, ke1);
              QE[s * H_QS + k] = (bf16u)pq; QE[(s + 1) * H_QS + k] = (bf16u)(pq >> 16); KE[s * H_QS + k] = (bf16u)pk; KE[(s + 1) * H_QS + k] = (bf16u)(pk >> 16);
              kt[ip] = pk; }
          *(LAS v4u*)(KET + k * H_SS + seg * 16) = (v4u){kt[0], kt[1], kt[2], kt[3]};
          *(LAS v4u*)(KET + k * H_SS + seg * 16 + 8) = (v4u){kt[4], kt[5], kt[6], kt[7]}; }
#pragma unroll
        for (int j = 0; j < 2; ++j) { const int kk = (2 * (w & 1) + j) * 32 + l31; const float em = __expf(TOT[kk] + TOT[128 + kk]);
#pragma unroll
            for (int r = 0; r < 16; r += 2) { const unsigned pp = pk2(st[j][r] * em, st[j][r + 1] * em); const int v = vb * 32 + crowg(r, hi); STP[v * H_QS + kk] = (bf16u)pp; STP[(v + 1) * H_QS + kk] = (bf16u)(pp >> 16); } }
        HBAR();
        f32x16g o;
#pragma unroll
        for (int r = 0; r < 16; ++r) o[r] = 0.f;
#pragma unroll
        for (int ks = 0; ks < 8; ++ks) { const bf16x8g a = *(const LAS bf16x8g*)(STP + (vb * 32 + l31) * H_QS + ks * 16 + 8 * hi);
            const bf16x8g bq = *(const LAS bf16x8g*)(QE + (tb * 32 + l31) * H_QS + ks * 16 + 8 * hi); o = MFMA32(a, bq, o); }
        if (w < 4) { const int sb = vb; f32x16g A;
#pragma unroll
            for (int r = 0; r < 16; ++r) A[r] = 0.f;
            if (!(sb == 1 && tb == 0)) {
#pragma unroll
                for (int ks = 0; ks < 8; ++ks) { const bf16x8g a = *(const LAS bf16x8g*)(KE + (sb * 32 + l31) * H_QS + ks * 16 + 8 * hi);
                    const bf16x8g bq = *(const LAS bf16x8g*)(QE + (tb * 32 + l31) * H_QS + ks * 16 + 8 * hi); A = MFMA32(a, bq, A); } }
            const int t = tb * 32 + l31;
#pragma unroll
            for (int g = 0; g < 4; ++g) { const int s0 = sb * 32 + 8 * g + 4 * hi;
                const float a0 = (s0 + 0 <= t) ? A[4 * g + 0] : 0.f, a1 = (s0 + 1 <= t) ? A[4 * g + 1] : 0.f, a2 = (s0 + 2 <= t) ? A[4 * g + 2] : 0.f, a3 = (s0 + 3 <= t) ? A[4 * g + 3] : 0.f;
                typedef unsigned u2v __attribute__((ext_vector_type(2)));
                *(LAS u2v*)(AL + t * H_SS + s0) = (u2v){pk2(a0, a1), pk2(a2, a3)}; } }
        HBAR();
        { bf16x8g av[4];
#pragma unroll
          for (int ss = 0; ss < 4; ++ss)
#pragma unroll
              for (int e = 0; e < 8; ++e) av[ss][e] = (short)VT[(ss * 16 + 8 * hi + e) * H_QS + vb * 32 + l31];
#pragma unroll
          for (int ss = 0; ss < 4; ++ss) { const bf16x8g ba = *(const LAS bf16x8g*)(AL + (tb * 32 + l31) * H_SS + ss * 16 + 8 * hi); o = MFMA32(av[ss], ba, o); }
#pragma unroll
          for (int j = 0; j < 2; ++j) { const int kk = (2 * (w & 1) + j) * 32 + l31; f32x16g W;
#pragma unroll
              for (int r = 0; r < 16; ++r) W[r] = 0.f;
#pragma unroll
              for (int ss = 0; ss < 4; ++ss) { const bf16x8g bk = *(const LAS bf16x8g*)(KET + kk * H_SS + ss * 16 + 8 * hi); W = MFMA32(av[ss], bk, W); }
              const float mk = TOT[kk] + TOT[128 + kk], lastk = mk + TOT[256 + kk] + TOT[384 + kk];
              const float el = __expf(lastk), elm = __expf(lastk - mk);
#pragma unroll
              for (int r = 0; r < 16; ++r) st[j][r] = el * st[j][r] + elm * W[r]; } }
        { float q = 0.f;
#pragma unroll
          for (int r = 0; r < 16; ++r) q += o[r] * o[r];
          q += __shfl_xor(q, 32);
          if (hi == 0) SSB[vb * 64 + tb * 32 + l31] = q; }
        HBAR();
        { const int t = tb * 32 + l31; const float tot = (SSB[t] + SSB[64 + t]) + (SSB[128 + t] + SSB[192 + t]);
          const float rstd = 1.0f / sqrtf(tot * (1.f / 128.f) + NEPS);
#pragma unroll
          for (int g = 0; g < 4; ++g) { typedef unsigned u2w __attribute__((ext_vector_type(2)));
              *(LAS u2w*)(QE + t * H_QS + vb * 32 + 8 * g + 4 * hi) = (u2w){pk2(o[4 * g] * rstd, o[4 * g + 1] * rstd), pk2(o[4 * g + 2] * rstd, o[4 * g + 3] * rstd)}; } }
        HBAR();
#pragma unroll
        for (int j = 0; j < 2; ++j) { const int id = tid + 512 * j, t = id >> 4, v0 = (id & 15) * 8;
            const v4u ov = *(const LAS v4u*)(QE + t * H_QS + v0);
            const v4u gv = gvv[j];
            const f32x4g g0 = *(const f32x4g*)(onorm_g + h * 128 + v0), g1 = *(const f32x4g*)(onorm_g + h * 128 + v0 + 4);
            const float gn[8] = {g0.x, g0.y, g0.z, g0.w, g1.x, g1.y, g1.z, g1.w};
            v4u wv;
#pragma unroll
            for (int i = 0; i < 4; ++i) wv[i] = pk2(b2f(ov[i] & 0xffffu) * gn[2 * i] * b2f(gv[i] & 0xffffu), b2f(ov[i] >> 16) * gn[2 * i + 1] * b2f(gv[i] >> 16));
            *(v4u*)(OA + (row0 + t) * 512 + h * 128 + v0) = wv; }
        HBAR();
    }
}

#undef HLOAD
#define GAS __attribute__((address_space(1)))
typedef GAS unsigned gu32;
#define XB_TMO      128
#define XB_XCNT(j)  (256  + 64 * (j))
#define XB_XSUB(j)  (1280 + 64 * (j))
#define XB_XGEN(j)  (2304 + 64 * (j))
#define XB_TOP      3328
#define XB_TOPGEN   3392
#define XCD_BAR_WORDS 3456
#define XB_SPIN_CAP (1u << 18)

__device__ __forceinline__ unsigned xb_ld(unsigned* p)              { return __hip_atomic_load(p, __ATOMIC_RELAXED, __HIP_MEMORY_SCOPE_AGENT); }
__device__ __forceinline__ unsigned xb_add(unsigned* p, unsigned v) { return __hip_atomic_fetch_add(p, v, __ATOMIC_RELAXED, __HIP_MEMORY_SCOPE_AGENT); }
__device__ __forceinline__ unsigned xb_xcc_id() { return (unsigned)__builtin_amdgcn_s_getreg((3 << 11) | 20) & 0xFu; }
#define XB_SPIN(cond, bar) do { unsigned _sp = 0; while (cond) { __builtin_amdgcn_s_sleep(1); \
    if ((++_sp & 255u) == 0u) { if (xb_ld(&(bar)[XB_TMO])) break; if (_sp > XB_SPIN_CAP) { atomicAdd(&(bar)[XB_TMO], 1u); break; } } } } while (0)

struct XcdBarrier {
    unsigned* bar; unsigned x;
    volatile LAS unsigned* st;
};

__device__ __forceinline__ XcdBarrier xcd_barrier_post(unsigned* bar, volatile LAS unsigned* st) {
    XcdBarrier b; b.bar = bar; b.x = xb_xcc_id(); b.st = st;
    if (threadIdx.x == 0) (void)xb_add(&bar[XB_XCNT(b.x)], 1u);
    return b;
}
__device__ __forceinline__ void xcd_barrier_complete(unsigned* bar, unsigned x, unsigned& nloc, unsigned& nx) {
    const unsigned G = gridDim.x * gridDim.y * gridDim.z;
    unsigned sum, cnt, mine, sp = 0u;
    for (;;) {
        sum = 0u; cnt = 0u; mine = 0u;
#pragma unroll
        for (unsigned j = 0; j < 16; ++j) { const unsigned c = xb_ld(&bar[XB_XCNT(j)]); sum += c; cnt += (c > 0u) ? 1u : 0u; mine = (j == x) ? c : mine; }
        if (sum == G) break;
        __builtin_amdgcn_s_sleep(1);
        if ((++sp & 255u) == 0u) { if (xb_ld(&bar[XB_TMO])) break; if (sp > XB_SPIN_CAP) { atomicAdd(&bar[XB_TMO], 1u); break; } }
    }
    nloc = mine > 0u ? mine : 1u; nx = cnt > 0u ? cnt : 1u;
}

__device__ __forceinline__ void xcd_barrier(const XcdBarrier& b) {
    asm volatile("s_waitcnt vmcnt(0)" ::: "memory");
    __syncthreads();
    if (threadIdx.x == 0) {
        unsigned* bar = b.bar;
        __builtin_amdgcn_s_waitcnt(0);
        unsigned nloc = b.st[0], nx = b.st[1];
        if (nloc == 0u) { xcd_barrier_complete(bar, b.x, nloc, nx); b.st[0] = nloc; b.st[1] = nx; }
        const unsigned old = xb_add(&bar[XB_XSUB(b.x)], 1u);
        const unsigned gen = old / nloc;
        if (old + 1u == (gen + 1u) * nloc) {
            __builtin_amdgcn_fence(__ATOMIC_RELEASE, "agent");
            asm volatile("s_waitcnt vmcnt(0)" ::: "memory");
            const unsigned og = xb_add(&bar[XB_TOP], 1u);
            const unsigned tg = og / nx;
            if (og + 1u == (tg + 1u) * nx) xb_add(&bar[XB_TOPGEN], 1u);
            else XB_SPIN(xb_ld(&bar[XB_TOPGEN]) == tg, bar);
            __builtin_amdgcn_fence(__ATOMIC_ACQUIRE, "agent");
            xb_add(&bar[XB_XGEN(b.x)], 1u);
            asm volatile("s_waitcnt vmcnt(0)" ::: "memory");
        } else {
            XB_SPIN(xb_ld(&bar[XB_XGEN(b.x)]) == gen, bar);
            __builtin_amdgcn_fence(__ATOMIC_ACQUIRE, "agent");
            asm volatile("s_waitcnt vmcnt(0)" ::: "memory");
        }
    }
    __syncthreads();
}

struct Args { const float* in[15]; float* out; unsigned char* ws; };
__global__ void __launch_bounds__(NWAVES * 64, 2) fwd_kernel(Args args) {
    extern __shared__ __attribute__((aligned(16))) unsigned char lds_raw[];
    cg::grid_group grid = cg::this_grid();
    LAS unsigned char* lds = (LAS unsigned char*)lds_raw;
    const int G = gridDim.x, bx = blockIdx.x;
    if (threadIdx.x < 32) ((volatile LAS unsigned*)(lds + MISC_OFF))[threadIdx.x] = 0u;
    __syncthreads();
#define PHASE_IDS int tid = threadIdx.x; asm volatile("" : "+v"(tid)); const int lane = tid & 63, wave = __builtin_amdgcn_readfirstlane(tid >> 6); const int gw = bx * NWAVES + wave, NGW = G * NWAVES; const int gt = bx * (NWAVES * 64) + tid, NGT = G * NWAVES * 64; (void)lane; (void)gw; (void)NGW; (void)gt; (void)NGT;
#define ws (args.ws)
#define X_IN (args.in[0])
#define norm1_g (args.in[1])
#define w_in (args.in[2])
#define lb_logits (args.in[3])
#define onorm_g (args.in[4])
#define qn_g (args.in[5])
#define kn_g (args.in[6])
#define w_a (args.in[7])
#define w_b (args.in[8])
#define w_out (args.in[9])
#define norm2_g (args.in[10])
#define w_up (args.in[11])
#define conv_w (args.in[12])
#define conv_b (args.in[13])
#define w_down (args.in[14])
#define OUT_P (args.out)
#define ctl ((unsigned*)(ws + WS_CTL))
#define rope ((float*)(ws + WS_ROPE))
#define kmean ((float*)(ws + WS_KMEAN))
#define Win_t ((bf16u*)(ws + WS_WIN))
#define Wa_t ((bf16u*)(ws + WS_WA))
#define Wb_t ((bf16u*)(ws + WS_WB))
#define Wout_t ((bf16u*)(ws + WS_WOUT))
#define Wup_t ((bf16u*)(ws + WS_WUP))
#define Wdn_t ((bf16u*)(ws + WS_WDN))
#define XN ((bf16u*)(ws + WS_XN))
#define OA ((bf16u*)(ws + WS_OA))
#define OB ((bf16u*)(ws + WS_OB))
#define HG ((bf16u*)(ws + WS_HG))
#define QKV ((bf16u*)(ws + WS_QKV))
#define GT ((bf16u*)(ws + WS_GT))
#define MIX ((bf16u*)(ws + WS_MIX))
#define UV ((bf16u*)(ws + WS_UV))
#define GB ((bf16u*)(ws + WS_G))

    { PHASE_IDS
        LAS float* scr = (LAS float*)(lds + wave * 16384);
        constexpr int I_IN = (DMODEL / 64) * (DIN / 32), I_A = (512 / 64) * (DMODEL / 32), I_OUT = (DMODEL / 64) * (DMODEL / 32), I_DN = (DFF / 64) * (DMODEL / 32);
        constexpr int NITEMS = 2 * I_IN + 2 * I_A + I_OUT + I_DN;
        for (int it = gw; it < NITEMS; it += NGW) {
            int r = it;
            if (r < I_IN) { p0_transpose_item<2, 1>(w_in, DMODEL, DIN, Win_t, scr, r, lane); continue; } r -= I_IN;
            if (r < I_IN) { p0_transpose_item<1>(w_up, DMODEL, DIN, Wup_t, scr, r, lane, norm2_g); continue; } r -= I_IN;
            if (r < I_A) { p0_transpose_item<0>(w_a, 512, DMODEL, Wa_t, scr, r, lane); continue; } r -= I_A;
            if (r < I_A) { p0_transpose_item<0>(w_b, 512, DMODEL, Wb_t, scr, r, lane); continue; } r -= I_A;
            if (r < I_OUT) { p0_transpose_item<0>(w_out, DMODEL, DMODEL, Wout_t, scr, r, lane); continue; } r -= I_OUT;
            p0_transpose_item<0>(w_down, DFF, DMODEL, Wdn_t, scr, r, lane);
        }
        for (int m = gw * 4; m < MTOK; m += NGW * 4) rms_rows_to_bf16<4, 1>(X_IN + (size_t)m * DMODEL, norm1_g, XN, lane, m);
        for (int e = gt; e < SEQL * 32; e += NGT) { const int pos = e >> 5, i = e & 31;
            const float inv = 1.0f / exp2f((float)i * (13.287712379549449f / 32.0f));
            const float ang = (float)pos * inv; float rv = ang * 0.15915494309189535f; rv -= floorf(rv);
            rope[2 * e] = __builtin_amdgcn_cosf(rv); rope[2 * e + 1] = __builtin_amdgcn_sinf(rv); }
        if (gt == 0) ctl[0] = 0u;
        for (int e = gt; e < MTOK; e += NGT) ((float*)(ws + WS_ROWSS))[e] = 0.f;
        for (int e = gt; e < 32 * 8 * 8 * 64; e += NGT) kmean[e] = 0.f;
        if (bx == 0) for (int i = tid; i < XCD_BAR_WORDS; i += NWAVES * 64) ctl[CW_BAR + i] = 0u;
    }
    grid.sync();
    XcdBarrier xbar = xcd_barrier_post(ctl + CW_BAR, (volatile LAS unsigned*)(lds + MISC_OFF) + 8);

    {
        pg8::Gemm g{XN, Win_t, MTOK, DIN, DMODEL}; pg8::StaticOrder S; S.init(MTOK, DIN, G, bx);
        pg8::EpiInProj E{HG, QKV, GT, lb_logits, qn_g, kn_g, rope, kmean};
        pg8::gemm_phase<pg8::EpiInProj, pg8::StaticOrder, PG8_ALIGN, PG8_SP2, true>(lds, g, S, E);
    }
    xcd_barrier(xbar);

    { PHASE_IDS
        volatile LAS unsigned* MISC = (volatile LAS unsigned*)(lds + MISC_OFF);
        for (;;) {
            if (tid == 0) MISC[0] = __hip_atomic_fetch_add(ctl, 1u, __ATOMIC_RELAXED, __HIP_MEMORY_SCOPE_AGENT);
            __syncthreads();
            const int item = (int)MISC[0];
            __syncthreads();
            if (item >= 128 + 2048) break;
            if (item < 128) hgrn_unit(item, HG, onorm_g, OA, lds, tid);
            else { const int j = item - 128, qb = 7 - (j >> 8), bh = j & 255;
                attn_body::attn_unit<8>(bh >> 3, bh & 7, qb, (const attn_body::bf16*)QKV, (const attn_body::bf16*)(QKV + 512), (const attn_body::bf16*)(QKV + 1024), (attn_body::bf16*)OB, kmean, (char*)lds_raw); }
        }
    }
    xcd_barrier(xbar);

    {
        pg8::Gemm g{OA, Wa_t, MTOK, DMODEL, 512}; pg8::StaticOrder S; S.init(MTOK, DMODEL, G, bx);
        pg8::EpiGateMix<0> E{MIX, GT};
        pg8::gemm_phase<pg8::EpiGateMix<0>, pg8::StaticOrder, PG8_ALIGN, PG8_SP2>(lds, g, S, E);
    }
    {
        pg8::Gemm g{OB, Wb_t, MTOK, DMODEL, 512}; pg8::StaticOrder S; S.init(MTOK, DMODEL, G, bx);
        pg8::EpiGateMix<1> E{MIX, GT + 1024};
        pg8::gemm_phase<pg8::EpiGateMix<1>, pg8::StaticOrder, PG8_ALIGN, PG8_SP2>(lds, g, S, E);
    }
    xcd_barrier(xbar);

    {
        pg8::Gemm g{MIX, Wout_t, MTOK, DMODEL, DMODEL}; pg8::StaticOrder S; S.init(MTOK, DMODEL, G, bx);
        pg8::EpiResNorm E{X_IN, OUT_P, XN, (float*)(ws + WS_ROWSS)};
        pg8::gemm_phase<pg8::EpiResNorm, pg8::StaticOrder, PG8_ALIGN, PG8_SP2>(lds, g, S, E);
    }
    xcd_barrier(xbar);

    {
        pg8::Gemm g{XN, Wup_t, MTOK, DIN, DMODEL}; pg8::StaticOrder S; S.init(MTOK, DIN, G, bx);
        pg8::EpiUpConv E{GB, conv_w, conv_b, (float*)(ws + WS_UFIRST), (float*)(ws + WS_VFIRST), (float*)(ws + WS_ULAST), (LAS float*)(lds + XCH_OFF), (const float*)(ws + WS_ROWSS)};
        pg8::gemm_phase<pg8::EpiUpConv, pg8::StaticOrder, true, PG8_SP2>(lds, g, S, E);
    }
    xcd_barrier(xbar);
    { PHASE_IDS
        const float* ufirst = (const float*)(ws + WS_UFIRST); const float* vfirst = (const float*)(ws + WS_VFIRST); const float* ulast = (const float*)(ws + WS_ULAST);
        for (int idx = gt; idx < 256 * 2 * 352; idx += NGT) {
            const int pm = idx / 704, rem = idx - pm * 704, j = rem / 352, c0 = (rem - j * 352) * 8; const bool seq0 = (pm & 7) == 0;
            v4u wv;
#pragma unroll
            for (int i = 0; i < 4; ++i) { float rr[2];
#pragma unroll
                for (int hh = 0; hh < 2; ++hh) { const int c = c0 + 2 * i + hh;
                    const float uc = ufirst[(size_t)(pm * 2 + j) * DFF + c];
                    float um1, um2;
                    if (j == 0) { um1 = seq0 ? 0.f : ulast[(size_t)((pm - 1) * 2 + 1) * DFF + c]; um2 = seq0 ? 0.f : ulast[(size_t)((pm - 1) * 2 + 0) * DFF + c]; }
                    else { um1 = ufirst[(size_t)(pm * 2 + 0) * DFF + c]; um2 = seq0 ? 0.f : ulast[(size_t)((pm - 1) * 2 + 1) * DFF + c]; }
                    rr[hh] = conv_b[c] + conv_w[c] * um2 + conv_w[DFF + c] * um1 + conv_w[2 * DFF + c] * uc; }
                const pg8::f32x2 gl = pg8::gelu_pk((pg8::f32x2){rr[0], rr[1]});
                wv[i] = pk2(gl.x * vfirst[(size_t)(pm * 2 + j) * DFF + c0 + 2 * i], gl.y * vfirst[(size_t)(pm * 2 + j) * DFF + c0 + 2 * i + 1]); }
            *(v4u*)(GB + (size_t)(pm * 256 + j) * DFF + c0) = wv;
        }
    }
    xcd_barrier(xbar);

    {
        pg8::Gemm g{GB, Wdn_t, MTOK, DMODEL, DFF}; pg8::StaticOrder S; S.init(MTOK, DMODEL, G, bx);
        pg8::EpiResF32 E{OUT_P, OUT_P, DMODEL};
        pg8::gemm_phase<pg8::EpiResF32, pg8::StaticOrder, PG8_ALIGN, PG8_SP2>(lds, g, S, E);
    }
}

#undef ws
#undef X_IN
#undef norm1_g
#undef w_in
#undef lb_logits
#undef onorm_g
#undef qn_g
#undef kn_g
#undef w_a
#undef w_b
#undef w_out
#undef norm2_g
#undef w_up
#undef conv_w
#undef conv_b
#undef w_down
#undef OUT_P
#undef ctl
#undef rope
#undef kmean
#undef Win_t
#undef Wa_t
#undef Wb_t
#undef Wout_t
#undef Wup_t
#undef Wdn_t
#undef XN
#undef OA
#undef OB
#undef HG
#undef QKV
#undef GT
#undef MIX
#undef UV
#undef GB
extern "C" void kernel_launch(void* const* d_in, const int* in_sizes, int n_in, void* d_out, int out_size, void* d_ws, size_t ws_size, hipStream_t stream) {
    static int grid = 0;
    if (grid == 0) {
        if (n_in != 15 || out_size != MTOK * DMODEL || ws_size < WS_END) { fprintf(stderr, "kernel_launch: unexpected shapes (n_in %d out %d ws %zu)\n", n_in, out_size, ws_size); grid = -1; return; }
        int dev = 0, cus = 0, per_cu = 0;
        (void)hipGetDevice(&dev); (void)hipDeviceGetAttribute(&cus, hipDeviceAttributeMultiprocessorCount, dev);
        if (hipFuncSetAttribute((const void*)fwd_kernel, hipFuncAttributeMaxDynamicSharedMemorySize, LDS_BYTES) != hipSuccess) { fprintf(stderr, "kernel_launch: hipFuncSetAttribute failed\n"); grid = -1; return; }
        if (hipOccupancyMaxActiveBlocksPerMultiprocessor(&per_cu, (const void*)fwd_kernel, NWAVES * 64, LDS_BYTES) != hipSuccess || per_cu < 1) per_cu = 1;
        (void)hipGetLastError();
        grid = cus * 1;
        if (grid <= 0) grid = 256;
    }
    if (grid < 0) return;
    Args a{};
    for (int i = 0; i < 15; ++i) a.in[i] = (const float*)d_in[i];
    a.out = (float*)d_out; a.ws = (unsigned char*)d_ws;
    void* kargs[] = {&a};
    hipError_t e = hipLaunchCooperativeKernel((const void*)fwd_kernel, dim3(grid), dim3(NWAVES * 64), kargs, LDS_BYTES, stream);
    if (e != hipSuccess) fprintf(stderr, "kernel_launch: cooperative launch failed: %s (grid %d)\n", hipGetErrorString(e), grid);
}
```

```cpp
#include <hip/hip_runtime.h>
#include <hip/hip_cooperative_groups.h>
#include <cstdio>
#include <cstdint>
#include <type_traits>
namespace cg = cooperative_groups;
namespace pg8 {
#define PG8_LAS __attribute__((address_space(3)))
typedef unsigned short bf16_t;
typedef short bf16x8 __attribute__((ext_vector_type(8)));
typedef float f32x4 __attribute__((ext_vector_type(4)));
typedef unsigned u32x4 __attribute__((ext_vector_type(4)));
constexpr int BM = 256, BK = 64, HALF = 128, HTB = HALF * BK * 2  , STAGE_BYTES = 8 * HTB, NXCD = 8, WGM = 8;

__host__ __device__ __forceinline__ int lds_byte(int r, int c) { const int st = (r >> 4) * 2 + (c >> 5), rr = r & 15, cc = c & 31, ob = rr * 64 + cc * 2; return st * 1024 + (ob ^ (((ob >> 9) & 1) << 5)); }
__host__ __device__ __forceinline__ void stage_rc(int b, int& R, int& C) { const int st = b / 1024, sb = b % 1024, swz = sb ^ (((sb >> 9) & 1) << 5); R = (st >> 1) * 16 + swz / 64; C = (st & 1) * 32 + (swz % 64) / 2; }
__host__ __device__ __forceinline__ int perm32(int rho) { const int n = rho >> 4, i = rho & 15; return 8 * (i >> 2) + 4 * n + (i & 3); }

struct Unit { int pm, pn; };
struct Gemm { const bf16_t* A; const bf16_t* Bt; int M, N, K; };

struct StaticOrder {
    int nM, nN, nwg, G, c;
    __host__ __device__ void init(int M, int N, int G_, int c_) { nM = M / BM; nN = N / BM; nwg = nM * nN; G = G_; c = c_; }
    __host__ __device__ bool next(int i, Unit& u) const {
        const long L = (long)i * G + c; if (L >= nwg) return false;
        int wgid = (int)L; { const int q = nwg / NXCD, r = nwg % NXCD, xcd = wgid % NXCD, off = wgid / NXCD; wgid = (xcd < r ? xcd * (q + 1) : r * (q + 1) + (xcd - r) * q) + off; }
        const int nig = WGM * nN, gid = wgid / nig, fm = gid * WGM, gsz = (nM - fm) < WGM ? (nM - fm) : WGM;
        u.pm = fm + ((wgid % nig) % gsz); u.pn = (wgid % nig) / gsz; return true;
    }
    __device__ __forceinline__ void a_ready(const Unit&) const {}
    __device__ __forceinline__ void done(const Unit&) const {}
};

typedef float cvt_f32x2_t __attribute__((ext_vector_type(2))); typedef __bf16 cvt_bf16x2_t __attribute__((ext_vector_type(2)));
__device__ __forceinline__ unsigned cvt_pk_bf16(float lo, float hi) { const cvt_f32x2_t v = {lo, hi}; return __builtin_bit_cast(unsigned, __builtin_convertvector(v, cvt_bf16x2_t)); }
typedef float f32x2 __attribute__((ext_vector_type(2)));
__device__ __forceinline__ f32x2 gelu_pk(f32x2 v) {
    const f32x2 av = __builtin_elementwise_abs(v), d = av * 0.2316418882f + 1.0f;
    f32x2 t; t.x = __builtin_amdgcn_rcpf(d.x); t.y = __builtin_amdgcn_rcpf(d.y);
    f32x2 q = t * 0.5307027145f + (-0.7265760135f); q = q * t + 0.7107068705f; q = q * t + (-0.142248368f); q = q * t + 0.127414796f; q = q * t;
    const f32x2 s = (v * v) * (-0.72134752044f);
    f32x2 e; e.x = __builtin_amdgcn_exp2f(s.x); e.y = __builtin_amdgcn_exp2f(s.y);
    const f32x2 m = v * (q * e), r = v - m;
    f32x2 o; o.x = v.x < 0.f ? m.x : r.x; o.y = v.y < 0.f ? m.y : r.y; return o;
}

template <int ACT  > struct EpiBf16 {
    static constexpr bool PERM = true, AFTER_DRAIN = false; static_assert(ACT == 0 || ACT == 1, "EpiBf16: ACT is 0 (none) or 1 (gelu_pk)");
    bf16_t* O; int ldc; const float* bias; int split_cols; size_t split_stride; float scale0;
    __device__ __forceinline__ void operator()(const f32x4 (&acc)[2][2][4][2], const Unit& u, int wr, int wc, int fr, int fq) const {
        const int row0 = u.pm * BM + wr * 64 + fr; int colt = u.pn * BM; bf16_t* base = O;
        float sc = 1.f; if (split_cols) { const int t = colt / split_cols; base += (size_t)t * split_stride; colt -= t * split_cols; if (t == 0) sc = scale0; }
        const int col0 = colt + wc * 32 + 8 * fq, bcol0 = u.pn * BM + wc * 32 + 8 * fq;
        f32x4 bv[2][2];
#pragma unroll
        for (int bj = 0; bj < 2; ++bj)
#pragma unroll
            for (int n = 0; n < 2; ++n) bv[bj][n] = bias ? *(const f32x4*)(bias + bcol0 + bj * HALF + 4 * n) : (f32x4){0.f, 0.f, 0.f, 0.f};
#pragma unroll
        for (int ai = 0; ai < 2; ++ai)
#pragma unroll
            for (int m = 0; m < 4; ++m) { bf16_t* rowp = base + (size_t)(row0 + ai * HALF + m * 16) * ldc + col0;
#pragma unroll
                for (int bj = 0; bj < 2; ++bj) { f32x4 v0 = acc[ai][bj][m][0] + bv[bj][0], v1 = acc[ai][bj][m][1] + bv[bj][1];
                    if (ACT == 1) { f32x2 a = gelu_pk((f32x2){v0[0], v0[1]}), b = gelu_pk((f32x2){v0[2], v0[3]}), c = gelu_pk((f32x2){v1[0], v1[1]}), d = gelu_pk((f32x2){v1[2], v1[3]});
                        v0 = (f32x4){a.x, a.y, b.x, b.y}; v1 = (f32x4){c.x, c.y, d.x, d.y}; }
                    v0 = v0 * sc; v1 = v1 * sc; u32x4 w; w.x = cvt_pk_bf16(v0[0], v0[1]); w.y = cvt_pk_bf16(v0[2], v0[3]); w.z = cvt_pk_bf16(v1[0], v1[1]); w.w = cvt_pk_bf16(v1[2], v1[3]);
                    *(u32x4*)(rowp + bj * HALF) = w; } }
    }
};
__device__ __forceinline__ float bf2f(unsigned h) { return __uint_as_float(h << 16); }
__device__ __forceinline__ float sigm(float x) { return __builtin_amdgcn_rcpf(1.0f + __expf(-x)); }
struct EpiInProj {
    static constexpr bool PERM = true, AFTER_DRAIN = false;
    bf16_t* HG; bf16_t* QKV; bf16_t* GT; const float* lbl;
    const float* qg; const float* kg; const float* rope; float* kmean;
    __device__ __forceinline__ void operator()(const f32x4 (&acc)[2][2][4][2], const Unit& u, int wr, int wc, int fr, int fq) const {
        const int row0 = u.pm * BM + wr * 64 + fr; const int colt = u.pn * BM; const int seg = colt >> 9;
        bf16_t* base; int ldc, cb, mode;
        if (seg < 4) { base = HG; ldc = 2048; cb = colt; mode = (seg == 1) ? 1 : (seg == 2 ? 2 : 0); }
        else if (seg < 7) { base = QKV; ldc = 1536; cb = colt - 2048; mode = 2; }
        else { base = GT; ldc = 2048; cb = colt - 3584; mode = 3; }
        if (seg == 4 || seg == 5) {
            const bool isq = (seg == 4); const float* gn = isq ? qg : kg; const float sc = isq ? (0.125f * 1.4426950408889634f) : 1.0f;
            float g0[8], g1[8], ks0[8], ks1[8];
#pragma unroll
            for (int e = 0; e < 8; ++e) { g0[e] = gn[8 * fq + e] * sc; g1[e] = gn[32 + 8 * fq + e] * sc; ks0[e] = 0.f; ks1[e] = 0.f; }
            bf16_t* obase = QKV + cb + 64 * wc + 8 * fq;
#pragma unroll
            for (int ai = 0; ai < 2; ++ai)
#pragma unroll
                for (int m = 0; m < 4; ++m) { const int row = row0 + ai * HALF + m * 16; const int pos = row & 2047;
                    const f32x4 a0 = acc[ai][0][m][0], a1 = acc[ai][0][m][1], b0 = acc[ai][1][m][0], b1 = acc[ai][1][m][1];
                    const float v0[8] = {a0[0], a0[1], a0[2], a0[3], a1[0], a1[1], a1[2], a1[3]}, v1[8] = {b0[0], b0[1], b0[2], b0[3], b1[0], b1[1], b1[2], b1[3]};
                    float ss = 0.f;
#pragma unroll
                    for (int e = 0; e < 8; ++e) ss += v0[e] * v0[e] + v1[e] * v1[e];
                    ss += __shfl_xor(ss, 16); ss += __shfl_xor(ss, 32);
                    const float rstd = 1.0f / sqrtf(ss * (1.0f / 64.0f) + 1e-6f);
                    const f32x4* tp = (const f32x4*)(rope + ((size_t)pos * 32 + 8 * fq) * 2);
                    float o0[8], o1[8];
#pragma unroll
                    for (int j = 0; j < 4; ++j) { const f32x4 t = tp[j];
                        { const float y0 = v0[2 * j] * rstd * g0[2 * j], y1 = v1[2 * j] * rstd * g1[2 * j]; o0[2 * j] = y0 * t[0] - y1 * t[1]; o1[2 * j] = y1 * t[0] + y0 * t[1]; }
                        { const float y0 = v0[2 * j + 1] * rstd * g0[2 * j + 1], y1 = v1[2 * j + 1] * rstd * g1[2 * j + 1]; o0[2 * j + 1] = y0 * t[2] - y1 * t[3]; o1[2 * j + 1] = y1 * t[2] + y0 * t[3]; } }
                    if (!isq) {
#pragma unroll
                        for (int e = 0; e < 8; ++e) { ks0[e] += o0[e]; ks1[e] += o1[e]; } }
                    u32x4 w0, w1; w0.x = cvt_pk_bf16(o0[0], o0[1]); w0.y = cvt_pk_bf16(o0[2], o0[3]); w0.z = cvt_pk_bf16(o0[4], o0[5]); w0.w = cvt_pk_bf16(o0[6], o0[7]);
                    w1.x = cvt_pk_bf16(o1[0], o1[1]); w1.y = cvt_pk_bf16(o1[2], o1[3]); w1.z = cvt_pk_bf16(o1[4], o1[5]); w1.w = cvt_pk_bf16(o1[6], o1[7]);
                    *(u32x4*)(obase + (size_t)row * 1536) = w0; *(u32x4*)(obase + (size_t)row * 1536 + 32) = w1; }
            if (!isq) {
                const int head = ((colt - 2560) >> 6) + wc; float* km = kmean + ((size_t)((u.pm >> 3) * 8 + head) * 8 + (u.pm & 7)) * 64 + 8 * fq;
#pragma unroll
                for (int e = 0; e < 8; ++e) { float a = ks0[e], b = ks1[e];
                    a += __shfl_xor(a, 1); a += __shfl_xor(a, 2); a += __shfl_xor(a, 4); a += __shfl_xor(a, 8);
                    b += __shfl_xor(b, 1); b += __shfl_xor(b, 2); b += __shfl_xor(b, 4); b += __shfl_xor(b, 8);
                    if (fr == 0) { atomicAdd(km + e, a * (1.0f / 256.0f)); atomicAdd(km + 32 + e, b * (1.0f / 256.0f)); } } }
            return;
        }
        if (mode == 3) {
            bf16_t* gbase = GT + ((colt - 3584) >> 1) + wc * 32 + 8 * fq;
#pragma unroll
            for (int ai = 0; ai < 2; ++ai)
#pragma unroll
                for (int m = 0; m < 4; ++m) { bf16_t* rowp = gbase + (size_t)(row0 + ai * HALF + m * 16) * 2048;
                    const f32x4 a0 = acc[ai][0][m][0], a1 = acc[ai][0][m][1], b0 = acc[ai][1][m][0], b1 = acc[ai][1][m][1];
                    const float ga[8] = {a0[0], a0[1], a0[2], a0[3], a1[0], a1[1], a1[2], a1[3]}, gb[8] = {b0[0], b0[1], b0[2], b0[3], b1[0], b1[1], b1[2], b1[3]};
                    float rho[8], sb[8];
#pragma unroll
                    for (int i = 0; i < 8; ++i) { const float ea = 1.0f + __expf(-ga[i]), eb = 1.0f + __expf(-gb[i]); sb[i] = __builtin_amdgcn_rcpf(eb); rho[i] = eb * __builtin_amdgcn_rcpf(ea); }
                    u32x4 w0, w1; w0.x = cvt_pk_bf16(rho[0], rho[1]); w0.y = cvt_pk_bf16(rho[2], rho[3]); w0.z = cvt_pk_bf16(rho[4], rho[5]); w0.w = cvt_pk_bf16(rho[6], rho[7]);
                    w1.x = cvt_pk_bf16(sb[0], sb[1]); w1.y = cvt_pk_bf16(sb[2], sb[3]); w1.z = cvt_pk_bf16(sb[4], sb[5]); w1.w = cvt_pk_bf16(sb[6], sb[7]);
                    *(u32x4*)rowp = w0; *(u32x4*)(rowp + 1024) = w1; }
            return;
        }
        const int col0 = cb + wc * 32 + 8 * fq;
        if (mode == 0) tile_store<0>(acc, base, ldc, row0, col0, colt, wc, fq);
        else if (mode == 1) tile_store<1>(acc, base, ldc, row0, col0, colt, wc, fq);
        else if (mode == 2) tile_store<2>(acc, base, ldc, row0, col0, colt, wc, fq);
        else tile_store<3>(acc, base, ldc, row0, col0, colt, wc, fq);
    }
    template <int MODE> __device__ __forceinline__ void tile_store(const f32x4 (&acc)[2][2][4][2], bf16_t* base, int ldc, int row0, int col0, int colt, int wc, int fq) const {
        float lb[2][8];
#pragma unroll
        for (int bj = 0; bj < 2; ++bj)
#pragma unroll
            for (int e = 0; e < 8; ++e) lb[bj][e] = 0.f;
        if (MODE == 1) { const int c0 = colt - 512 + wc * 32 + 8 * fq;
#pragma unroll
            for (int bj = 0; bj < 2; ++bj)
#pragma unroll
                for (int e = 0; e < 8; ++e) lb[bj][e] = sigm(lbl[c0 + bj * HALF + e] - lbl[512 + c0 + bj * HALF + e]); }
#pragma unroll
        for (int ai = 0; ai < 2; ++ai)
#pragma unroll
            for (int m = 0; m < 4; ++m) { bf16_t* rowp = base + (size_t)(row0 + ai * HALF + m * 16) * ldc + col0;
#pragma unroll
                for (int bj = 0; bj < 2; ++bj) { const f32x4 a0 = acc[ai][bj][m][0], a1 = acc[ai][bj][m][1];
                    float v[8] = {a0[0], a0[1], a0[2], a0[3], a1[0], a1[1], a1[2], a1[3]};
                    if (MODE == 0) {
#pragma unroll
                        for (int e = 0; e < 8; ++e) v[e] = v[e] * sigm(v[e]);
                    } else if (MODE == 1) {
#pragma unroll
                        for (int e = 0; e < 8; ++e) { const float s = sigm(v[e]); v[e] = __logf(lb[bj][e] + (1.0f - lb[bj][e]) * s); }
                    } else if (MODE == 3) {
#pragma unroll
                        for (int e = 0; e < 8; ++e) v[e] = sigm(v[e]);
                    }
                    u32x4 w; w.x = cvt_pk_bf16(v[0], v[1]); w.y = cvt_pk_bf16(v[2], v[3]); w.z = cvt_pk_bf16(v[4], v[5]); w.w = cvt_pk_bf16(v[6], v[7]);
                    *(u32x4*)(rowp + bj * HALF) = w; } }
    }
};
template <int SECOND> struct EpiGateMix {
    static constexpr bool PERM = true, AFTER_DRAIN = false;
    bf16_t* O; const bf16_t* gate;
    __device__ __forceinline__ void operator()(const f32x4 (&acc)[2][2][4][2], const Unit& u, int wr, int wc, int fr, int fq) const {
        const int row0 = u.pm * BM + wr * 64 + fr; const int col0 = u.pn * BM + wc * 32 + 8 * fq;
#pragma unroll
        for (int ai = 0; ai < 2; ++ai)
#pragma unroll
            for (int m = 0; m < 4; ++m) { const size_t r = (size_t)(row0 + ai * HALF + m * 16);
#pragma unroll
                for (int bj = 0; bj < 2; ++bj) { const int c = col0 + bj * HALF;
                    const u32x4 g = *(const u32x4*)(gate + r * 2048 + c);
                    u32x4 p = (u32x4){0u, 0u, 0u, 0u}; if (SECOND) p = *(const u32x4*)(O + r * 1024 + c);
                    const f32x4 a0 = acc[ai][bj][m][0], a1 = acc[ai][bj][m][1];
                    float v[8] = {a0[0], a0[1], a0[2], a0[3], a1[0], a1[1], a1[2], a1[3]};
#pragma unroll
                    for (int i = 0; i < 4; ++i) { v[2 * i] = v[2 * i] * bf2f(g[i] & 0xffffu) + bf2f(p[i] & 0xffffu); v[2 * i + 1] = v[2 * i + 1] * bf2f(g[i] >> 16) + bf2f(p[i] >> 16); }
                    u32x4 w; w.x = cvt_pk_bf16(v[0], v[1]); w.y = cvt_pk_bf16(v[2], v[3]); w.z = cvt_pk_bf16(v[4], v[5]); w.w = cvt_pk_bf16(v[6], v[7]);
                    *(u32x4*)(O + r * 1024 + c) = w; } }
    }
};
struct EpiMix {
    static constexpr bool PERM = true, AFTER_DRAIN = false, HAS_MID = true;
    bf16_t* O; const bf16_t* gt;
    __device__ __forceinline__ void mid(f32x4 (&acc)[2][2][4][2], const Unit& u, int wr, int wc, int fr, int fq) const {
        int row0 = u.pm * BM + wr * 64 + fr; const int col0 = u.pn * BM + wc * 32 + 8 * fq;
        asm volatile("" : "+v"(row0));
#pragma unroll
        for (int ai = 0; ai < 2; ++ai)
#pragma unroll
            for (int m = 0; m < 4; ++m) { const size_t r = (size_t)(row0 + ai * HALF + m * 16);
#pragma unroll
                for (int bj = 0; bj < 2; ++bj) { const u32x4 g = *(const u32x4*)(gt + r * 2048 + col0 + bj * HALF);
                    acc[ai][bj][m][0] = acc[ai][bj][m][0] * (f32x4){bf2f(g[0] & 0xffffu), bf2f(g[0] >> 16), bf2f(g[1] & 0xffffu), bf2f(g[1] >> 16)};
                    acc[ai][bj][m][1] = acc[ai][bj][m][1] * (f32x4){bf2f(g[2] & 0xffffu), bf2f(g[2] >> 16), bf2f(g[3] & 0xffffu), bf2f(g[3] >> 16)}; }
                if (m & 1) asm volatile("" ::: "memory"); }
    }
    __device__ __forceinline__ void operator()(const f32x4 (&acc)[2][2][4][2], const Unit& u, int wr, int wc, int fr, int fq) const {
        const int row0 = u.pm * BM + wr * 64 + fr; const int col0 = u.pn * BM + wc * 32 + 8 * fq;
#pragma unroll
        for (int ai = 0; ai < 2; ++ai)
#pragma unroll
            for (int m = 0; m < 4; ++m) { const size_t r = (size_t)(row0 + ai * HALF + m * 16);
#pragma unroll
                for (int bj = 0; bj < 2; ++bj) { const int c = col0 + bj * HALF; const u32x4 g = *(const u32x4*)(gt + r * 2048 + 1024 + c);
                    const f32x4 v0 = acc[ai][bj][m][0] * (f32x4){bf2f(g[0] & 0xffffu), bf2f(g[0] >> 16), bf2f(g[1] & 0xffffu), bf2f(g[1] >> 16)};
                    const f32x4 v1 = acc[ai][bj][m][1] * (f32x4){bf2f(g[2] & 0xffffu), bf2f(g[2] >> 16), bf2f(g[3] & 0xffffu), bf2f(g[3] >> 16)};
                    u32x4 w; w.x = cvt_pk_bf16(v0[0], v0[1]); w.y = cvt_pk_bf16(v0[2], v0[3]); w.z = cvt_pk_bf16(v1[0], v1[1]); w.w = cvt_pk_bf16(v1[2], v1[3]);
                    *(u32x4*)(O + r * 1024 + c) = w; } }
    }
};
struct EpiResF32 {
    static constexpr bool PERM = false, AFTER_DRAIN = false;
    const float* base; float* out; int ldc;
    __device__ __forceinline__ void operator()(const f32x4 (&acc)[2][2][4][2], const Unit& u, int wr, int wc, int fr, int fq) const {
        const int col0 = u.pn * BM + wc * 32 + 4 * fq;
#pragma unroll
        for (int ai = 0; ai < 2; ++ai)
#pragma unroll
            for (int m = 0; m < 4; ++m) { const size_t off = (size_t)(u.pm * BM + ai * HALF + wr * 64 + m * 16 + fr) * ldc + col0;
#pragma unroll
                for (int bj = 0; bj < 2; ++bj)
#pragma unroll
                    for (int n = 0; n < 2; ++n) { const f32x4 bs = *(const f32x4*)(base + off + bj * HALF + n * 16); *(f32x4*)(out + off + bj * HALF + n * 16) = bs + acc[ai][bj][m][n]; } }
    }
};

struct EpiResNorm {
    static constexpr bool PERM = true, AFTER_DRAIN = false;
    const float* base; float* out; bf16_t* xb; float* rowss;
    __device__ __forceinline__ void operator()(const f32x4 (&acc)[2][2][4][2], const Unit& u, int wr, int wc, int fr, int fq) const {
        const int col0 = u.pn * BM + wc * 32 + 8 * fq;
#pragma unroll
        for (int ai = 0; ai < 2; ++ai)
#pragma unroll
            for (int m = 0; m < 4; ++m) { const int row = u.pm * BM + ai * HALF + wr * 64 + m * 16 + fr; const size_t off = (size_t)row * 1024 + col0; float s = 0.f;
#pragma unroll
                for (int bj = 0; bj < 2; ++bj) { const f32x4 o0 = *(const f32x4*)(base + off + bj * HALF) + acc[ai][bj][m][0], o1 = *(const f32x4*)(base + off + bj * HALF + 4) + acc[ai][bj][m][1];
                    *(f32x4*)(out + off + bj * HALF) = o0; *(f32x4*)(out + off + bj * HALF + 4) = o1;
                    s += (o0[0] * o0[0] + o0[1] * o0[1]) + (o0[2] * o0[2] + o0[3] * o0[3]) + (o1[0] * o1[0] + o1[1] * o1[1]) + (o1[2] * o1[2] + o1[3] * o1[3]);
                    u32x4 w; w.x = cvt_pk_bf16(o0[0], o0[1]); w.y = cvt_pk_bf16(o0[2], o0[3]); w.z = cvt_pk_bf16(o1[0], o1[1]); w.w = cvt_pk_bf16(o1[2], o1[3]);
                    *(u32x4*)(xb + off + bj * HALF) = w; }
                s += __shfl_xor(s, 16); s += __shfl_xor(s, 32);
                if (fq == 0) atomicAdd(rowss + row, s); }
    }
};
__device__ __forceinline__ float dpp_shr1(float v) { return __builtin_bit_cast(float, __builtin_amdgcn_update_dpp(0, __builtin_bit_cast(int, v), 0x111, 0xf, 0xf, true)); }
__device__ __forceinline__ float dpp_shr2(float v) { return __builtin_bit_cast(float, __builtin_amdgcn_update_dpp(0, __builtin_bit_cast(int, v), 0x112, 0xf, 0xf, true)); }
__device__ __forceinline__ float dpp_shr1_old(float oldv, float v) { return __builtin_bit_cast(float, __builtin_amdgcn_update_dpp(__builtin_bit_cast(int, oldv), __builtin_bit_cast(int, v), 0x111, 0xf, 0xf, false)); }
__device__ __forceinline__ float dpp_shr2_old(float oldv, float v) { return __builtin_bit_cast(float, __builtin_amdgcn_update_dpp(__builtin_bit_cast(int, oldv), __builtin_bit_cast(int, v), 0x112, 0xf, 0xf, false)); }
struct EpiUpConv {
    static constexpr bool PERM = true, AFTER_DRAIN = false;
    bf16_t* G; const float* conv_w; const float* conv_b; float* ufirst; float* vfirst; float* ulast; PG8_LAS float* xch; const float* rowss;
    __device__ __forceinline__ void operator()(const f32x4 (&acc0)[2][2][4][2], const Unit& u, int wr, int wc, int fr, int fq) const {
        const int ch0 = u.pn * 128 + wc * 32 + 8 * fq;
        float w0[8], w1[8], w2[8], bb[8];
#pragma unroll
        for (int j = 0; j < 2; ++j) { const f32x4 a = *(const f32x4*)(conv_w + ch0 + 4 * j), b = *(const f32x4*)(conv_w + 2816 + ch0 + 4 * j), c = *(const f32x4*)(conv_w + 5632 + ch0 + 4 * j), d = *(const f32x4*)(conv_b + ch0 + 4 * j);
#pragma unroll
            for (int e = 0; e < 4; ++e) { w0[4 * j + e] = a[e]; w1[4 * j + e] = b[e]; w2[4 * j + e] = c[e]; bb[4 * j + e] = d[e]; } }
        f32x4 acc[2][2][4][2];
#pragma unroll
        for (int ai = 0; ai < 2; ++ai)
#pragma unroll
            for (int m = 0; m < 4; ++m) { const float rs = 1.0f / sqrtf(rowss[u.pm * BM + ai * HALF + wr * 64 + m * 16 + fr] * (1.0f / 1024.0f) + 1e-6f);
#pragma unroll
                for (int bj = 0; bj < 2; ++bj)
#pragma unroll
                    for (int n = 0; n < 2; ++n) acc[ai][bj][m][n] = acc0[ai][bj][m][n] * rs; }
        if (fr >= 14) {
#pragma unroll
            for (int ai = 0; ai < 2; ++ai)
#pragma unroll
                for (int m = 0; m < 4; ++m) { const int g = 4 * (2 * ai + wr) + m; PG8_LAS f32x4* p = (PG8_LAS f32x4*)(xch + (((g * 4 + wc) * 2 + (fr - 14)) * 4 + fq) * 8);
                    p[0] = acc[ai][0][m][0]; p[1] = acc[ai][0][m][1]; }
            if (wr == 1) { float* pl = ulast + (size_t)(u.pm * 2 + (fr - 14)) * 2816 + ch0; *(f32x4*)pl = acc[1][0][3][0]; *(f32x4*)(pl + 4) = acc[1][0][3][1]; }
        }
        if (wr == 0 && fr < 2) { float* pu = ufirst + (size_t)(u.pm * 2 + fr) * 2816 + ch0; *(f32x4*)pu = acc[0][0][0][0]; *(f32x4*)(pu + 4) = acc[0][0][0][1];
            float* pv = vfirst + (size_t)(u.pm * 2 + fr) * 2816 + ch0; *(f32x4*)pv = acc[0][1][0][0]; *(f32x4*)(pv + 4) = acc[0][1][0][1]; }
        asm volatile("s_waitcnt lgkmcnt(0)" ::: "memory"); __builtin_amdgcn_s_barrier(); asm volatile("" ::: "memory");
        const int row0 = u.pm * BM + wr * 64 + fr;
#pragma unroll
        for (int ai = 0; ai < 2; ++ai)
#pragma unroll
            for (int m = 0; m < 4; ++m) { const int g = 4 * (2 * ai + wr) + m; const int gp = (g > 0) ? g - 1 : 0;
                const PG8_LAS f32x4* xp = (const PG8_LAS f32x4*)(xch + (((gp * 4 + wc) * 2) * 4 + fq) * 8);
                const f32x4 xa0 = xp[0], xa1 = xp[1], xb0 = xp[8], xb1 = xp[9];
                const float X0[8] = {xa0[0], xa0[1], xa0[2], xa0[3], xa1[0], xa1[1], xa1[2], xa1[3]}, X1[8] = {xb0[0], xb0[1], xb0[2], xb0[3], xb1[0], xb1[1], xb1[2], xb1[3]};
                const f32x4 u0 = acc[ai][0][m][0], u1 = acc[ai][0][m][1], v0 = acc[ai][1][m][0], v1 = acc[ai][1][m][1];
                const float uu[8] = {u0[0], u0[1], u0[2], u0[3], u1[0], u1[1], u1[2], u1[3]}, vv[8] = {v0[0], v0[1], v0[2], v0[3], v1[0], v1[1], v1[2], v1[3]};
                float r[8];
#pragma unroll
                for (int e = 0; e < 8; e += 2) {
                    const float xs0 = (fr == 0) ? X0[e] : X1[e], xs1 = (fr == 0) ? X0[e + 1] : X1[e + 1];
                    const f32x2 P1 = {dpp_shr1_old(X1[e], uu[e]), dpp_shr1_old(X1[e + 1], uu[e + 1])}, P2 = {dpp_shr2_old(xs0, uu[e]), dpp_shr2_old(xs1, uu[e + 1])};
                    const f32x2 U = {uu[e], uu[e + 1]}, B = {bb[e], bb[e + 1]}, W0 = {w0[e], w0[e + 1]}, W1 = {w1[e], w1[e + 1]}, W2 = {w2[e], w2[e + 1]};
                    const f32x2 rr = B + W0 * P2 + W1 * P1 + W2 * U; r[e] = rr.x; r[e + 1] = rr.y; }
                u32x4 w;
#pragma unroll
                for (int i = 0; i < 4; ++i) { const f32x2 gl = gelu_pk((f32x2){r[2 * i], r[2 * i + 1]}); w[i] = cvt_pk_bf16(gl.x * vv[2 * i], gl.y * vv[2 * i + 1]); }
                *(u32x4*)(G + (size_t)(row0 + ai * HALF + m * 16) * 2816 + ch0) = w; }
    }
};

template <class T, class = void> struct epi_has_mid : std::false_type {};
template <class T> struct epi_has_mid<T, std::void_t<decltype(T::HAS_MID)>> : std::true_type {};
template <class Epi, class Sched, bool ALIGN_EPI = false, bool SP2 = false, bool TL = false>
__device__ __forceinline__ void gemm_phase(PG8_LAS unsigned char* lds, const Gemm g, const Sched& S, const Epi& E) {
    int tid_l = threadIdx.x; asm volatile("" : "+v"(tid_l));
    const int tid = tid_l, wid = __builtin_amdgcn_readfirstlane(tid >> 6), lane = tid & 63, wr = wid >> 2, wc = wid & 3, fr = lane & 15, fq = lane >> 4;
    const int K = g.K, nt = K / BK;
    unsigned voffA[2], voffB[2];
#pragma unroll
    for (int i = 0; i < 2; ++i) { int R, C; stage_rc(tid * 16 + i * 8192, R, C); const int Rb = Epi::PERM ? ((R & ~31) + perm32(R & 31)) : R;
        voffA[i] = (unsigned)(R * (TL ? BK : K) + C) * 2u; voffB[i] = (unsigned)(Rb * (TL ? BK : K) + C) * 2u; }
    const size_t kstep = TL ? (size_t)(BM * BK * 2) : (size_t)(BK * 2);
    const size_t hstep = TL ? (size_t)(HALF * BK * 2) : (size_t)HALF * K * 2;
    const size_t tstep = (size_t)BM * K * 2;
    const unsigned ldsw = (unsigned)wid * 1024u;
    const int aoff = lds_byte(wr * 64 + fr, fq * 8), boff = lds_byte(wc * 32 + fr, fq * 8);
#define PG8_SA(b, h) (((b) * 2 + (h)) * HTB)
#define PG8_SB(b, h) ((4 + (b) * 2 + (h)) * HTB)
#define PG8_STAGE(bufoff, gbase, voff) do { _Pragma("unroll") for (int _i = 0; _i < 2; ++_i) \
        __builtin_amdgcn_global_load_lds((const unsigned*)((const char*)(gbase) + (voff)[_i]), (PG8_LAS unsigned*)(lds + (bufoff) + ldsw + _i * 8192), 16, 0, 0); } while (0)
#define PG8_LDA(dst, b, h) do { _Pragma("unroll") for (int m = 0; m < 4; ++m) _Pragma("unroll") for (int k = 0; k < 2; ++k) dst[m][k] = *(const PG8_LAS bf16x8*)(lds + PG8_SA(b, h) + aoff + m * 2048 + k * 1024); } while (0)
#define PG8_LDB(dst, b, h) do { _Pragma("unroll") for (int n = 0; n < 2; ++n) _Pragma("unroll") for (int k = 0; k < 2; ++k) dst[n][k] = *(const PG8_LAS bf16x8*)(lds + PG8_SB(b, h) + boff + n * 2048 + k * 1024); } while (0)
#define PG8_MMA(ai, bj, At, Bt) do { __builtin_amdgcn_s_setprio(1); _Pragma("unroll") for (int m = 0; m < 4; ++m) _Pragma("unroll") for (int n = 0; n < 2; ++n) _Pragma("unroll") for (int k = 0; k < 2; ++k) \
        acc[ai][bj][m][n] = __builtin_amdgcn_mfma_f32_16x16x32_bf16(Bt[n][k], At[m][k], acc[ai][bj][m][n], 0, 0, 0); __builtin_amdgcn_s_setprio(0); } while (0)
#define PG8_WAIT_V(n) asm volatile("s_waitcnt vmcnt(" #n ")" ::: "memory")
#define PG8_WAIT_L(n) asm volatile("s_waitcnt lgkmcnt(" #n ")" ::: "memory")
#define PG8_BAR __builtin_amdgcn_s_barrier()
#define PG8_SCHED __builtin_amdgcn_sched_barrier(0)
    Unit cur, nxt; int ui = 0;
    if (!S.next(0, cur)) return;
    f32x4 acc[2][2][4][2];
#pragma unroll
    for (int a = 0; a < 2; ++a)
#pragma unroll
        for (int b = 0; b < 2; ++b)
#pragma unroll
            for (int m = 0; m < 4; ++m)
#pragma unroll
                for (int n = 0; n < 2; ++n) acc[a][b][m][n] = (f32x4){0.f, 0.f, 0.f, 0.f};
    bf16x8 At[4][2], B0[2][2], B1[2][2];
    const char* cA = (const char*)g.A + (size_t)cur.pm * tstep; const char* cB = (const char*)g.Bt + (size_t)cur.pn * tstep;
    S.a_ready(cur);
    if constexpr (SP2) {
        PG8_STAGE(PG8_SB(0, 0), cB, voffB); PG8_STAGE(PG8_SB(0, 1), cB + hstep, voffB); PG8_STAGE(PG8_SA(0, 0), cA, voffA); PG8_STAGE(PG8_SA(0, 1), cA + hstep, voffA);
        if (wr == 1) PG8_BAR;
        PG8_WAIT_V(2); PG8_BAR;
        PG8_STAGE(PG8_SB(1, 0), cB + kstep, voffB); PG8_STAGE(PG8_SA(1, 0), cA + kstep, voffA); PG8_STAGE(PG8_SB(1, 1), cB + hstep + kstep, voffB);
        PG8_WAIT_V(6); PG8_BAR;
    } else {
        PG8_STAGE(PG8_SB(0, 0), cB, voffB); PG8_STAGE(PG8_SA(0, 0), cA, voffA); PG8_STAGE(PG8_SB(0, 1), cB + hstep, voffB); PG8_STAGE(PG8_SA(0, 1), cA + hstep, voffA);
        if (wr == 1) PG8_BAR;
        PG8_WAIT_V(4); PG8_BAR;
        PG8_STAGE(PG8_SB(1, 0), cB + kstep, voffB); PG8_STAGE(PG8_SA(1, 0), cA + kstep, voffA); PG8_STAGE(PG8_SB(1, 1), cB + hstep + kstep, voffB);
        PG8_WAIT_V(6); PG8_BAR;
    }
    for (;;) {
        const bool has_next = S.next(ui + 1, nxt);
        const char* nA = has_next ? (const char*)g.A + (size_t)nxt.pm * tstep : cA; const char* nB = has_next ? (const char*)g.Bt + (size_t)nxt.pn * tstep : cB;
        for (int t = 0; t < nt; t += 2) {
            if constexpr (epi_has_mid<Epi>::value) { if (t == (nt >> 1)) E.mid(acc, cur, wr, wc, fr, fq); }
            const bool last = (t == nt - 2);
            const char* a1 = cA + (size_t)(t + 1) * kstep;
            const char* a2 = last ? nA : cA + (size_t)(t + 2) * kstep; const char* b2 = last ? nB : cB + (size_t)(t + 2) * kstep;
            const char* a3 = a2 + kstep; const char* b3 = b2 + kstep;
            if (last && has_next) S.a_ready(nxt);
            if constexpr (SP2) {
            PG8_LDB(B0, 0, 0); PG8_LDB(B1, 0, 1); PG8_SCHED; PG8_LDA(At, 0, 0); PG8_STAGE(PG8_SA(1, 1), a1 + hstep, voffA);
            PG8_WAIT_V(8); PG8_WAIT_L(0); PG8_BAR; PG8_MMA(0, 0, At, B0); PG8_MMA(0, 1, At, B1); PG8_BAR; PG8_SCHED;
            PG8_LDA(At, 0, 1); PG8_STAGE(PG8_SB(0, 0), b2, voffB); PG8_STAGE(PG8_SB(0, 1), b2 + hstep, voffB); PG8_STAGE(PG8_SA(0, 0), a2, voffA);
            PG8_WAIT_V(8); PG8_WAIT_L(0); PG8_BAR; PG8_MMA(1, 0, At, B0); PG8_MMA(1, 1, At, B1); PG8_BAR; PG8_SCHED;
            PG8_LDB(B0, 1, 0); PG8_LDB(B1, 1, 1); PG8_SCHED; PG8_LDA(At, 1, 0); PG8_STAGE(PG8_SA(0, 1), a2 + hstep, voffA);
            PG8_WAIT_V(8); PG8_WAIT_L(0); PG8_BAR; PG8_MMA(0, 0, At, B0); PG8_MMA(0, 1, At, B1); PG8_BAR; PG8_SCHED;
            PG8_LDA(At, 1, 1); PG8_STAGE(PG8_SB(1, 0), b3, voffB); PG8_STAGE(PG8_SB(1, 1), b3 + hstep, voffB); PG8_STAGE(PG8_SA(1, 0), a3, voffA);
            PG8_WAIT_V(8); PG8_WAIT_L(0); PG8_BAR; PG8_MMA(1, 0, At, B0); PG8_MMA(1, 1, At, B1); PG8_BAR; PG8_SCHED;
            } else {
            PG8_LDB(B0, 0, 0); PG8_SCHED; PG8_LDA(At, 0, 0); PG8_STAGE(PG8_SA(1, 1), a1 + hstep, voffA);
            PG8_WAIT_L(8); PG8_BAR; PG8_WAIT_L(0); PG8_MMA(0, 0, At, B0); PG8_BAR; PG8_SCHED;
            PG8_LDB(B1, 0, 1); PG8_STAGE(PG8_SB(0, 0), b2, voffB);
            PG8_BAR; PG8_WAIT_L(0); PG8_MMA(0, 1, At, B1); PG8_BAR;
            PG8_LDA(At, 0, 1); PG8_STAGE(PG8_SA(0, 0), a2, voffA);
            PG8_BAR; PG8_WAIT_L(0); PG8_MMA(1, 0, At, B0); PG8_BAR; PG8_SCHED;
            PG8_STAGE(PG8_SB(0, 1), b2 + hstep, voffB);
            PG8_WAIT_V(6); PG8_BAR; PG8_MMA(1, 1, At, B1); PG8_BAR;
            PG8_LDB(B0, 1, 0); PG8_SCHED; PG8_LDA(At, 1, 0); PG8_STAGE(PG8_SA(0, 1), a2 + hstep, voffA);
            PG8_WAIT_L(8); PG8_BAR; PG8_WAIT_L(0); PG8_MMA(0, 0, At, B0); PG8_BAR; PG8_SCHED;
            PG8_LDB(B1, 1, 1); PG8_STAGE(PG8_SB(1, 0), b3, voffB);
            PG8_BAR; PG8_WAIT_L(0); PG8_MMA(0, 1, At, B1); PG8_BAR;
            PG8_LDA(At, 1, 1); PG8_STAGE(PG8_SA(1, 0), a3, voffA);
            PG8_BAR; PG8_WAIT_L(0); PG8_MMA(1, 0, At, B0); PG8_BAR; PG8_SCHED;
            PG8_STAGE(PG8_SB(1, 1), b3 + hstep, voffB);
            PG8_WAIT_V(6); PG8_BAR; PG8_MMA(1, 1, At, B1); PG8_BAR;
            }
        }
        if constexpr (ALIGN_EPI) { if (wr == 0) PG8_BAR; }
        if constexpr (!Epi::AFTER_DRAIN) { E(acc, cur, wr, wc, fr, fq); S.done(cur); }
        if (!has_next) break;
#pragma unroll
        for (int a = 0; a < 2; ++a)
#pragma unroll
            for (int b = 0; b < 2; ++b)
#pragma unroll
                for (int m = 0; m < 4; ++m)
#pragma unroll
                    for (int n = 0; n < 2; ++n) acc[a][b][m][n] = (f32x4){0.f, 0.f, 0.f, 0.f};
        cur = nxt; cA = nA; cB = nB; ++ui;
        if constexpr (ALIGN_EPI) { if (wr == 1) PG8_BAR; }
    }
    PG8_WAIT_V(0);
    if constexpr (!ALIGN_EPI) { if (wr == 0) PG8_BAR; }
    PG8_BAR;
    if constexpr (Epi::AFTER_DRAIN) { E.fused(acc, cur, wr, wc, fr, fq, lds, wid, lane); S.done(cur); }
#undef PG8_SA
#undef PG8_SB
#undef PG8_STAGE
#undef PG8_LDA
#undef PG8_LDB
#undef PG8_MMA
#undef PG8_WAIT_V
#undef PG8_WAIT_L
#undef PG8_BAR
#undef PG8_SCHED
}
}

#ifndef PG8_SP2
#define PG8_SP2 true
#endif
#ifndef PG8_ALIGN
#define PG8_ALIGN true
#endif
#include <hip/hip_bf16.h>
#include <cmath>
namespace attn_body {
using bf16=__hip_bfloat16;
using bf16x8=__attribute__((ext_vector_type(8)))short;
using s16x4=__attribute__((ext_vector_type(4)))short;
using f32x16=__attribute__((ext_vector_type(16)))float;
using u32x4=__attribute__((ext_vector_type(4)))unsigned;
constexpr int BATCH=32,NHEAD=8,SEQ=2048,D=64,DM=1536,OPITCH=1024;
constexpr int NW=8,QBLK=32,QB=QBLK*NW,KVBLK=64,NQB=SEQ/QB;
constexpr int ATTN_PITCH=DM, ATTN_UNIT_ROWS=QB;
__device__ __forceinline__ int crow(int r,int hi){return (r&3)+8*(r>>2)+4*hi;}
#define SBAR() __builtin_amdgcn_sched_barrier(0)
__device__ __forceinline__ void cmask(f32x16&p0,f32x16&p1,int jb,int qrel,int hi){
  const float NEG=-INFINITY; int kb=64*jb+4*hi;
  #pragma unroll
  for(int r=0;r<16;++r){int kv=kb+(r&3)+8*(r>>2); if(kv>qrel)p0[r]=NEG; if(kv+32>qrel)p1[r]=NEG;}
}

constexpr int NSLOT=3, SLOTB=8192;
constexpr int LDS_K=0, LDS_V=NSLOT*SLOTB, LDS_WS=2*NSLOT*SLOTB, LDS_OST=LDS_WS+NW*64*4, LDS_BYTES=LDS_OST+NW*4096;
constexpr float C2=0.125f*1.4426950408889634f;
__device__ __forceinline__ void glds16(const void*gsrc,unsigned lds_dst){unsigned keep;
  asm volatile("s_mov_b32 %0, m0\n\ts_mov_b32 m0, %2\n\ts_nop 0\n\tglobal_load_lds_dwordx4 %1, off\n\ts_mov_b32 m0, %0":"=&s"(keep):"v"(gsrc),"s"(lds_dst):"memory");}
__device__ __forceinline__ float max3f(float a,float b,float c){float r;asm("v_max3_f32 %0, %1, %2, %3":"=v"(r):"v"(a),"v"(b),"v"(c));return r;}
__device__ __forceinline__ float max2f(float a,float b){float r;asm("v_max_f32_e32 %0, %1, %2":"=v"(r):"v"(a),"v"(b));return r;}
__device__ __forceinline__ float fadd_s(float a,float b){float r;asm("v_add_f32_e32 %0, %1, %2":"=v"(r):"v"(a),"v"(b));return r;}
__device__ __forceinline__ float fsub_s(float a,float b){float r;asm("v_sub_f32_e32 %0, %1, %2":"=v"(r):"v"(a),"v"(b));return r;}
typedef float f32x2_t __attribute__((ext_vector_type(2))); typedef __bf16 bf16x2_t __attribute__((ext_vector_type(2)));
__device__ __forceinline__ unsigned cvtpk_s(float lo,float hi){f32x2_t v={lo,hi};bf16x2_t b=__builtin_convertvector(v,bf16x2_t);return __builtin_bit_cast(unsigned,b);}
#define WAIT_BAR(N) asm volatile("s_waitcnt vmcnt(" #N ") lgkmcnt(0)\n\ts_barrier":::"memory")

__device__ __forceinline__ void qkt(f32x16&p0,f32x16&p1,const char*Kslot,const bf16x8*qr,const f32x16&negm,int r32,int hi){
  const char*kb=Kslot+hi*1024+r32*16;
  #pragma unroll
  for(int d0=0;d0<4;++d0){
    const bf16x8 b0=*reinterpret_cast<const bf16x8*>(kb+d0*2048);
    const bf16x8 b1=*reinterpret_cast<const bf16x8*>(kb+d0*2048+512);
    if(d0==0){p0=__builtin_amdgcn_mfma_f32_32x32x16_bf16(b0,qr[0],negm,0,0,0);p1=__builtin_amdgcn_mfma_f32_32x32x16_bf16(b1,qr[0],negm,0,0,0);}
    else{p0=__builtin_amdgcn_mfma_f32_32x32x16_bf16(b0,qr[d0],p0,0,0,0);p1=__builtin_amdgcn_mfma_f32_32x32x16_bf16(b1,qr[d0],p1,0,0,0);}}
}
typedef __attribute__((address_space(3))) const char* lds_cptr;
typedef short v4i16_t __attribute__((ext_vector_type(4)));
__device__ __forceinline__ void kload8(bf16x8*kf,lds_cptr kp){
  kf[0]=*(const __attribute__((address_space(3))) bf16x8*)(kp);      kf[1]=*(const __attribute__((address_space(3))) bf16x8*)(kp+512);
  kf[2]=*(const __attribute__((address_space(3))) bf16x8*)(kp+2048); kf[3]=*(const __attribute__((address_space(3))) bf16x8*)(kp+2560);
  kf[4]=*(const __attribute__((address_space(3))) bf16x8*)(kp+4096); kf[5]=*(const __attribute__((address_space(3))) bf16x8*)(kp+4608);
  kf[6]=*(const __attribute__((address_space(3))) bf16x8*)(kp+6144); kf[7]=*(const __attribute__((address_space(3))) bf16x8*)(kp+6656);
}
__device__ __forceinline__ void kload2(bf16x8*kf,lds_cptr kp,int j){ kf[2*j]=*(const __attribute__((address_space(3))) bf16x8*)(kp+j*2048); kf[2*j+1]=*(const __attribute__((address_space(3))) bf16x8*)(kp+j*2048+512); }
__device__ __forceinline__ s16x4 vtr(lds_cptr p){ return __builtin_bit_cast(s16x4,__builtin_amdgcn_ds_read_tr16_b64_v4i16((__attribute__((address_space(3))) v4i16_t*)p)); }
__device__ __forceinline__ float rowmax(const f32x16&p0,const f32x16&p1){
  float a=max3f(p0[0],p0[1],p1[0]),b=max3f(p0[2],p0[3],p1[1]);a=max3f(a,p1[2],p1[3]);
  #pragma unroll
  for(int r=4;r<16;r+=4){a=max3f(a,p0[r],p0[r+1]);b=max3f(b,p0[r+2],p0[r+3]);a=max3f(a,p1[r],p1[r+1]);b=max3f(b,p1[r+2],p1[r+3]);}
  const float m=max2f(a,b);
  auto rr=__builtin_amdgcn_permlane32_swap(__float_as_uint(m),__float_as_uint(m),false,false);
  return max2f(__uint_as_float(rr[0]),__uint_as_float(rr[1]));
}
__device__ __forceinline__ void pv(f32x16*o,int vb,bf16x8 pa0,bf16x8 pa1,bf16x8 pa2,bf16x8 pa3){
  #pragma unroll
  for(int d0=0;d0<2;++d0){s16x4 lo[4],hi[4];
    #pragma unroll
    for(int ks=0;ks<4;++ks){
      asm volatile("ds_read_b64_tr_b16 %0,%1 offset:%c2":"=&v"(lo[ks]):"v"(vb),"i"(d0*4096+ks*1024):"memory");
      asm volatile("ds_read_b64_tr_b16 %0,%1 offset:%c2":"=&v"(hi[ks]):"v"(vb),"i"(d0*4096+ks*1024+512):"memory");}
    asm volatile("s_waitcnt lgkmcnt(0)":::"memory");SBAR();
    #define PK(k) (bf16x8){lo[k][0],lo[k][1],lo[k][2],lo[k][3],hi[k][0],hi[k][1],hi[k][2],hi[k][3]}
    o[d0]=__builtin_amdgcn_mfma_f32_32x32x16_bf16(pa0,PK(0),o[d0],0,0,0);
    o[d0]=__builtin_amdgcn_mfma_f32_32x32x16_bf16(pa1,PK(1),o[d0],0,0,0);
    o[d0]=__builtin_amdgcn_mfma_f32_32x32x16_bf16(pa2,PK(2),o[d0],0,0,0);
    o[d0]=__builtin_amdgcn_mfma_f32_32x32x16_bf16(pa3,PK(3),o[d0],0,0,0);
    #undef PK
  }
}

#ifndef ATTN_STORE16
#define ATTN_STORE16(p,v) (*(u32x4*)(p)=(v))
#endif
template<int THRL> __device__ __forceinline__ void attn_unit(int b,int h,int qb,const bf16*Q,const bf16*__restrict__ K,const bf16*__restrict__ V,bf16*O,const float*kmean,char*shm){
  int tid_l=threadIdx.x; asm volatile("":"+v"(tid_l)); const int tid=tid_l,lane=tid&63,r32=lane&31,hi=lane>>5; const int wid=__builtin_amdgcn_readfirstlane(tid>>6);
  const long rowbase=(long)b*SEQ; const int q0=qb*QB;
  const bf16*Qw=Q+(rowbase+q0+wid*QBLK)*DM+h*D;
  const bf16*Kh=K+rowbase*DM+h*D,*Vh=V+rowbase*DM+h*D;
  const unsigned lds0=(unsigned)(uintptr_t)shm;
  float*wsf=(float*)(shm+LDS_WS)+wid*64;
  const bf16*ksrc=Kh+(long)lane*DM+wid*8;
  const bf16*vsrc=Vh+(long)(16*(wid&3)+(lane>>2))*DM+(wid>>2)*32+(lane&3)*8;
  const unsigned kdst=lds0+LDS_K+wid*1024, vdst=lds0+LDS_V+wid*1024;
  #define DMA_K(t,slot) glds16(ksrc+(long)(t)*KVBLK*DM,(unsigned)__builtin_amdgcn_readfirstlane(kdst+(slot)))
  #define DMA_V(t,slot) glds16(vsrc+(long)(t)*KVBLK*DM,(unsigned)__builtin_amdgcn_readfirstlane(vdst+(slot)))
  const int vb0=(int)(lds0+LDS_V)+((lane>>4)&1)*32+(lane&3)*8+(4*hi+((lane&15)>>2))*64;
  const char*Kbase=shm+LDS_K; bf16x8 kf[8];
  const lds_cptr shm3=(lds_cptr)shm; const lds_cptr kp0=shm3+LDS_K+hi*1024+r32*16; const lds_cptr vp0=shm3+LDS_V+((lane>>4)&1)*32+(lane&3)*8+(4*hi+((lane&15)>>2))*64;
  const int NT=(q0+QB)/KVBLK;
  DMA_K(0,0);DMA_V(0,0);DMA_K(1,SLOTB);
  bf16x8 qr[4];
  #pragma unroll
  for(int d0=0;d0<4;++d0)qr[d0]=*reinterpret_cast<const bf16x8*>(&Qw[(long)r32*DM+d0*16+hi*8]);
  unsigned selm=0xffu;
  if(qb>=4){ float gsc[7]; const float*km=kmean+((long)(b*NHEAD+h)*8)*64;
    #pragma unroll
    for(int n=0;n<7;++n){ float s=-INFINITY;
      if(n<qb){ s=0.f;
        #pragma unroll
        for(int d0=0;d0<4;++d0){ const float4 k0=*reinterpret_cast<const float4*>(km+n*64+d0*16+hi*8),k1=*reinterpret_cast<const float4*>(km+n*64+d0*16+hi*8+4);
          const bf16x8 qq=qr[d0];
          s+=__uint_as_float((unsigned)(unsigned short)qq[0]<<16)*k0.x+__uint_as_float((unsigned)(unsigned short)qq[1]<<16)*k0.y+__uint_as_float((unsigned)(unsigned short)qq[2]<<16)*k0.z+__uint_as_float((unsigned)(unsigned short)qq[3]<<16)*k0.w
            +__uint_as_float((unsigned)(unsigned short)qq[4]<<16)*k1.x+__uint_as_float((unsigned)(unsigned short)qq[5]<<16)*k1.y+__uint_as_float((unsigned)(unsigned short)qq[6]<<16)*k1.z+__uint_as_float((unsigned)(unsigned short)qq[7]<<16)*k1.w; }
        s+=__shfl_xor(s,32); }
      gsc[n]=s; }
    selm=1u<<qb;
    #pragma unroll
    for(int n=0;n<7;++n){ int rank=0;
      #pragma unroll
      for(int m2=0;m2<7;++m2){ if(m2!=n){ if(gsc[m2]>gsc[n]||(gsc[m2]==gsc[n]&&m2<n))++rank; } }
      if(n<qb&&rank<3)selm|=1u<<n; } }
  float mhat=0.f,l_reg=0.f;f32x16 o[2];o[0]=f32x16{};o[1]=f32x16{};const f32x16 zero16=f32x16{};
  const bf16x8 kones=__builtin_bit_cast(bf16x8,(u32x4){hi==0?0x3F803F80u:0u,0u,0u,0u});
  const int qrel=wid*QBLK+r32;
  #define CMASK0(P0,P1,t) do{int jb_=(t)-(NT-4); if(jb_>=0)cmask(P0,P1,jb_,qrel,hi); else if(!((selm>>((t)>>2))&1u)){ _Pragma("unroll") for(int r_=0;r_<16;++r_){P0[r_]=-INFINITY;P1[r_]=-INFINITY;} } }while(0)
  #define CMASK(P0,P1,t) do{int jb_=(t)-(NT-4); if(jb_>=0)cmask(P0,P1,jb_,qrel,hi);}while(0)
  bool resc=false;
  #define START(P0,P1) do{ const float rm=rowmax(P0,P1); resc=false; \
    { const float dl=__builtin_ceilf(__builtin_fmaxf(rm,-30.f)); mhat=fadd_s(mhat,dl); \
      _Pragma("unroll") for(int r=0;r<16;++r){P0[r]=fsub_s(P0[r],dl);P1[r]=fsub_s(P1[r],dl);} \
      } \
    _Pragma("unroll") for(int r=0;r<16;++r)P0[r]=__builtin_amdgcn_exp2f(P0[r]); }while(0)
  #define RESC() do{ if(resc){ asm volatile("s_waitcnt lgkmcnt(0)":::"memory"); \
      _Pragma("unroll") for(int d_=0;d_<2;++d_) _Pragma("unroll") for(int r=0;r<16;++r)o[d_][r]*=wsf[crow(r,hi)]; } }while(0)
  f32x16 pA0,pA1,pB0,pB1;
  int sl_prev=0,sl_cur=0,sl_next=SLOTB;
  #define ROT() do{sl_prev=sl_cur;sl_cur=sl_next;sl_next=(sl_next==(NSLOT-1)*SLOTB)?0:sl_next+SLOTB;}while(0)
  DMA_K(2,2*SLOTB);
  WAIT_BAR(3);
  qkt(pA0,pA1,Kbase,qr,zero16,r32,hi);asm volatile("s_nop 15\n\ts_nop 7":"+v"(pA0),"+v"(pA1));CMASK0(pA0,pA1,0);
  START(pA0,pA1);
  _Pragma("unroll") for(int r=0;r<16;++r)pA1[r]=__builtin_amdgcn_exp2f(pA1[r]);
  WAIT_BAR(0);
  DMA_K(3,0);DMA_V(1,SLOTB);
  ROT();
  kload8(kf,kp0+sl_cur);
  WAIT_BAR(2);
  s16x4 vlo[8],vhi[8]; u32x4 pw0,pw1,pw2,pw3;
  #define PKW(P,B) cvtpk_s(P[B],P[B+1])
  #define PAF(k) __builtin_bit_cast(bf16x8,pw##k)
  #define VFR(i) (bf16x8){vlo[i][0],vlo[i][1],vlo[i][2],vlo[i][3],vhi[i][0],vhi[i][1],vhi[i][2],vhi[i][3]}
  #define PIN(x) asm volatile("":"+v"(x))
  #define MX3(a,b,c) __builtin_fmaxf(__builtin_fmaxf((a),(b)),(c))
  #define GAPA(MF,A0,A1,A2,A3,W0,W1,PW) do{ MF; sacc+=A0; sacc+=A1; sacc+=A2; sacc+=A3; PIN(sacc); W0; W1; PIN(PW); SBAR(); }while(0)
  #define EX(v) __builtin_amdgcn_exp2f(v)
  #define GAPB(MF,X,B) do{ MF; X[B]=EX(X[B]); X[B+1]=EX(X[B+1]); X[B+2]=EX(X[B+2]); X[B+3]=EX(X[B+3]); PIN(X); SBAR(); }while(0)
  #define VRD(i) do{ vlo[i]=vtr(vp_+(((i)>>2)*4096+((i)&3)*1024)); vhi[i]=vtr(vp_+(((i)>>2)*4096+((i)&3)*1024+512)); }while(0)
  #define KRD(G,j) do{ if(G){ kload2(kf,kp0+sl_next,j); SBAR(); } }while(0)
  #define STEP(C0,C1,P0,P1,t,GK,GV,GL) do{ SBAR(); \
    const lds_cptr vp_=vp0+sl_prev; \
    { const unsigned w_=(hi==0)?((__float_as_uint(-mhat)>>16)|(((selm>>((t)>>2))&1u)?0u:0xC6000000u)):0u; const bf16x8 qaug=__builtin_bit_cast(bf16x8,(u32x4){w_,0u,0u,0u}); \
      C0=__builtin_amdgcn_mfma_f32_32x32x16_bf16(kones,qaug,zero16,0,0,0); C1=__builtin_amdgcn_mfma_f32_32x32x16_bf16(kones,qaug,zero16,0,0,0); } \
    VRD(0); SBAR(); float sacc=(P0[0]+P0[1]); \
    GAPA(C0=__builtin_amdgcn_mfma_f32_32x32x16_bf16(kf[0],qr[0],C0,0,0,0), P0[2],P0[3],P0[4],P0[5],     pw0[0]=PKW(P0,0), pw0[1]=PKW(P0,2), pw0); \
    VRD(4); SBAR(); GAPA(C1=__builtin_amdgcn_mfma_f32_32x32x16_bf16(kf[1],qr[0],C1,0,0,0), P0[6],P0[7],P0[8],P0[9],     pw0[2]=PKW(P0,4), pw0[3]=PKW(P0,6), pw0); \
    VRD(1); SBAR(); GAPA(C0=__builtin_amdgcn_mfma_f32_32x32x16_bf16(kf[2],qr[1],C0,0,0,0),   P0[10],P0[11],P0[12],P0[13], pw1[0]=PKW(P0,8), pw1[1]=PKW(P0,10), pw1); \
    VRD(5); SBAR(); GAPA(C1=__builtin_amdgcn_mfma_f32_32x32x16_bf16(kf[3],qr[1],C1,0,0,0),   P0[14],P0[15],P1[0],P1[1],   pw1[2]=PKW(P0,12),pw1[3]=PKW(P0,14), pw1); \
    VRD(2); SBAR(); GAPA(C0=__builtin_amdgcn_mfma_f32_32x32x16_bf16(kf[4],qr[2],C0,0,0,0),   P1[2],P1[3],P1[4],P1[5],     pw2[0]=PKW(P1,0), pw2[1]=PKW(P1,2), pw2); \
    VRD(6); SBAR(); GAPA(C1=__builtin_amdgcn_mfma_f32_32x32x16_bf16(kf[5],qr[2],C1,0,0,0),   P1[6],P1[7],P1[8],P1[9],     pw2[2]=PKW(P1,4), pw2[3]=PKW(P1,6), pw2); \
    VRD(3); SBAR(); GAPA(C0=__builtin_amdgcn_mfma_f32_32x32x16_bf16(kf[6],qr[3],C0,0,0,0),   P1[10],P1[11],P1[12],P1[13], pw3[0]=PKW(P1,8), pw3[1]=PKW(P1,10), pw3); \
    VRD(7); SBAR(); GAPA(C1=__builtin_amdgcn_mfma_f32_32x32x16_bf16(kf[7],qr[3],C1,0,0,0),   P1[14],P1[15],0.f,0.f,       pw3[2]=PKW(P1,12),pw3[3]=PKW(P1,14), pw3); \
    l_reg+=sacc; \
    if(GK){DMA_K((t)+3,sl_cur);} if(GV){DMA_V((t)+1,sl_next);} \
    CMASK(C0,C1,t); \
    { float a=MX3(C0[0],C0[1],C1[0]),b=MX3(C0[2],C0[3],C1[1]); a=MX3(a,C1[2],C1[3]); \
      _Pragma("unroll") for(int r=4;r<16;r+=4){a=MX3(a,C0[r],C0[r+1]);b=MX3(b,C0[r+2],C0[r+3]);a=MX3(a,C1[r],C1[r+1]);b=MX3(b,C1[r+2],C1[r+3]);} \
      float rm=__builtin_fmaxf(a,b); { auto rr=__builtin_amdgcn_permlane32_swap(__float_as_uint(rm),__float_as_uint(rm),false,false); rm=__builtin_fmaxf(__uint_as_float(rr[0]),__uint_as_float(rr[1])); } \
      resc=false; \
      if(__builtin_expect(__any(rm>(float)THRL),0)){ const float dl=__builtin_ceilf(__builtin_fmaxf(rm,0.f)); mhat+=dl; \
        _Pragma("unroll") for(int r=0;r<16;++r){C0[r]-=dl;C1[r]-=dl;} \
        const float f=__builtin_amdgcn_exp2f(-dl); l_reg*=f; if(hi==0)wsf[r32]=f; resc=true; } } \
    SBAR(); \
    GAPB(o[0]=__builtin_amdgcn_mfma_f32_32x32x16_bf16(PAF(0),VFR(0),o[0],0,0,0), C0,0); \
    GAPB(o[1]=__builtin_amdgcn_mfma_f32_32x32x16_bf16(PAF(0),VFR(4),o[1],0,0,0), C0,4); \
    KRD(GL,0); GAPB(o[0]=__builtin_amdgcn_mfma_f32_32x32x16_bf16(PAF(1),VFR(1),o[0],0,0,0), C0,8); \
    KRD(GL,1); GAPB(o[1]=__builtin_amdgcn_mfma_f32_32x32x16_bf16(PAF(1),VFR(5),o[1],0,0,0), C0,12); \
    KRD(GL,2); GAPB(o[0]=__builtin_amdgcn_mfma_f32_32x32x16_bf16(PAF(2),VFR(2),o[0],0,0,0), C1,0); \
    KRD(GL,3); GAPB(o[1]=__builtin_amdgcn_mfma_f32_32x32x16_bf16(PAF(2),VFR(6),o[1],0,0,0), C1,4); \
    GAPB(o[0]=__builtin_amdgcn_mfma_f32_32x32x16_bf16(PAF(3),VFR(3),o[0],0,0,0), C1,8); \
    GAPB(o[1]=__builtin_amdgcn_mfma_f32_32x32x16_bf16(PAF(3),VFR(7),o[1],0,0,0), C1,12); \
    }while(0)
  int t=1;
  #undef CMASK
  #define CMASK(P0,P1,t) do{}while(0)
  for(;t+5<NT;t+=2){
    STEP(pB0,pB1,pA0,pA1,t,true,true,true);     WAIT_BAR(2); RESC(); ROT();
    STEP(pA0,pA1,pB0,pB1,t+1,true,true,true);   WAIT_BAR(2); RESC(); ROT();
  }
  #undef CMASK
  #define CMASK(P0,P1,t) do{int jb_=(t)-(NT-4); if(jb_>=0)cmask(P0,P1,jb_,qrel,hi);}while(0)
  #define ENDW(tt) do{ if((tt)+3<NT){WAIT_BAR(2);} else if((tt)+2<NT){WAIT_BAR(1);} else {WAIT_BAR(0);} }while(0)
  for(;t+1<NT;t+=2){
    STEP(pB0,pB1,pA0,pA1,t,(t+3<NT),(t+1<NT),(t+1<NT));       ENDW(t);   RESC(); ROT();
    STEP(pA0,pA1,pB0,pB1,t+1,(t+4<NT),(t+2<NT),(t+2<NT));     ENDW(t+1); RESC(); ROT();
  }
  STEP(pB0,pB1,pA0,pA1,NT-1,false,false,false); RESC();
  { float sacc=pB0[0]+pB0[1]; _Pragma("unroll") for(int r=2;r<16;++r)sacc+=pB0[r]; _Pragma("unroll") for(int r=0;r<16;++r)sacc+=pB1[r]; l_reg+=sacc;
    pw0=(u32x4){PKW(pB0,0),PKW(pB0,2),PKW(pB0,4),PKW(pB0,6)};pw1=(u32x4){PKW(pB0,8),PKW(pB0,10),PKW(pB0,12),PKW(pB0,14)};pw2=(u32x4){PKW(pB1,0),PKW(pB1,2),PKW(pB1,4),PKW(pB1,6)};pw3=(u32x4){PKW(pB1,8),PKW(pB1,10),PKW(pB1,12),PKW(pB1,14)};
    SBAR(); pv(o,vb0+sl_cur,PAF(0),PAF(1),PAF(2),PAF(3)); }
  #undef PKW
  #undef PAF
  #undef VFR
  #undef PIN
  #undef MX3
  #undef GAPA
  #undef GAPB
  #undef EX
  #undef VRD
  #undef KRD
  #undef STEP
  #undef ENDW
  {auto rr=__builtin_amdgcn_permlane32_swap(__float_as_uint(l_reg),__float_as_uint(l_reg),false,false);l_reg=__uint_as_float(rr[0])+__uint_as_float(rr[1]);}
  if(hi==0)wsf[32+r32]=l_reg;asm volatile("s_waitcnt lgkmcnt(0)":::"memory");
  float rli[16];
  #pragma unroll
  for(int r=0;r<16;++r)rli[r]=__builtin_amdgcn_rcpf(wsf[32+crow(r,hi)]);
  bf16*Ow=O+(rowbase+q0+wid*QBLK)*OPITCH+h*D;
  { bf16*stg=(bf16*)(shm+LDS_OST)+wid*2048;
    #pragma unroll
    for(int r=0;r<16;++r){const int orow=crow(r,hi);
      #pragma unroll
      for(int d0=0;d0<2;++d0)stg[orow*64+d0*32+r32]=__float2bfloat16(o[d0][r]*rli[r]);}
    asm volatile("s_waitcnt lgkmcnt(0)":::"memory");
    #pragma unroll
    for(int i=0;i<4;++i){const int row=i*8+(lane>>3),ch=lane&7; const u32x4 v=*(const u32x4*)(stg+row*64+ch*8); ATTN_STORE16(Ow+(long)row*OPITCH+ch*8,v);} }
  asm volatile("s_waitcnt lgkmcnt(0)\n\ts_barrier":::"memory");
  #undef DMA_K
  #undef DMA_V
  #undef CMASK
  #undef START
  #undef RESC
  #undef ROT
}
#undef SBAR
#undef WAIT_BAR
}
#define LAS __attribute__((address_space(3)))
typedef unsigned short bf16u;
typedef unsigned v4u __attribute__((ext_vector_type(4)));
typedef float f32x4g __attribute__((ext_vector_type(4)));
typedef short bf16x8g __attribute__((ext_vector_type(8)));
typedef float f32x16g __attribute__((ext_vector_type(16)));

constexpr int MTOK = 65536, SEQL = 2048, DMODEL = 1024, DIN = 5632, DFF = 2816;
constexpr float NEPS = 1e-6f;
constexpr size_t MiB = 1u << 20;
constexpr size_t WS_CTL = 0, WS_ROPE = 1 * MiB, WS_KMEAN = 1 * MiB + 512 * 1024, WS_WIN = 2 * MiB, WS_WA = 13 * MiB, WS_WB = 14 * MiB, WS_WOUT = 15 * MiB, WS_WUP = 17 * MiB, WS_WDN = 28 * MiB;
constexpr size_t WS_XN = 34 * MiB, WS_OA = 34 * MiB, WS_OB = 98 * MiB, WS_BIG = 162 * MiB;
constexpr size_t WS_HG = WS_BIG, WS_QKV = WS_BIG + 256 * MiB, WS_GT = WS_BIG + 448 * MiB, WS_MIX = WS_BIG, WS_UV = WS_BIG, WS_G = WS_BIG + 352 * MiB, WS_END = WS_BIG + 704 * MiB + 24 * MiB;
constexpr size_t WS_UFIRST = WS_BIG + 704 * MiB, WS_VFIRST = WS_UFIRST + 8 * MiB, WS_ULAST = WS_UFIRST + 16 * MiB;
constexpr int RING_BYTES = 131072, MISC_OFF = RING_BYTES + 320, LDS_BYTES = 149504, XCH_OFF = RING_BYTES + 512;
constexpr int NWAVES = 8;
constexpr int CW_BAR = 4096;
constexpr size_t WS_ROWSS = 512 * 1024;

__device__ __forceinline__ unsigned f2bf(float f) { unsigned u = __builtin_bit_cast(unsigned, f); return (u + 0x7fffu + ((u >> 16) & 1u)) >> 16; }
__device__ __forceinline__ unsigned pk2(float lo, float hi) { return pg8::cvt_pk_bf16(lo, hi); }
__device__ __forceinline__ float b2f(unsigned h) { return __uint_as_float(h << 16); }
__device__ __forceinline__ float wave_sum(float v) {
#pragma unroll
    for (int o = 1; o < 64; o <<= 1) v += __shfl_xor(v, o);
    return v;
}
#define LDS_WAIT() asm volatile("s_waitcnt lgkmcnt(0)" ::: "memory")

template <int REMAP, int TILED = 0> __device__ __forceinline__ void p0_transpose_item(const float* W, int K, int N, bf16u* WT, LAS float* scr, int item, int lane, const float* kscale = nullptr, int ldk = 0, int koff = 0) {
    const int nblk = N / 32, kb = item / nblk, nb = item % nblk, k0 = 64 * kb, n0 = 32 * nb;
    int nr = n0;
    if (REMAP == 2) { if (n0 >= 2048 && n0 < 3072) { const int o = n0 - 2048; nr = 2048 + (o & ~255) + 128 * ((o >> 5) & 1) + 32 * ((o >> 6) & 3); }
                      else if (n0 >= 3584) { const int o = (n0 - 3584) & 1023; nr = 3584 + (o >> 7) * 256 + (n0 >= 4608 ? 128 : 0) + (o & 127); } }
    else if (REMAP) { nr = (n0 < DFF) ? ((n0 >> 7) * 256 + (n0 & 127)) : (((n0 - DFF) >> 7) * 256 + 128 + ((n0 - DFF) & 127)); }
    float wv_[32];
#pragma unroll
    for (int i = 0; i < 32; ++i) { const int kk = 2 * i + (lane >> 5); wv_[i] = W[(size_t)(k0 + kk) * N + n0 + (lane & 31)] * (kscale ? kscale[k0 + kk] : 1.0f); }
#pragma unroll
    for (int i = 0; i < 32; ++i) { const int kk = 2 * i + (lane >> 5); scr[kk * 33 + (lane & 31)] = wv_[i]; }
    LDS_WAIT(); asm volatile("" ::: "memory");
    const int c = lane & 7;
#pragma unroll
    for (int j = 0; j < 4; ++j) { const int n = (lane >> 3) + 8 * j; const LAS float* s = scr + (8 * c) * 33 + n;
        v4u o; o.x = pk2(s[0 * 33], s[1 * 33]); o.y = pk2(s[2 * 33], s[3 * 33]); o.z = pk2(s[4 * 33], s[5 * 33]); o.w = pk2(s[6 * 33], s[7 * 33]);
        const int row_ = nr + n;
        if (TILED) *(v4u*)(WT + (size_t)(row_ >> 8) * 256 * K + (size_t)kb * 16384 + (row_ & 255) * 64 + 8 * c) = o;
        else *(v4u*)(WT + (size_t)row_ * (ldk ? ldk : K) + koff + k0 + 8 * c) = o; }
    LDS_WAIT(); asm volatile("" ::: "memory");
}
template <int R, int TILED = 0> __device__ __forceinline__ void rms_rows_to_bf16(const float* xrow, const float* g, bf16u* orow, int lane, int row0 = 0) {
    const f32x4g* gr = (const f32x4g*)g + lane;
    f32x4g v[R][4]; float s[R];
#pragma unroll
    for (int r = 0; r < R; ++r) { const f32x4g* xr = (const f32x4g*)(xrow + (size_t)r * DMODEL) + lane;
#pragma unroll
        for (int j = 0; j < 4; ++j) v[r][j] = xr[64 * j]; }
#pragma unroll
    for (int r = 0; r < R; ++r) { float a = 0.f;
#pragma unroll
        for (int j = 0; j < 4; ++j) a += (v[r][j].x * v[r][j].x + v[r][j].y * v[r][j].y) + (v[r][j].z * v[r][j].z + v[r][j].w * v[r][j].w);
        s[r] = 1.0f / sqrtf(wave_sum(a) * (1.f / DMODEL) + NEPS); }
#pragma unroll
    for (int j = 0; j < 4; ++j) { const f32x4g gg = gr[64 * j];
#pragma unroll
        for (int r = 0; r < R; ++r) { unsigned long long* o8 = (unsigned long long*)(orow + (size_t)r * DMODEL) + lane;
            if (TILED) { const int m_ = row0 + r; o8 = (unsigned long long*)(orow + (size_t)(m_ >> 8) * 256 * DMODEL + (size_t)(4 * j + (lane >> 4)) * 16384 + (m_ & 255) * 64 + 4 * (lane & 15)) - 64 * j; }
            o8[64 * j] = (unsigned long long)pk2(v[r][j].x * s[r] * gg.x, v[r][j].y * s[r] * gg.y) | ((unsigned long long)pk2(v[r][j].z * s[r] * gg.z, v[r][j].w * s[r] * gg.w) << 32); } }
}

__device__ __forceinline__ void qk_one(v4u raw, const float (&g)[8], const float (&cs)[8], const float (&sn)[8], int c, float scale, float (&out)[8]) {
    float x[8];
#pragma unroll
    for (int i = 0; i < 4; ++i) { x[2 * i] = b2f(raw[i] & 0xffffu); x[2 * i + 1] = b2f(raw[i] >> 16); }
    float ss = 0.f;
#pragma unroll
    for (int e = 0; e < 8; ++e) ss += x[e] * x[e];
    ss += __shfl_xor(ss, 1); ss += __shfl_xor(ss, 2); ss += __shfl_xor(ss, 4);
    const float rstd = 1.0f / sqrtf(ss * (1.f / 64.f) + NEPS);
#pragma unroll
    for (int e = 0; e < 8; ++e) { const float y = x[e] * rstd * g[e]; const float py = __shfl_xor(y, 4);
        out[e] = ((c < 4) ? (y * cs[e] - py * sn[e]) : (y * cs[e] + py * sn[e])) * scale; }
}
__device__ __forceinline__ void qk_prep_item(int b, int kb, bf16u* QKV, const float* qg, const float* kg, const float* rope, float* kmean, LAS float* scr, int tid) {
    const int r8 = tid >> 6, cc = tid & 63, hh = cc >> 3, c = cc & 7;
    float gq[8], gk[8], ks[8];
#pragma unroll
    for (int e = 0; e < 8; ++e) { gq[e] = qg[8 * c + e]; gk[e] = kg[8 * c + e]; ks[e] = 0.f; }
    const size_t rowbase = (size_t)b * SEQL + (size_t)kb * 256;
    for (int i = 0; i < 32; ++i) {
        const int rl = i * 8 + r8, pos = kb * 256 + rl;
        bf16u* prow = QKV + (rowbase + rl) * 1536 + hh * 64 + 8 * c;
        const v4u qv = *(const v4u*)prow; const v4u kv = *(const v4u*)(prow + 512);
        const f32x4g* tp = (const f32x4g*)(rope + ((size_t)pos * 32 + 8 * (c & 3)) * 2);
        float cs[8], sn[8];
#pragma unroll
        for (int j = 0; j < 4; ++j) { const f32x4g t = tp[j]; cs[2 * j] = t.x; sn[2 * j] = t.y; cs[2 * j + 1] = t.z; sn[2 * j + 1] = t.w; }
        float oq[8], ok[8];
        qk_one(qv, gq, cs, sn, c, 0.125f * 1.4426950408889634f, oq);
        qk_one(kv, gk, cs, sn, c, 1.0f, ok);
#pragma unroll
        for (int e = 0; e < 8; ++e) ks[e] += ok[e];
        v4u wq, wk;
#pragma unroll
        for (int j = 0; j < 4; ++j) { wq[j] = pk2(oq[2 * j], oq[2 * j + 1]); wk[j] = pk2(ok[2 * j], ok[2 * j + 1]); }
        *(v4u*)prow = wq; *(v4u*)(prow + 512) = wk;
    }
#pragma unroll
    for (int e = 0; e < 8; ++e) scr[(r8 * 64 + cc) * 8 + e] = ks[e];
    __syncthreads();
    { const int col = tid; float s = 0.f;
#pragma unroll
      for (int r = 0; r < 8; ++r) s += scr[(r * 64 + (col >> 3)) * 8 + (col & 7)];
      kmean[(((size_t)b * 8 + (col >> 6)) * 8 + kb) * 64 + (col & 63)] = s * (1.f / 256.f); }
    __syncthreads();
}

constexpr int H_QS = 136, H_SS = 72;
constexpr int L_QE = 0, L_KE = 17408, L_KET = 34816, L_VT = 53248, L_STP = 71680, L_A = 106496, L_TOT = 115712, L_SSB = 117760;
__device__ __forceinline__ int crowg(int r, int hi) { return (r & 3) + 8 * (r >> 2) + 4 * hi; }
#define MFMA32(a, b, c) __builtin_amdgcn_mfma_f32_32x32x16_bf16((a), (b), (c), 0, 0, 0)
#define HBAR() asm volatile("s_waitcnt lgkmcnt(0)\n\ts_barrier" ::: "memory")
__device__ __forceinline__ void hgrn_unit(int item, const bf16u* HG, const float* onorm_g, bf16u* OA, LAS unsigned char* lds, int tid) {
    asm volatile("" : "+v"(tid));
    const int b = item >> 2, h = item & 3;
    const int lane = tid & 63, w = __builtin_amdgcn_readfirstlane(tid >> 6), l31 = lane & 31, hi = lane >> 5;
    const int k = tid & 127, seg = tid >> 7;
    const int vb = w >> 1, tb = w & 1;
    LAS bf16u* QE = (LAS bf16u*)(lds + L_QE); LAS bf16u* KE = (LAS bf16u*)(lds + L_KE); LAS bf16u* KET = (LAS bf16u*)(lds + L_KET);
    LAS bf16u* VT = (LAS bf16u*)(lds + L_VT); LAS bf16u* STP = (LAS bf16u*)(lds + L_STP); LAS bf16u* AL = (LAS bf16u*)(lds + L_A);
    LAS float* TOT = (LAS float*)(lds + L_TOT); LAS float* SSB = (LAS float*)(lds + L_SSB);
    f32x16g st[2];
#pragma unroll
    for (int j = 0; j < 2; ++j)
#pragma unroll
        for (int r = 0; r < 16; ++r) st[j][r] = 0.f;
    unsigned rq[16], rl[16]; v4u rv[2];
#define HLOAD(cc) do { const size_t r0_ = (size_t)b * SEQL + (size_t)(cc) * 64; const bf16u* pq_ = HG + (r0_ + seg * 16) * 2048 + h * 128 + k; \
        _Pragma("unroll") for (int i = 0; i < 16; ++i) { rq[i] = pq_[(size_t)i * 2048]; rl[i] = pq_[(size_t)i * 2048 + 512]; } \
        _Pragma("unroll") for (int j = 0; j < 2; ++j) { const int id_ = tid + 512 * j; rv[j] = *(const v4u*)(HG + (r0_ + (id_ >> 4)) * 2048 + 1024 + h * 128 + (id_ & 15) * 8); } } while (0)
    HLOAD(0);
    for (int c = 0; c < 32; ++c) {
        const size_t row0 = (size_t)b * SEQL + (size_t)c * 64;
        v4u gvv[2];
#pragma unroll
        for (int j = 0; j < 2; ++j) { const int id = tid + 512 * j; gvv[j] = *(const v4u*)(HG + (row0 + (id >> 4)) * 2048 + 1536 + h * 128 + (id & 15) * 8); }
        float lf[16], qv[16], cs[16];
#pragma unroll
        for (int i = 0; i < 16; ++i) { qv[i] = b2f(rq[i]); lf[i] = b2f(rl[i]); }
        { float run = 0.f;
#pragma unroll
          for (int i = 0; i < 16; ++i) { run += lf[i]; cs[i] = run; }
          TOT[seg * 128 + k] = run; }
#pragma unroll
        for (int j = 0; j < 2; ++j) { const int id = tid + 512 * j, s = id >> 4, v0 = (id & 15) * 8; const v4u vv = rv[j];
            *(LAS v4u*)(VT + s * H_QS + v0) = vv; }
        if (c + 1 < 32) HLOAD(c + 1);
        HBAR();
        { const float t0 = TOT[k], t1 = TOT[128 + k], t2 = TOT[256 + k];
          const float mm = t0 + t1; const float p = (seg == 0) ? 0.f : (seg == 1) ? t0 : (seg == 2) ? mm : (mm + t2);
          unsigned kt[8];
#pragma unroll
          for (int ip = 0; ip < 8; ++ip) { const int s = seg * 16 + 2 * ip; const float c0 = p + cs[2 * ip], c1 = p + cs[2 * ip + 1];
              const float f0 = __expf(lf[2 * ip]), f1 = __expf(lf[2 * ip + 1]);
              const float qe0 = qv[2 * ip] * __expf(c0 - mm), qe1 = qv[2 * ip + 1] * __expf(c1 - mm), ke0 = (1.0f - f0) * __expf(mm - c0), ke1 = (1.0f - f1) * __expf(mm - c1);
              const unsigned pq = pk2(qe0, qe1), pk = pk2(ke0, ke1);
              QE[s * H_QS + k] = (bf16u)pq; QE[(s + 1) * H_QS + k] = (bf16u)(pq >> 16); KE[s * H_QS + k] = (bf16u)pk; KE[(s + 1) * H_QS + k] = (bf16u)(pk >> 16);
              kt[ip] = pk; }
          *(LAS v4u*)(KET + k * H_SS + seg * 16) = (v4u){kt[0], kt[1], kt[2], kt[3]};
          *(LAS v4u*)(KET + k * H_SS + seg * 16 + 8) = (v4u){kt[4], kt[5], kt[6], kt[7]}; }
#pragma unroll
        for (int j = 0; j < 2; ++j) { const int kk = (2 * (w & 1) + j) * 32 + l31; const float em = __expf(TOT[kk] + TOT[128 + kk]);
#pragma unroll
            for (int r = 0; r < 16; r += 2) { const unsigned pp = pk2(st[j][r] * em, st[j][r + 1] * em); const int v = vb * 32 + crowg(r, hi); STP[v * H_QS + kk] = (bf16u)pp; STP[(v + 1) * H_QS + kk] = (bf16u)(pp >> 16); } }
        HBAR();
        f32x16g o;
#pragma unroll
        for (int r = 0; r < 16; ++r) o[r] = 0.f;
#pragma unroll
        for (int ks = 0; ks < 8; ++ks) { const bf16x8g a = *(const LAS bf16x8g*)(STP + (vb * 32 + l31) * H_QS + ks * 16 + 8 * hi);
            const bf16x8g bq = *(const LAS bf16x8g*)(QE + (tb * 32 + l31) * H_QS + ks * 16 + 8 * hi); o = MFMA32(a, bq, o); }
        if (w < 4) { const int sb = vb; f32x16g A;
#pragma unroll
            for (int r = 0; r < 16; ++r) A[r] = 0.f;
            if (!(sb == 1 && tb == 0)) {
#pragma unroll
                for (int ks = 0; ks < 8; ++ks) { const bf16x8g a = *(const LAS bf16x8g*)(KE + (sb * 32 + l31) * H_QS + ks * 16 + 8 * hi);
                    const bf16x8g bq = *(const LAS bf16x8g*)(QE + (tb * 32 + l31) * H_QS + ks * 16 + 8 * hi); A = MFMA32(a, bq, A); } }
            const int t = tb * 32 + l31;
#pragma unroll
            for (int g = 0; g < 4; ++g) { const int s0 = sb * 32 + 8 * g + 4 * hi;
                const float a0 = (s0 + 0 <= t) ? A[4 * g + 0] : 0.f, a1 = (s0 + 1 <= t) ? A[4 * g + 1] : 0.f, a2 = (s0 + 2 <= t) ? A[4 * g + 2] : 0.f, a3 = (s0 + 3 <= t) ? A[4 * g + 3] : 0.f;
                typedef unsigned u2v __attribute__((ext_vector_type(2)));
                *(LAS u2v*)(AL + t * H_SS + s0) = (u2v){pk2(a0, a1), pk2(a2, a3)}; } }
        HBAR();
        { bf16x8g av[4];
#pragma unroll
          for (int ss = 0; ss < 4; ++ss)
#pragma unroll
              for (int e = 0; e < 8; ++e) av[ss][e] = (short)VT[(ss * 16 + 8 * hi + e) * H_QS + vb * 32 + l31];
#pragma unroll
          for (int ss = 0; ss < 4; ++ss) { const bf16x8g ba = *(const LAS bf16x8g*)(AL + (tb * 32 + l31) * H_SS + ss * 16 + 8 * hi); o = MFMA32(av[ss], ba, o); }
#pragma unroll
          for (int j = 0; j < 2; ++j) { const int kk = (2 * (w & 1) + j) * 32 + l31; f32x16g W;
#pragma unroll
              for (int r = 0; r < 16; ++r) W[r] = 0.f;
#pragma unroll
              for (int ss = 0; ss < 4; ++ss) { const bf16x8g bk = *(const LAS bf16x8g*)(KET + kk * H_SS + ss * 16 + 8 * hi); W = MFMA32(av[ss], bk, W); }
              const float mk = TOT[kk] + TOT[128 + kk], lastk = mk + TOT[256 + kk] + TOT[384 + kk];
              const float el = __expf(lastk), elm = __expf(lastk - mk);
#pragma unroll
              for (int r = 0; r < 16; ++r) st[j][r] = el * st[j][r] + elm * W[r]; } }
        { float q = 0.f;
#pragma unroll
          for (int r = 0; r < 16; ++r) q += o[r] * o[r];
          q += __shfl_xor(q, 32);
          if (hi == 0) SSB[vb * 64 + tb * 32 + l31] = q; }
        HBAR();
        { const int t = tb * 32 + l31; const float tot = (SSB[t] + SSB[64 + t]) + (SSB[128 + t] + SSB[192 + t]);
          const float rstd = 1.0f / sqrtf(tot * (1.f / 128.f) + NEPS);
#pragma unroll
          for (int g = 0; g < 4; ++g) { typedef unsigned u2w __attribute__((ext_vector_type(2)));
              *(LAS u2w*)(QE + t * H_QS + vb * 32 + 8 * g + 4 * hi) = (u2w){pk2(o[4 * g] * rstd, o[4 * g + 1] * rstd), pk2(o[4 * g + 2] * rstd, o[4 * g + 3] * rstd)}; } }
        HBAR();
#pragma unroll
        for (int j = 0; j < 2; ++j) { const int id = tid + 512 * j, t = id >> 4, v0 = (id & 15) * 8;
            const v4u ov = *(const LAS v4u*)(QE + t * H_QS + v0);
            const v4u gv = gvv[j];
            const f32x4g g0 = *(const f32x4g*)(onorm_g + h * 128 + v0), g1 = *(const f32x4g*)(onorm_g + h * 128 + v0 + 4);
            const float gn[8] = {g0.x, g0.y, g0.z, g0.w, g1.x, g1.y, g1.z, g1.w};
            v4u wv;
#pragma unroll
            for (int i = 0; i < 4; ++i) wv[i] = pk2(b2f(ov[i] & 0xffffu) * gn[2 * i] * b2f(gv[i] & 0xffffu), b2f(ov[i] >> 16) * gn[2 * i + 1] * b2f(gv[i] >> 16));
            *(v4u*)(OA + (row0 + t) * 1024 + h * 128 + v0) = wv; }
        HBAR();
    }
}

#undef HLOAD
#define GAS __attribute__((address_space(1)))
typedef GAS unsigned gu32;
#define XB_TMO      128
#define XB_XCNT(j)  (256  + 64 * (j))
#define XB_XSUB(j)  (1280 + 64 * (j))
#define XB_XGEN(j)  (2304 + 64 * (j))
#define XB_TOP      3328
#define XB_TOPGEN   3392
#define XCD_BAR_WORDS 3456
#define XB_SPIN_CAP (1u << 18)

__device__ __forceinline__ unsigned xb_ld(unsigned* p)              { return __hip_atomic_load(p, __ATOMIC_RELAXED, __HIP_MEMORY_SCOPE_AGENT); }
__device__ __forceinline__ unsigned xb_add(unsigned* p, unsigned v) { return __hip_atomic_fetch_add(p, v, __ATOMIC_RELAXED, __HIP_MEMORY_SCOPE_AGENT); }
__device__ __forceinline__ unsigned xb_xcc_id() { return (unsigned)__builtin_amdgcn_s_getreg((3 << 11) | 20) & 0xFu; }
#define XB_SPIN(cond, bar) do { unsigned _sp = 0; while (cond) { __builtin_amdgcn_s_sleep(1); \
    if ((++_sp & 255u) == 0u) { if (xb_ld(&(bar)[XB_TMO])) break; if (_sp > XB_SPIN_CAP) { atomicAdd(&(bar)[XB_TMO], 1u); break; } } } } while (0)

struct XcdBarrier {
    unsigned* bar; unsigned x;
    volatile LAS unsigned* st;
};

__device__ __forceinline__ XcdBarrier xcd_barrier_post(unsigned* bar, volatile LAS unsigned* st) {
    XcdBarrier b; b.bar = bar; b.x = xb_xcc_id(); b.st = st;
    if (threadIdx.x == 0) (void)xb_add(&bar[XB_XCNT(b.x)], 1u);
    return b;
}
__device__ __forceinline__ void xcd_barrier_complete(unsigned* bar, unsigned x, unsigned& nloc, unsigned& nx) {
    const unsigned G = gridDim.x * gridDim.y * gridDim.z;
    unsigned sum, cnt, mine, sp = 0u;
    for (;;) {
        sum = 0u; cnt = 0u; mine = 0u;
#pragma unroll
        for (unsigned j = 0; j < 16; ++j) { const unsigned c = xb_ld(&bar[XB_XCNT(j)]); sum += c; cnt += (c > 0u) ? 1u : 0u; mine = (j == x) ? c : mine; }
        if (sum == G) break;
        __builtin_amdgcn_s_sleep(1);
        if ((++sp & 255u) == 0u) { if (xb_ld(&bar[XB_TMO])) break; if (sp > XB_SPIN_CAP) { atomicAdd(&bar[XB_TMO], 1u); break; } }
    }
    nloc = mine > 0u ? mine : 1u; nx = cnt > 0u ? cnt : 1u;
}

__device__ __forceinline__ void xcd_barrier(const XcdBarrier& b) {
    asm volatile("s_waitcnt vmcnt(0)" ::: "memory");
    __syncthreads();
    if (threadIdx.x == 0) {
        unsigned* bar = b.bar;
        __builtin_amdgcn_s_waitcnt(0);
        unsigned nloc = b.st[0], nx = b.st[1];
        if (nloc == 0u) { xcd_barrier_complete(bar, b.x, nloc, nx); b.st[0] = nloc; b.st[1] = nx; }
        const unsigned old = xb_add(&bar[XB_XSUB(b.x)], 1u);
        const unsigned gen = old / nloc;
        if (old + 1u == (gen + 1u) * nloc) {
            __builtin_amdgcn_fence(__ATOMIC_RELEASE, "agent");
            asm volatile("s_waitcnt vmcnt(0)" ::: "memory");
            const unsigned og = xb_add(&bar[XB_TOP], 1u);
            const unsigned tg = og / nx;
            if (og + 1u == (tg + 1u) * nx) xb_add(&bar[XB_TOPGEN], 1u);
            else XB_SPIN(xb_ld(&bar[XB_TOPGEN]) == tg, bar);
            __builtin_amdgcn_fence(__ATOMIC_ACQUIRE, "agent");
            xb_add(&bar[XB_XGEN(b.x)], 1u);
            asm volatile("s_waitcnt vmcnt(0)" ::: "memory");
        } else {
            XB_SPIN(xb_ld(&bar[XB_XGEN(b.x)]) == gen, bar);
            __builtin_amdgcn_fence(__ATOMIC_ACQUIRE, "agent");
            asm volatile("s_waitcnt vmcnt(0)" ::: "memory");
        }
    }
    __syncthreads();
}

struct Args { const float* in[15]; float* out; unsigned char* ws; };
__global__ void __launch_bounds__(NWAVES * 64, 2) fwd_kernel(Args args) {
    extern __shared__ __attribute__((aligned(16))) unsigned char lds_raw[];
    cg::grid_group grid = cg::this_grid();
    LAS unsigned char* lds = (LAS unsigned char*)lds_raw;
    const int G = gridDim.x, bx = blockIdx.x;
    if (threadIdx.x < 32) ((volatile LAS unsigned*)(lds + MISC_OFF))[threadIdx.x] = 0u;
    __syncthreads();
#define PHASE_IDS int tid = threadIdx.x; asm volatile("" : "+v"(tid)); const int lane = tid & 63, wave = __builtin_amdgcn_readfirstlane(tid >> 6); const int gw = bx * NWAVES + wave, NGW = G * NWAVES; const int gt = bx * (NWAVES * 64) + tid, NGT = G * NWAVES * 64; (void)lane; (void)gw; (void)NGW; (void)gt; (void)NGT;
#define ws (args.ws)
#define X_IN (args.in[0])
#define norm1_g (args.in[1])
#define w_in (args.in[2])
#define lb_logits (args.in[3])
#define onorm_g (args.in[4])
#define qn_g (args.in[5])
#define kn_g (args.in[6])
#define w_a (args.in[7])
#define w_b (args.in[8])
#define w_out (args.in[9])
#define norm2_g (args.in[10])
#define w_up (args.in[11])
#define conv_w (args.in[12])
#define conv_b (args.in[13])
#define w_down (args.in[14])
#define OUT_P (args.out)
#define ctl ((unsigned*)(ws + WS_CTL))
#define rope ((float*)(ws + WS_ROPE))
#define kmean ((float*)(ws + WS_KMEAN))
#define Win_t ((bf16u*)(ws + WS_WIN))
#define Wa_t ((bf16u*)(ws + WS_WA))
#define Wb_t ((bf16u*)(ws + WS_WB))
#define Wout_t ((bf16u*)(ws + WS_WOUT))
#define Wup_t ((bf16u*)(ws + WS_WUP))
#define Wdn_t ((bf16u*)(ws + WS_WDN))
#define XN ((bf16u*)(ws + WS_XN))
#define OA ((bf16u*)(ws + WS_OA))
#define OB ((bf16u*)(ws + WS_OB))
#define HG ((bf16u*)(ws + WS_HG))
#define QKV ((bf16u*)(ws + WS_QKV))
#define GT ((bf16u*)(ws + WS_GT))
#define MIX ((bf16u*)(ws + WS_MIX))
#define UV ((bf16u*)(ws + WS_UV))
#define GB ((bf16u*)(ws + WS_G))

    { PHASE_IDS
        LAS float* scr = (LAS float*)(lds + wave * 16384);
        constexpr int I_IN = (DMODEL / 64) * (DIN / 32), I_A = (512 / 64) * (DMODEL / 32), I_OUT = (DMODEL / 64) * (DMODEL / 32), I_DN = (DFF / 64) * (DMODEL / 32);
        constexpr int NITEMS = 2 * I_IN + 2 * I_A + I_OUT + I_DN;
        for (int it = gw; it < NITEMS; it += NGW) {
            int r = it;
            if (r < I_IN) { p0_transpose_item<2, 1>(w_in, DMODEL, DIN, Win_t, scr, r, lane); continue; } r -= I_IN;
            if (r < I_IN) { p0_transpose_item<1>(w_up, DMODEL, DIN, Wup_t, scr, r, lane, norm2_g); continue; } r -= I_IN;
            if (r < I_A) { p0_transpose_item<0>(w_a, 512, DMODEL, Wa_t, scr, r, lane, nullptr, 1024, 0); continue; } r -= I_A;
            if (r < I_A) { p0_transpose_item<0>(w_b, 512, DMODEL, Wa_t, scr, r, lane, nullptr, 1024, 512); continue; } r -= I_A;
            if (r < I_OUT) { p0_transpose_item<0>(w_out, DMODEL, DMODEL, Wout_t, scr, r, lane); continue; } r -= I_OUT;
            p0_transpose_item<0>(w_down, DFF, DMODEL, Wdn_t, scr, r, lane);
        }
        for (int m = gw * 4; m < MTOK; m += NGW * 4) rms_rows_to_bf16<4, 1>(X_IN + (size_t)m * DMODEL, norm1_g, XN, lane, m);
        for (int e = gt; e < SEQL * 32; e += NGT) { const int pos = e >> 5, i = e & 31;
            const float inv = 1.0f / exp2f((float)i * (13.287712379549449f / 32.0f));
            const float ang = (float)pos * inv; float rv = ang * 0.15915494309189535f; rv -= floorf(rv);
            rope[2 * e] = __builtin_amdgcn_cosf(rv); rope[2 * e + 1] = __builtin_amdgcn_sinf(rv); }
        if (gt == 0) ctl[0] = 0u;
        for (int e = gt; e < MTOK; e += NGT) ((float*)(ws + WS_ROWSS))[e] = 0.f;
        for (int e = gt; e < 32 * 8 * 8 * 64; e += NGT) kmean[e] = 0.f;
        if (bx == 0) for (int i = tid; i < XCD_BAR_WORDS; i += NWAVES * 64) ctl[CW_BAR + i] = 0u;
    }
    grid.sync();
    XcdBarrier xbar = xcd_barrier_post(ctl + CW_BAR, (volatile LAS unsigned*)(lds + MISC_OFF) + 8);

    {
        pg8::Gemm g{XN, Win_t, MTOK, DIN, DMODEL}; pg8::StaticOrder S; S.init(MTOK, DIN, G, bx);
        pg8::EpiInProj E{HG, QKV, GT, lb_logits, qn_g, kn_g, rope, kmean};
        pg8::gemm_phase<pg8::EpiInProj, pg8::StaticOrder, PG8_ALIGN, PG8_SP2, true>(lds, g, S, E);
    }
    xcd_barrier(xbar);

    { PHASE_IDS
        volatile LAS unsigned* MISC = (volatile LAS unsigned*)(lds + MISC_OFF);
        for (;;) {
            if (tid == 0) MISC[0] = __hip_atomic_fetch_add(ctl, 1u, __ATOMIC_RELAXED, __HIP_MEMORY_SCOPE_AGENT);
            __syncthreads();
            const int item = (int)MISC[0];
            __syncthreads();
            if (item >= 128 + 2048) break;
            if (item < 128) hgrn_unit(item, HG, onorm_g, OA, lds, tid);
            else { const int j = item - 128, qb = 7 - (j >> 8), bh = j & 255;
                attn_body::attn_unit<8>(bh >> 3, bh & 7, qb, (const attn_body::bf16*)QKV, (const attn_body::bf16*)(QKV + 512), (const attn_body::bf16*)(QKV + 1024), (attn_body::bf16*)(OA + 512), kmean, (char*)lds_raw); }
        }
    }
    xcd_barrier(xbar);

    {
        pg8::Gemm g{OA, Wa_t, MTOK, DMODEL, DMODEL}; pg8::StaticOrder S; S.init(MTOK, DMODEL, G, bx);
        pg8::EpiMix E{MIX, GT};
        pg8::gemm_phase<pg8::EpiMix, pg8::StaticOrder, PG8_ALIGN, PG8_SP2>(lds, g, S, E);
    }
    xcd_barrier(xbar);

    {
        pg8::Gemm g{MIX, Wout_t, MTOK, DMODEL, DMODEL}; pg8::StaticOrder S; S.init(MTOK, DMODEL, G, bx);
        pg8::EpiResNorm E{X_IN, OUT_P, XN, (float*)(ws + WS_ROWSS)};
        pg8::gemm_phase<pg8::EpiResNorm, pg8::StaticOrder, PG8_ALIGN, PG8_SP2>(lds, g, S, E);
    }
    xcd_barrier(xbar);

    {
        pg8::Gemm g{XN, Wup_t, MTOK, DIN, DMODEL}; pg8::StaticOrder S; S.init(MTOK, DIN, G, bx);
        pg8::EpiUpConv E{GB, conv_w, conv_b, (float*)(ws + WS_UFIRST), (float*)(ws + WS_VFIRST), (float*)(ws + WS_ULAST), (LAS float*)(lds + XCH_OFF), (const float*)(ws + WS_ROWSS)};
        pg8::gemm_phase<pg8::EpiUpConv, pg8::StaticOrder, true, PG8_SP2>(lds, g, S, E);
    }
    xcd_barrier(xbar);
    { PHASE_IDS
        const float* ufirst = (const float*)(ws + WS_UFIRST); const float* vfirst = (const float*)(ws + WS_VFIRST); const float* ulast = (const float*)(ws + WS_ULAST);
        for (int idx = gt; idx < 256 * 2 * 352; idx += NGT) {
            const int pm = idx / 704, rem = idx - pm * 704, j = rem / 352, c0 = (rem - j * 352) * 8; const bool seq0 = (pm & 7) == 0;
            v4u wv;
#pragma unroll
            for (int i = 0; i < 4; ++i) { float rr[2];
#pragma unroll
                for (int hh = 0; hh < 2; ++hh) { const int c = c0 + 2 * i + hh;
                    const float uc = ufirst[(size_t)(pm * 2 + j) * DFF + c];
                    float um1, um2;
                    if (j == 0) { um1 = seq0 ? 0.f : ulast[(size_t)((pm - 1) * 2 + 1) * DFF + c]; um2 = seq0 ? 0.f : ulast[(size_t)((pm - 1) * 2 + 0) * DFF + c]; }
                    else { um1 = ufirst[(size_t)(pm * 2 + 0) * DFF + c]; um2 = seq0 ? 0.f : ulast[(size_t)((pm - 1) * 2 + 1) * DFF + c]; }
                    rr[hh] = conv_b[c] + conv_w[c] * um2 + conv_w[DFF + c] * um1 + conv_w[2 * DFF + c] * uc; }
                const pg8::f32x2 gl = pg8::gelu_pk((pg8::f32x2){rr[0], rr[1]});
                wv[i] = pk2(gl.x * vfirst[(size_t)(pm * 2 + j) * DFF + c0 + 2 * i], gl.y * vfirst[(size_t)(pm * 2 + j) * DFF + c0 + 2 * i + 1]); }
            *(v4u*)(GB + (size_t)(pm * 256 + j) * DFF + c0) = wv;
        }
    }
    xcd_barrier(xbar);

    {
        pg8::Gemm g{GB, Wdn_t, MTOK, DMODEL, DFF}; pg8::StaticOrder S; S.init(MTOK, DMODEL, G, bx);
        pg8::EpiResF32 E{OUT_P, OUT_P, DMODEL};
        pg8::gemm_phase<pg8::EpiResF32, pg8::StaticOrder, PG8_ALIGN, PG8_SP2>(lds, g, S, E);
    }
}

#undef ws
#undef X_IN
#undef norm1_g
#undef w_in
#undef lb_logits
#undef onorm_g
#undef qn_g
#undef kn_g
#undef w_a
#undef w_b
#undef w_out
#undef norm2_g
#undef w_up
#undef conv_w
#undef conv_b
#undef w_down
#undef OUT_P
#undef ctl
#undef rope
#undef kmean
#undef Win_t
#undef Wa_t
#undef Wb_t
#undef Wout_t
#undef Wup_t
#undef Wdn_t
#undef XN
#undef OA
#undef OB
#undef HG
#undef QKV
#undef GT
#undef MIX
#undef UV
#undef GB
extern "C" void kernel_launch(void* const* d_in, const int* in_sizes, int n_in, void* d_out, int out_size, void* d_ws, size_t ws_size, hipStream_t stream) {
    static int grid = 0;
    if (grid == 0) {
        if (n_in != 15 || out_size != MTOK * DMODEL || ws_size < WS_END) { fprintf(stderr, "kernel_launch: unexpected shapes (n_in %d out %d ws %zu)\n", n_in, out_size, ws_size); grid = -1; return; }
        int dev = 0, cus = 0, per_cu = 0;
        (void)hipGetDevice(&dev); (void)hipDeviceGetAttribute(&cus, hipDeviceAttributeMultiprocessorCount, dev);
        if (hipFuncSetAttribute((const void*)fwd_kernel, hipFuncAttributeMaxDynamicSharedMemorySize, LDS_BYTES) != hipSuccess) { fprintf(stderr, "kernel_launch: hipFuncSetAttribute failed\n"); grid = -1; return; }
        if (hipOccupancyMaxActiveBlocksPerMultiprocessor(&per_cu, (const void*)fwd_kernel, NWAVES * 64, LDS_BYTES) != hipSuccess || per_cu < 1) per_cu = 1;
        (void)hipGetLastError();
        grid = cus * 1;
        if (grid <= 0) grid = 256;
    }
    if (grid < 0) return;
    Args a{};
    for (int i = 0; i < 15; ++i) a.in[i] = (const float*)d_in[i];
    a.out = (float*)d_out; a.ws = (unsigned char*)d_ws;
    void* kargs[] = {&a};
    hipError_t e = hipLaunchCooperativeKernel((const void*)fwd_kernel, dim3(grid), dim3(NWAVES * 64), kargs, LDS_BYTES, stream);
    if (e != hipSuccess) fprintf(stderr, "kernel_launch: cooperative launch failed: %s (grid %d)\n", hipGetErrorString(e), grid);
}
```

```cpp
#include <hip/hip_runtime.h>
#include <hip/hip_cooperative_groups.h>
#include <cstdio>
#include <cstdint>
#include <type_traits>
namespace cg = cooperative_groups;
namespace pg8 {
#define PG8_LAS __attribute__((address_space(3)))
typedef unsigned short bf16_t;
typedef short bf16x8 __attribute__((ext_vector_type(8)));
typedef float f32x4 __attribute__((ext_vector_type(4)));
typedef unsigned u32x4 __attribute__((ext_vector_type(4)));
constexpr int BM = 256, BK = 64, HALF = 128, HTB = HALF * BK * 2  , STAGE_BYTES = 8 * HTB, NXCD = 8, WGM = 8;

__host__ __device__ __forceinline__ int lds_byte(int r, int c) { const int st = (r >> 4) * 2 + (c >> 5), rr = r & 15, cc = c & 31, ob = rr * 64 + cc * 2; return st * 1024 + (ob ^ (((ob >> 9) & 1) << 5)); }
__host__ __device__ __forceinline__ void stage_rc(int b, int& R, int& C) { const int st = b / 1024, sb = b % 1024, swz = sb ^ (((sb >> 9) & 1) << 5); R = (st >> 1) * 16 + swz / 64; C = (st & 1) * 32 + (swz % 64) / 2; }
__host__ __device__ __forceinline__ int perm32(int rho) { const int n = rho >> 4, i = rho & 15; return 8 * (i >> 2) + 4 * n + (i & 3); }

struct Unit { int pm, pn; };
struct Gemm { const bf16_t* A; const bf16_t* Bt; int M, N, K; };

struct StaticOrder {
    int nM, nN, nwg, G, c;
    __host__ __device__ void init(int M, int N, int G_, int c_) { nM = M / BM; nN = N / BM; nwg = nM * nN; G = G_; c = c_; }
    __host__ __device__ bool next(int i, Unit& u) const {
        const long L = (long)i * G + c; if (L >= nwg) return false;
        int wgid = (int)L; { const int q = nwg / NXCD, r = nwg % NXCD, xcd = wgid % NXCD, off = wgid / NXCD; wgid = (xcd < r ? xcd * (q + 1) : r * (q + 1) + (xcd - r) * q) + off; }
        const int nig = WGM * nN, gid = wgid / nig, fm = gid * WGM, gsz = (nM - fm) < WGM ? (nM - fm) : WGM;
        u.pm = fm + ((wgid % nig) % gsz); u.pn = (wgid % nig) / gsz; return true;
    }
    __device__ __forceinline__ void a_ready(const Unit&) const {}
    __device__ __forceinline__ void done(const Unit&) const {}
};

typedef float cvt_f32x2_t __attribute__((ext_vector_type(2))); typedef __bf16 cvt_bf16x2_t __attribute__((ext_vector_type(2)));
__device__ __forceinline__ unsigned cvt_pk_bf16(float lo, float hi) { const cvt_f32x2_t v = {lo, hi}; return __builtin_bit_cast(unsigned, __builtin_convertvector(v, cvt_bf16x2_t)); }
typedef float f32x2 __attribute__((ext_vector_type(2)));
__device__ __forceinline__ f32x2 gelu_pk(f32x2 v) {
    const f32x2 av = __builtin_elementwise_abs(v), d = av * 0.2316418882f + 1.0f;
    f32x2 t; t.x = __builtin_amdgcn_rcpf(d.x); t.y = __builtin_amdgcn_rcpf(d.y);
    f32x2 q = t * 0.5307027145f + (-0.7265760135f); q = q * t + 0.7107068705f; q = q * t + (-0.142248368f); q = q * t + 0.127414796f; q = q * t;
    const f32x2 s = (v * v) * (-0.72134752044f);
    f32x2 e; e.x = __builtin_amdgcn_exp2f(s.x); e.y = __builtin_amdgcn_exp2f(s.y);
    const f32x2 m = v * (q * e), r = v - m;
    f32x2 o; o.x = v.x < 0.f ? m.x : r.x; o.y = v.y < 0.f ? m.y : r.y; return o;
}

template <int ACT  > struct EpiBf16 {
    static constexpr bool PERM = true, AFTER_DRAIN = false; static_assert(ACT == 0 || ACT == 1, "EpiBf16: ACT is 0 (none) or 1 (gelu_pk)");
    bf16_t* O; int ldc; const float* bias; int split_cols; size_t split_stride; float scale0;
    __device__ __forceinline__ void operator()(const f32x4 (&acc)[2][2][4][2], const Unit& u, int wr, int wc, int fr, int fq) const {
        const int row0 = u.pm * BM + wr * 64 + fr; int colt = u.pn * BM; bf16_t* base = O;
        float sc = 1.f; if (split_cols) { const int t = colt / split_cols; base += (size_t)t * split_stride; colt -= t * split_cols; if (t == 0) sc = scale0; }
        const int col0 = colt + wc * 32 + 8 * fq, bcol0 = u.pn * BM + wc * 32 + 8 * fq;
        f32x4 bv[2][2];
#pragma unroll
        for (int bj = 0; bj < 2; ++bj)
#pragma unroll
            for (int n = 0; n < 2; ++n) bv[bj][n] = bias ? *(const f32x4*)(bias + bcol0 + bj * HALF + 4 * n) : (f32x4){0.f, 0.f, 0.f, 0.f};
#pragma unroll
        for (int ai = 0; ai < 2; ++ai)
#pragma unroll
            for (int m = 0; m < 4; ++m) { bf16_t* rowp = base + (size_t)(row0 + ai * HALF + m * 16) * ldc + col0;
#pragma unroll
                for (int bj = 0; bj < 2; ++bj) { f32x4 v0 = acc[ai][bj][m][0] + bv[bj][0], v1 = acc[ai][bj][m][1] + bv[bj][1];
                    if (ACT == 1) { f32x2 a = gelu_pk((f32x2){v0[0], v0[1]}), b = gelu_pk((f32x2){v0[2], v0[3]}), c = gelu_pk((f32x2){v1[0], v1[1]}), d = gelu_pk((f32x2){v1[2], v1[3]});
                        v0 = (f32x4){a.x, a.y, b.x, b.y}; v1 = (f32x4){c.x, c.y, d.x, d.y}; }
                    v0 = v0 * sc; v1 = v1 * sc; u32x4 w; w.x = cvt_pk_bf16(v0[0], v0[1]); w.y = cvt_pk_bf16(v0[2], v0[3]); w.z = cvt_pk_bf16(v1[0], v1[1]); w.w = cvt_pk_bf16(v1[2], v1[3]);
                    *(u32x4*)(rowp + bj * HALF) = w; } }
    }
};
__device__ __forceinline__ float bf2f(unsigned h) { return __uint_as_float(h << 16); }
__device__ __forceinline__ float sigm(float x) { return __builtin_amdgcn_rcpf(1.0f + __expf(-x)); }
struct EpiInProj {
    static constexpr bool PERM = true, AFTER_DRAIN = false;
    bf16_t* HG; bf16_t* QKV; bf16_t* GT; const float* lbl;
    const float* qg; const float* kg; const float* rope; float* kmean;
    __device__ __forceinline__ void operator()(const f32x4 (&acc)[2][2][4][2], const Unit& u, int wr, int wc, int fr, int fq) const {
        const int row0 = u.pm * BM + wr * 64 + fr; const int colt = u.pn * BM; const int seg = colt >> 9;
        bf16_t* base; int ldc, cb, mode;
        if (seg < 4) { base = HG; ldc = 2048; cb = colt; mode = (seg == 1) ? 1 : (seg == 2 ? 2 : 0); }
        else if (seg < 7) { base = QKV; ldc = 1536; cb = colt - 2048; mode = 2; }
        else { base = GT; ldc = 2048; cb = colt - 3584; mode = 3; }
        if (seg == 4 || seg == 5) {
            const bool isq = (seg == 4); const float* gn = isq ? qg : kg; const float sc = isq ? (0.125f * 1.4426950408889634f) : 1.0f;
            float g0[8], g1[8], ks0[8], ks1[8];
#pragma unroll
            for (int e = 0; e < 8; ++e) { g0[e] = gn[8 * fq + e] * sc; g1[e] = gn[32 + 8 * fq + e] * sc; ks0[e] = 0.f; ks1[e] = 0.f; }
            bf16_t* obase = QKV + cb + 64 * wc + 8 * fq;
#pragma unroll
            for (int ai = 0; ai < 2; ++ai)
#pragma unroll
                for (int m = 0; m < 4; ++m) { const int row = row0 + ai * HALF + m * 16; const int pos = row & 2047;
                    const f32x4 a0 = acc[ai][0][m][0], a1 = acc[ai][0][m][1], b0 = acc[ai][1][m][0], b1 = acc[ai][1][m][1];
                    const float v0[8] = {a0[0], a0[1], a0[2], a0[3], a1[0], a1[1], a1[2], a1[3]}, v1[8] = {b0[0], b0[1], b0[2], b0[3], b1[0], b1[1], b1[2], b1[3]};
                    float ss = 0.f;
#pragma unroll
                    for (int e = 0; e < 8; ++e) ss += v0[e] * v0[e] + v1[e] * v1[e];
                    ss += __shfl_xor(ss, 16); ss += __shfl_xor(ss, 32);
                    const float rstd = 1.0f / sqrtf(ss * (1.0f / 64.0f) + 1e-6f);
                    const f32x4* tp = (const f32x4*)(rope + ((size_t)pos * 32 + 8 * fq) * 2);
                    float o0[8], o1[8];
#pragma unroll
                    for (int j = 0; j < 4; ++j) { const f32x4 t = tp[j];
                        { const float y0 = v0[2 * j] * rstd * g0[2 * j], y1 = v1[2 * j] * rstd * g1[2 * j]; o0[2 * j] = y0 * t[0] - y1 * t[1]; o1[2 * j] = y1 * t[0] + y0 * t[1]; }
                        { const float y0 = v0[2 * j + 1] * rstd * g0[2 * j + 1], y1 = v1[2 * j + 1] * rstd * g1[2 * j + 1]; o0[2 * j + 1] = y0 * t[2] - y1 * t[3]; o1[2 * j + 1] = y1 * t[2] + y0 * t[3]; } }
                    if (!isq) {
#pragma unroll
                        for (int e = 0; e < 8; ++e) { ks0[e] += o0[e]; ks1[e] += o1[e]; } }
                    u32x4 w0, w1; w0.x = cvt_pk_bf16(o0[0], o0[1]); w0.y = cvt_pk_bf16(o0[2], o0[3]); w0.z = cvt_pk_bf16(o0[4], o0[5]); w0.w = cvt_pk_bf16(o0[6], o0[7]);
                    w1.x = cvt_pk_bf16(o1[0], o1[1]); w1.y = cvt_pk_bf16(o1[2], o1[3]); w1.z = cvt_pk_bf16(o1[4], o1[5]); w1.w = cvt_pk_bf16(o1[6], o1[7]);
                    *(u32x4*)(obase + (size_t)row * 1536) = w0; *(u32x4*)(obase + (size_t)row * 1536 + 32) = w1; }
            if (!isq) {
                const int head = ((colt - 2560) >> 6) + wc; float* km = kmean + ((size_t)((u.pm >> 3) * 8 + head) * 8 + (u.pm & 7)) * 64 + 8 * fq;
#pragma unroll
                for (int e = 0; e < 8; ++e) { float a = ks0[e], b = ks1[e];
                    a += __shfl_xor(a, 1); a += __shfl_xor(a, 2); a += __shfl_xor(a, 4); a += __shfl_xor(a, 8);
                    b += __shfl_xor(b, 1); b += __shfl_xor(b, 2); b += __shfl_xor(b, 4); b += __shfl_xor(b, 8);
                    if (fr == 0) { atomicAdd(km + e, a * (1.0f / 256.0f)); atomicAdd(km + 32 + e, b * (1.0f / 256.0f)); } } }
            return;
        }
        if (mode == 3) {
            bf16_t* gbase = GT + ((colt - 3584) >> 1) + wc * 32 + 8 * fq;
#pragma unroll
            for (int ai = 0; ai < 2; ++ai)
#pragma unroll
                for (int m = 0; m < 4; ++m) { bf16_t* rowp = gbase + (size_t)(row0 + ai * HALF + m * 16) * 2048;
                    const f32x4 a0 = acc[ai][0][m][0], a1 = acc[ai][0][m][1], b0 = acc[ai][1][m][0], b1 = acc[ai][1][m][1];
                    const float ga[8] = {a0[0], a0[1], a0[2], a0[3], a1[0], a1[1], a1[2], a1[3]}, gb[8] = {b0[0], b0[1], b0[2], b0[3], b1[0], b1[1], b1[2], b1[3]};
                    float rho[8], sb[8];
#pragma unroll
                    for (int i = 0; i < 8; ++i) { const float ea = 1.0f + __expf(-ga[i]), eb = 1.0f + __expf(-gb[i]); sb[i] = __builtin_amdgcn_rcpf(eb); rho[i] = eb * __builtin_amdgcn_rcpf(ea); }
                    u32x4 w0, w1; w0.x = cvt_pk_bf16(rho[0], rho[1]); w0.y = cvt_pk_bf16(rho[2], rho[3]); w0.z = cvt_pk_bf16(rho[4], rho[5]); w0.w = cvt_pk_bf16(rho[6], rho[7]);
                    w1.x = cvt_pk_bf16(sb[0], sb[1]); w1.y = cvt_pk_bf16(sb[2], sb[3]); w1.z = cvt_pk_bf16(sb[4], sb[5]); w1.w = cvt_pk_bf16(sb[6], sb[7]);
                    *(u32x4*)rowp = w0; *(u32x4*)(rowp + 1024) = w1; }
            return;
        }
        const int col0 = cb + wc * 32 + 8 * fq;
        if (mode == 0) tile_store<0>(acc, base, ldc, row0, col0, colt, wc, fq);
        else if (mode == 1) tile_store<1>(acc, base, ldc, row0, col0, colt, wc, fq);
        else if (mode == 2) tile_store<2>(acc, base, ldc, row0, col0, colt, wc, fq);
        else tile_store<3>(acc, base, ldc, row0, col0, colt, wc, fq);
    }
    template <int MODE> __device__ __forceinline__ void tile_store(const f32x4 (&acc)[2][2][4][2], bf16_t* base, int ldc, int row0, int col0, int colt, int wc, int fq) const {
        float lb[2][8];
#pragma unroll
        for (int bj = 0; bj < 2; ++bj)
#pragma unroll
            for (int e = 0; e < 8; ++e) lb[bj][e] = 0.f;
        if (MODE == 1) { const int c0 = colt - 512 + wc * 32 + 8 * fq;
#pragma unroll
            for (int bj = 0; bj < 2; ++bj)
#pragma unroll
                for (int e = 0; e < 8; ++e) lb[bj][e] = sigm(lbl[c0 + bj * HALF + e] - lbl[512 + c0 + bj * HALF + e]); }
#pragma unroll
        for (int ai = 0; ai < 2; ++ai)
#pragma unroll
            for (int m = 0; m < 4; ++m) { bf16_t* rowp = base + (size_t)(row0 + ai * HALF + m * 16) * ldc + col0;
#pragma unroll
                for (int bj = 0; bj < 2; ++bj) { const f32x4 a0 = acc[ai][bj][m][0], a1 = acc[ai][bj][m][1];
                    float v[8] = {a0[0], a0[1], a0[2], a0[3], a1[0], a1[1], a1[2], a1[3]};
                    if (MODE == 0) {
#pragma unroll
                        for (int e = 0; e < 8; ++e) v[e] = v[e] * sigm(v[e]);
                    } else if (MODE == 1) {
#pragma unroll
                        for (int e = 0; e < 8; ++e) { const float s = sigm(v[e]); v[e] = __logf(lb[bj][e] + (1.0f - lb[bj][e]) * s); }
                    } else if (MODE == 3) {
#pragma unroll
                        for (int e = 0; e < 8; ++e) v[e] = sigm(v[e]);
                    }
                    u32x4 w; w.x = cvt_pk_bf16(v[0], v[1]); w.y = cvt_pk_bf16(v[2], v[3]); w.z = cvt_pk_bf16(v[4], v[5]); w.w = cvt_pk_bf16(v[6], v[7]);
                    *(u32x4*)(rowp + bj * HALF) = w; } }
    }
};
template <int SECOND> struct EpiGateMix {
    static constexpr bool PERM = true, AFTER_DRAIN = false;
    bf16_t* O; const bf16_t* gate;
    __device__ __forceinline__ void operator()(const f32x4 (&acc)[2][2][4][2], const Unit& u, int wr, int wc, int fr, int fq) const {
        const int row0 = u.pm * BM + wr * 64 + fr; const int col0 = u.pn * BM + wc * 32 + 8 * fq;
#pragma unroll
        for (int ai = 0; ai < 2; ++ai)
#pragma unroll
            for (int m = 0; m < 4; ++m) { const size_t r = (size_t)(row0 + ai * HALF + m * 16);
#pragma unroll
                for (int bj = 0; bj < 2; ++bj) { const int c = col0 + bj * HALF;
                    const u32x4 g = *(const u32x4*)(gate + r * 2048 + c);
                    u32x4 p = (u32x4){0u, 0u, 0u, 0u}; if (SECOND) p = *(const u32x4*)(O + r * 1024 + c);
                    const f32x4 a0 = acc[ai][bj][m][0], a1 = acc[ai][bj][m][1];
                    float v[8] = {a0[0], a0[1], a0[2], a0[3], a1[0], a1[1], a1[2], a1[3]};
#pragma unroll
                    for (int i = 0; i < 4; ++i) { v[2 * i] = v[2 * i] * bf2f(g[i] & 0xffffu) + bf2f(p[i] & 0xffffu); v[2 * i + 1] = v[2 * i + 1] * bf2f(g[i] >> 16) + bf2f(p[i] >> 16); }
                    u32x4 w; w.x = cvt_pk_bf16(v[0], v[1]); w.y = cvt_pk_bf16(v[2], v[3]); w.z = cvt_pk_bf16(v[4], v[5]); w.w = cvt_pk_bf16(v[6], v[7]);
                    *(u32x4*)(O + r * 1024 + c) = w; } }
    }
};
struct EpiMix {
    static constexpr bool PERM = true, AFTER_DRAIN = false, HAS_MID = true;
    bf16_t* O; const bf16_t* gt;
    __device__ __forceinline__ void mid(f32x4 (&acc)[2][2][4][2], const Unit& u, int wr, int wc, int fr, int fq) const {
        int row0 = u.pm * BM + wr * 64 + fr; const int col0 = u.pn * BM + wc * 32 + 8 * fq;
        asm volatile("" : "+v"(row0));
#pragma unroll
        for (int ai = 0; ai < 2; ++ai)
#pragma unroll
            for (int m = 0; m < 4; ++m) { const size_t r = (size_t)(row0 + ai * HALF + m * 16);
#pragma unroll
                for (int bj = 0; bj < 2; ++bj) { const u32x4 g = *(const u32x4*)(gt + r * 2048 + col0 + bj * HALF);
                    acc[ai][bj][m][0] = acc[ai][bj][m][0] * (f32x4){bf2f(g[0] & 0xffffu), bf2f(g[0] >> 16), bf2f(g[1] & 0xffffu), bf2f(g[1] >> 16)};
                    acc[ai][bj][m][1] = acc[ai][bj][m][1] * (f32x4){bf2f(g[2] & 0xffffu), bf2f(g[2] >> 16), bf2f(g[3] & 0xffffu), bf2f(g[3] >> 16)}; }
                if (m & 1) asm volatile("" ::: "memory"); }
    }
    __device__ __forceinline__ void operator()(const f32x4 (&acc)[2][2][4][2], const Unit& u, int wr, int wc, int fr, int fq) const {
        const int row0 = u.pm * BM + wr * 64 + fr; const int col0 = u.pn * BM + wc * 32 + 8 * fq;
#pragma unroll
        for (int ai = 0; ai < 2; ++ai)
#pragma unroll
            for (int m = 0; m < 4; ++m) { const size_t r = (size_t)(row0 + ai * HALF + m * 16);
#pragma unroll
                for (int bj = 0; bj < 2; ++bj) { const int c = col0 + bj * HALF; const u32x4 g = *(const u32x4*)(gt + r * 2048 + 1024 + c);
                    const f32x4 v0 = acc[ai][bj][m][0] * (f32x4){bf2f(g[0] & 0xffffu), bf2f(g[0] >> 16), bf2f(g[1] & 0xffffu), bf2f(g[1] >> 16)};
                    const f32x4 v1 = acc[ai][bj][m][1] * (f32x4){bf2f(g[2] & 0xffffu), bf2f(g[2] >> 16), bf2f(g[3] & 0xffffu), bf2f(g[3] >> 16)};
                    u32x4 w; w.x = cvt_pk_bf16(v0[0], v0[1]); w.y = cvt_pk_bf16(v0[2], v0[3]); w.z = cvt_pk_bf16(v1[0], v1[1]); w.w = cvt_pk_bf16(v1[2], v1[3]);
                    *(u32x4*)(O + r * 1024 + c) = w; } }
    }
};
struct EpiResBf {
    static constexpr bool PERM = true, AFTER_DRAIN = false;
    const bf16_t* xb; float* out;
    __device__ __forceinline__ void operator()(const f32x4 (&acc)[2][2][4][2], const Unit& u, int wr, int wc, int fr, int fq) const {
        const int col0 = u.pn * BM + wc * 32 + 8 * fq;
#pragma unroll
        for (int ai = 0; ai < 2; ++ai)
#pragma unroll
            for (int m = 0; m < 4; ++m) { const size_t off = (size_t)(u.pm * BM + ai * HALF + wr * 64 + m * 16 + fr) * 1024 + col0;
#pragma unroll
                for (int bj = 0; bj < 2; ++bj) { const u32x4 g = *(const u32x4*)(xb + off + bj * HALF);
                    *(f32x4*)(out + off + bj * HALF) = acc[ai][bj][m][0] + (f32x4){bf2f(g[0] & 0xffffu), bf2f(g[0] >> 16), bf2f(g[1] & 0xffffu), bf2f(g[1] >> 16)};
                    *(f32x4*)(out + off + bj * HALF + 4) = acc[ai][bj][m][1] + (f32x4){bf2f(g[2] & 0xffffu), bf2f(g[2] >> 16), bf2f(g[3] & 0xffffu), bf2f(g[3] >> 16)}; } }
    }
};
struct EpiResF32 {
    static constexpr bool PERM = false, AFTER_DRAIN = false;
    const float* base; float* out; int ldc;
    __device__ __forceinline__ void operator()(const f32x4 (&acc)[2][2][4][2], const Unit& u, int wr, int wc, int fr, int fq) const {
        const int col0 = u.pn * BM + wc * 32 + 4 * fq;
#pragma unroll
        for (int ai = 0; ai < 2; ++ai)
#pragma unroll
            for (int m = 0; m < 4; ++m) { const size_t off = (size_t)(u.pm * BM + ai * HALF + wr * 64 + m * 16 + fr) * ldc + col0;
#pragma unroll
                for (int bj = 0; bj < 2; ++bj)
#pragma unroll
                    for (int n = 0; n < 2; ++n) { const f32x4 bs = *(const f32x4*)(base + off + bj * HALF + n * 16); *(f32x4*)(out + off + bj * HALF + n * 16) = bs + acc[ai][bj][m][n]; } }
    }
};

struct EpiResNorm {
    static constexpr bool PERM = true, AFTER_DRAIN = false;
    const float* base; float* out; bf16_t* xb; float* rowss;
    __device__ __forceinline__ void operator()(const f32x4 (&acc)[2][2][4][2], const Unit& u, int wr, int wc, int fr, int fq) const {
        const int col0 = u.pn * BM + wc * 32 + 8 * fq;
#pragma unroll
        for (int ai = 0; ai < 2; ++ai)
#pragma unroll
            for (int m = 0; m < 4; ++m) { const int row = u.pm * BM + ai * HALF + wr * 64 + m * 16 + fr; const size_t off = (size_t)row * 1024 + col0; float s = 0.f;
#pragma unroll
                for (int bj = 0; bj < 2; ++bj) { const f32x4 o0 = *(const f32x4*)(base + off + bj * HALF) + acc[ai][bj][m][0], o1 = *(const f32x4*)(base + off + bj * HALF + 4) + acc[ai][bj][m][1];
                    s += (o0[0] * o0[0] + o0[1] * o0[1]) + (o0[2] * o0[2] + o0[3] * o0[3]) + (o1[0] * o1[0] + o1[1] * o1[1]) + (o1[2] * o1[2] + o1[3] * o1[3]);
                    u32x4 w; w.x = cvt_pk_bf16(o0[0], o0[1]); w.y = cvt_pk_bf16(o0[2], o0[3]); w.z = cvt_pk_bf16(o1[0], o1[1]); w.w = cvt_pk_bf16(o1[2], o1[3]);
                    *(u32x4*)(xb + off + bj * HALF) = w; }
                s += __shfl_xor(s, 16); s += __shfl_xor(s, 32);
                if (fq == 0) atomicAdd(rowss + row, s); }
    }
};
__device__ __forceinline__ float dpp_shr1(float v) { return __builtin_bit_cast(float, __builtin_amdgcn_update_dpp(0, __builtin_bit_cast(int, v), 0x111, 0xf, 0xf, true)); }
__device__ __forceinline__ float dpp_shr2(float v) { return __builtin_bit_cast(float, __builtin_amdgcn_update_dpp(0, __builtin_bit_cast(int, v), 0x112, 0xf, 0xf, true)); }
__device__ __forceinline__ float dpp_shr1_old(float oldv, float v) { return __builtin_bit_cast(float, __builtin_amdgcn_update_dpp(__builtin_bit_cast(int, oldv), __builtin_bit_cast(int, v), 0x111, 0xf, 0xf, false)); }
__device__ __forceinline__ float dpp_shr2_old(float oldv, float v) { return __builtin_bit_cast(float, __builtin_amdgcn_update_dpp(__builtin_bit_cast(int, oldv), __builtin_bit_cast(int, v), 0x112, 0xf, 0xf, false)); }
struct EpiUpConv {
    static constexpr bool PERM = true, AFTER_DRAIN = false;
    bf16_t* G; const float* conv_w; const float* conv_b; float* ufirst; float* vfirst; float* ulast; PG8_LAS float* xch; const float* rowss;
    __device__ __forceinline__ void operator()(const f32x4 (&acc0)[2][2][4][2], const Unit& u, int wr, int wc, int fr, int fq) const {
        const int ch0 = u.pn * 128 + wc * 32 + 8 * fq;
        float w0[8], w1[8], w2[8], bb[8];
#pragma unroll
        for (int j = 0; j < 2; ++j) { const f32x4 a = *(const f32x4*)(conv_w + ch0 + 4 * j), b = *(const f32x4*)(conv_w + 2816 + ch0 + 4 * j), c = *(const f32x4*)(conv_w + 5632 + ch0 + 4 * j), d = *(const f32x4*)(conv_b + ch0 + 4 * j);
#pragma unroll
            for (int e = 0; e < 4; ++e) { w0[4 * j + e] = a[e]; w1[4 * j + e] = b[e]; w2[4 * j + e] = c[e]; bb[4 * j + e] = d[e]; } }
        f32x4 acc[2][2][4][2];
#pragma unroll
        for (int ai = 0; ai < 2; ++ai)
#pragma unroll
            for (int m = 0; m < 4; ++m) { const float rs = 1.0f / sqrtf(rowss[u.pm * BM + ai * HALF + wr * 64 + m * 16 + fr] * (1.0f / 1024.0f) + 1e-6f);
#pragma unroll
                for (int bj = 0; bj < 2; ++bj)
#pragma unroll
                    for (int n = 0; n < 2; ++n) acc[ai][bj][m][n] = acc0[ai][bj][m][n] * rs; }
        if (fr >= 14) {
#pragma unroll
            for (int ai = 0; ai < 2; ++ai)
#pragma unroll
                for (int m = 0; m < 4; ++m) { const int g = 4 * (2 * ai + wr) + m; PG8_LAS f32x4* p = (PG8_LAS f32x4*)(xch + (((g * 4 + wc) * 2 + (fr - 14)) * 4 + fq) * 8);
                    p[0] = acc[ai][0][m][0]; p[1] = acc[ai][0][m][1]; }
            if (wr == 1) { float* pl = ulast + (size_t)(u.pm * 2 + (fr - 14)) * 2816 + ch0; *(f32x4*)pl = acc[1][0][3][0]; *(f32x4*)(pl + 4) = acc[1][0][3][1]; }
        }
        if (wr == 0 && fr < 2) { float* pu = ufirst + (size_t)(u.pm * 2 + fr) * 2816 + ch0; *(f32x4*)pu = acc[0][0][0][0]; *(f32x4*)(pu + 4) = acc[0][0][0][1];
            float* pv = vfirst + (size_t)(u.pm * 2 + fr) * 2816 + ch0; *(f32x4*)pv = acc[0][1][0][0]; *(f32x4*)(pv + 4) = acc[0][1][0][1]; }
        asm volatile("s_waitcnt lgkmcnt(0)" ::: "memory"); __builtin_amdgcn_s_barrier(); asm volatile("" ::: "memory");
        const int row0 = u.pm * BM + wr * 64 + fr;
#pragma unroll
        for (int ai = 0; ai < 2; ++ai)
#pragma unroll
            for (int m = 0; m < 4; ++m) { const int g = 4 * (2 * ai + wr) + m; const int gp = (g > 0) ? g - 1 : 0;
                const PG8_LAS f32x4* xp = (const PG8_LAS f32x4*)(xch + (((gp * 4 + wc) * 2) * 4 + fq) * 8);
                const f32x4 xa0 = xp[0], xa1 = xp[1], xb0 = xp[8], xb1 = xp[9];
                const float X0[8] = {xa0[0], xa0[1], xa0[2], xa0[3], xa1[0], xa1[1], xa1[2], xa1[3]}, X1[8] = {xb0[0], xb0[1], xb0[2], xb0[3], xb1[0], xb1[1], xb1[2], xb1[3]};
                const f32x4 u0 = acc[ai][0][m][0], u1 = acc[ai][0][m][1], v0 = acc[ai][1][m][0], v1 = acc[ai][1][m][1];
                const float uu[8] = {u0[0], u0[1], u0[2], u0[3], u1[0], u1[1], u1[2], u1[3]}, vv[8] = {v0[0], v0[1], v0[2], v0[3], v1[0], v1[1], v1[2], v1[3]};
                float r[8];
#pragma unroll
                for (int e = 0; e < 8; e += 2) {
                    const float xs0 = (fr == 0) ? X0[e] : X1[e], xs1 = (fr == 0) ? X0[e + 1] : X1[e + 1];
                    const f32x2 P1 = {dpp_shr1_old(X1[e], uu[e]), dpp_shr1_old(X1[e + 1], uu[e + 1])}, P2 = {dpp_shr2_old(xs0, uu[e]), dpp_shr2_old(xs1, uu[e + 1])};
                    const f32x2 U = {uu[e], uu[e + 1]}, B = {bb[e], bb[e + 1]}, W0 = {w0[e], w0[e + 1]}, W1 = {w1[e], w1[e + 1]}, W2 = {w2[e], w2[e + 1]};
                    const f32x2 rr = B + W0 * P2 + W1 * P1 + W2 * U; r[e] = rr.x; r[e + 1] = rr.y; }
                u32x4 w;
#pragma unroll
                for (int i = 0; i < 4; ++i) { const f32x2 gl = gelu_pk((f32x2){r[2 * i], r[2 * i + 1]}); w[i] = cvt_pk_bf16(gl.x * vv[2 * i], gl.y * vv[2 * i + 1]); }
                *(u32x4*)(G + (size_t)(row0 + ai * HALF + m * 16) * 2816 + ch0) = w; }
    }
};

template <class T, class = void> struct epi_has_mid : std::false_type {};
template <class T> struct epi_has_mid<T, std::void_t<decltype(T::HAS_MID)>> : std::true_type {};
template <class Epi, class Sched, bool ALIGN_EPI = false, bool SP2 = false, bool TL = false>
__device__ __forceinline__ void gemm_phase(PG8_LAS unsigned char* lds, const Gemm g, const Sched& S, const Epi& E) {
    int tid_l = threadIdx.x; asm volatile("" : "+v"(tid_l));
    const int tid = tid_l, wid = __builtin_amdgcn_readfirstlane(tid >> 6), lane = tid & 63, wr = wid >> 2, wc = wid & 3, fr = lane & 15, fq = lane >> 4;
    const int K = g.K, nt = K / BK;
    unsigned voffA[2], voffB[2];
#pragma unroll
    for (int i = 0; i < 2; ++i) { int R, C; stage_rc(tid * 16 + i * 8192, R, C); const int Rb = Epi::PERM ? ((R & ~31) + perm32(R & 31)) : R;
        voffA[i] = (unsigned)(R * (TL ? BK : K) + C) * 2u; voffB[i] = (unsigned)(Rb * (TL ? BK : K) + C) * 2u; }
    const size_t kstep = TL ? (size_t)(BM * BK * 2) : (size_t)(BK * 2);
    const size_t hstep = TL ? (size_t)(HALF * BK * 2) : (size_t)HALF * K * 2;
    const size_t tstep = (size_t)BM * K * 2;
    const unsigned ldsw = (unsigned)wid * 1024u;
    const int aoff = lds_byte(wr * 64 + fr, fq * 8), boff = lds_byte(wc * 32 + fr, fq * 8);
#define PG8_SA(b, h) (((b) * 2 + (h)) * HTB)
#define PG8_SB(b, h) ((4 + (b) * 2 + (h)) * HTB)
#define PG8_STAGE(bufoff, gbase, voff) do { _Pragma("unroll") for (int _i = 0; _i < 2; ++_i) \
        __builtin_amdgcn_global_load_lds((const unsigned*)((const char*)(gbase) + (voff)[_i]), (PG8_LAS unsigned*)(lds + (bufoff) + ldsw + _i * 8192), 16, 0, 0); } while (0)
#define PG8_LDA(dst, b, h) do { _Pragma("unroll") for (int m = 0; m < 4; ++m) _Pragma("unroll") for (int k = 0; k < 2; ++k) dst[m][k] = *(const PG8_LAS bf16x8*)(lds + PG8_SA(b, h) + aoff + m * 2048 + k * 1024); } while (0)
#define PG8_LDB(dst, b, h) do { _Pragma("unroll") for (int n = 0; n < 2; ++n) _Pragma("unroll") for (int k = 0; k < 2; ++k) dst[n][k] = *(const PG8_LAS bf16x8*)(lds + PG8_SB(b, h) + boff + n * 2048 + k * 1024); } while (0)
#define PG8_MMA(ai, bj, At, Bt) do { __builtin_amdgcn_s_setprio(1); _Pragma("unroll") for (int m = 0; m < 4; ++m) _Pragma("unroll") for (int n = 0; n < 2; ++n) _Pragma("unroll") for (int k = 0; k < 2; ++k) \
        acc[ai][bj][m][n] = __builtin_amdgcn_mfma_f32_16x16x32_bf16(Bt[n][k], At[m][k], acc[ai][bj][m][n], 0, 0, 0); __builtin_amdgcn_s_setprio(0); } while (0)
#define PG8_WAIT_V(n) asm volatile("s_waitcnt vmcnt(" #n ")" ::: "memory")
#define PG8_WAIT_L(n) asm volatile("s_waitcnt lgkmcnt(" #n ")" ::: "memory")
#define PG8_BAR __builtin_amdgcn_s_barrier()
#define PG8_SCHED __builtin_amdgcn_sched_barrier(0)
    Unit cur, nxt; int ui = 0;
    if (!S.next(0, cur)) return;
    f32x4 acc[2][2][4][2];
#pragma unroll
    for (int a = 0; a < 2; ++a)
#pragma unroll
        for (int b = 0; b < 2; ++b)
#pragma unroll
            for (int m = 0; m < 4; ++m)
#pragma unroll
                for (int n = 0; n < 2; ++n) acc[a][b][m][n] = (f32x4){0.f, 0.f, 0.f, 0.f};
    bf16x8 At[4][2], B0[2][2], B1[2][2];
    const char* cA = (const char*)g.A + (size_t)cur.pm * tstep; const char* cB = (const char*)g.Bt + (size_t)cur.pn * tstep;
    S.a_ready(cur);
    if constexpr (SP2) {
        PG8_STAGE(PG8_SB(0, 0), cB, voffB); PG8_STAGE(PG8_SB(0, 1), cB + hstep, voffB); PG8_STAGE(PG8_SA(0, 0), cA, voffA); PG8_STAGE(PG8_SA(0, 1), cA + hstep, voffA);
        if (wr == 1) PG8_BAR;
        PG8_WAIT_V(2); PG8_BAR;
        PG8_STAGE(PG8_SB(1, 0), cB + kstep, voffB); PG8_STAGE(PG8_SA(1, 0), cA + kstep, voffA); PG8_STAGE(PG8_SB(1, 1), cB + hstep + kstep, voffB);
        PG8_WAIT_V(6); PG8_BAR;
    } else {
        PG8_STAGE(PG8_SB(0, 0), cB, voffB); PG8_STAGE(PG8_SA(0, 0), cA, voffA); PG8_STAGE(PG8_SB(0, 1), cB + hstep, voffB); PG8_STAGE(PG8_SA(0, 1), cA + hstep, voffA);
        if (wr == 1) PG8_BAR;
        PG8_WAIT_V(4); PG8_BAR;
        PG8_STAGE(PG8_SB(1, 0), cB + kstep, voffB); PG8_STAGE(PG8_SA(1, 0), cA + kstep, voffA); PG8_STAGE(PG8_SB(1, 1), cB + hstep + kstep, voffB);
        PG8_WAIT_V(6); PG8_BAR;
    }
    for (;;) {
        const bool has_next = S.next(ui + 1, nxt);
        const char* nA = has_next ? (const char*)g.A + (size_t)nxt.pm * tstep : cA; const char* nB = has_next ? (const char*)g.Bt + (size_t)nxt.pn * tstep : cB;
        for (int t = 0; t < nt; t += 2) {
            if constexpr (epi_has_mid<Epi>::value) { if (t == (nt >> 1)) E.mid(acc, cur, wr, wc, fr, fq); }
            const bool last = (t == nt - 2);
            const char* a1 = cA + (size_t)(t + 1) * kstep;
            const char* a2 = last ? nA : cA + (size_t)(t + 2) * kstep; const char* b2 = last ? nB : cB + (size_t)(t + 2) * kstep;
            const char* a3 = a2 + kstep; const char* b3 = b2 + kstep;
            if (last && has_next) S.a_ready(nxt);
            if constexpr (SP2) {
            PG8_LDB(B0, 0, 0); PG8_LDB(B1, 0, 1); PG8_SCHED; PG8_LDA(At, 0, 0); PG8_STAGE(PG8_SA(1, 1), a1 + hstep, voffA);
            PG8_WAIT_V(8); PG8_WAIT_L(0); PG8_BAR; PG8_MMA(0, 0, At, B0); PG8_MMA(0, 1, At, B1); PG8_BAR; PG8_SCHED;
            PG8_LDA(At, 0, 1); PG8_STAGE(PG8_SB(0, 0), b2, voffB); PG8_STAGE(PG8_SB(0, 1), b2 + hstep, voffB); PG8_STAGE(PG8_SA(0, 0), a2, voffA);
            PG8_WAIT_V(8); PG8_WAIT_L(0); PG8_BAR; PG8_MMA(1, 0, At, B0); PG8_MMA(1, 1, At, B1); PG8_BAR; PG8_SCHED;
            PG8_LDB(B0, 1, 0); PG8_LDB(B1, 1, 1); PG8_SCHED; PG8_LDA(At, 1, 0); PG8_STAGE(PG8_SA(0, 1), a2 + hstep, voffA);
            PG8_WAIT_V(8); PG8_WAIT_L(0); PG8_BAR; PG8_MMA(0, 0, At, B0); PG8_MMA(0, 1, At, B1); PG8_BAR; PG8_SCHED;
            PG8_LDA(At, 1, 1); PG8_STAGE(PG8_SB(1, 0), b3, voffB); PG8_STAGE(PG8_SB(1, 1), b3 + hstep, voffB); PG8_STAGE(PG8_SA(1, 0), a3, voffA);
            PG8_WAIT_V(8); PG8_WAIT_L(0); PG8_BAR; PG8_MMA(1, 0, At, B0); PG8_MMA(1, 1, At, B1); PG8_BAR; PG8_SCHED;
            } else {
            PG8_LDB(B0, 0, 0); PG8_SCHED; PG8_LDA(At, 0, 0); PG8_STAGE(PG8_SA(1, 1), a1 + hstep, voffA);
            PG8_WAIT_L(8); PG8_BAR; PG8_WAIT_L(0); PG8_MMA(0, 0, At, B0); PG8_BAR; PG8_SCHED;
            PG8_LDB(B1, 0, 1); PG8_STAGE(PG8_SB(0, 0), b2, voffB);
            PG8_BAR; PG8_WAIT_L(0); PG8_MMA(0, 1, At, B1); PG8_BAR;
            PG8_LDA(At, 0, 1); PG8_STAGE(PG8_SA(0, 0), a2, voffA);
            PG8_BAR; PG8_WAIT_L(0); PG8_MMA(1, 0, At, B0); PG8_BAR; PG8_SCHED;
            PG8_STAGE(PG8_SB(0, 1), b2 + hstep, voffB);
            PG8_WAIT_V(6); PG8_BAR; PG8_MMA(1, 1, At, B1); PG8_BAR;
            PG8_LDB(B0, 1, 0); PG8_SCHED; PG8_LDA(At, 1, 0); PG8_STAGE(PG8_SA(0, 1), a2 + hstep, voffA);
            PG8_WAIT_L(8); PG8_BAR; PG8_WAIT_L(0); PG8_MMA(0, 0, At, B0); PG8_BAR; PG8_SCHED;
            PG8_LDB(B1, 1, 1); PG8_STAGE(PG8_SB(1, 0), b3, voffB);
            PG8_BAR; PG8_WAIT_L(0); PG8_MMA(0, 1, At, B1); PG8_BAR;
            PG8_LDA(At, 1, 1); PG8_STAGE(PG8_SA(1, 0), a3, voffA);
            PG8_BAR; PG8_WAIT_L(0); PG8_MMA(1, 0, At, B0); PG8_BAR; PG8_SCHED;
            PG8_STAGE(PG8_SB(1, 1), b3 + hstep, voffB);
            PG8_WAIT_V(6); PG8_BAR; PG8_MMA(1, 1, At, B1); PG8_BAR;
            }
        }
        if constexpr (ALIGN_EPI) { if (wr == 0) PG8_BAR; }
        if constexpr (!Epi::AFTER_DRAIN) { E(acc, cur, wr, wc, fr, fq); S.done(cur); }
        if (!has_next) break;
#pragma unroll
        for (int a = 0; a < 2; ++a)
#pragma unroll
            for (int b = 0; b < 2; ++b)
#pragma unroll
                for (int m = 0; m < 4; ++m)
#pragma unroll
                    for (int n = 0; n < 2; ++n) acc[a][b][m][n] = (f32x4){0.f, 0.f, 0.f, 0.f};
        cur = nxt; cA = nA; cB = nB; ++ui;
        if constexpr (ALIGN_EPI) { if (wr == 1) PG8_BAR; }
    }
    PG8_WAIT_V(0);
    if constexpr (!ALIGN_EPI) { if (wr == 0) PG8_BAR; }
    PG8_BAR;
    if constexpr (Epi::AFTER_DRAIN) { E.fused(acc, cur, wr, wc, fr, fq, lds, wid, lane); S.done(cur); }
#undef PG8_SA
#undef PG8_SB
#undef PG8_STAGE
#undef PG8_LDA
#undef PG8_LDB
#undef PG8_MMA
#undef PG8_WAIT_V
#undef PG8_WAIT_L
#undef PG8_BAR
#undef PG8_SCHED
}
}

#ifndef PG8_SP2
#define PG8_SP2 true
#endif
#ifndef PG8_ALIGN
#define PG8_ALIGN true
#endif
#include <hip/hip_bf16.h>
#include <cmath>
namespace attn_body {
using bf16=__hip_bfloat16;
using bf16x8=__attribute__((ext_vector_type(8)))short;
using s16x4=__attribute__((ext_vector_type(4)))short;
using f32x16=__attribute__((ext_vector_type(16)))float;
using u32x4=__attribute__((ext_vector_type(4)))unsigned;
constexpr int BATCH=32,NHEAD=8,SEQ=2048,D=64,DM=1536,OPITCH=1024;
constexpr int NW=8,QBLK=32,QB=QBLK*NW,KVBLK=64,NQB=SEQ/QB;
constexpr int ATTN_PITCH=DM, ATTN_UNIT_ROWS=QB;
__device__ __forceinline__ int crow(int r,int hi){return (r&3)+8*(r>>2)+4*hi;}
#define SBAR() __builtin_amdgcn_sched_barrier(0)
__device__ __forceinline__ void cmask(f32x16&p0,f32x16&p1,int jb,int qrel,int hi){
  const float NEG=-INFINITY; int kb=64*jb+4*hi;
  #pragma unroll
  for(int r=0;r<16;++r){int kv=kb+(r&3)+8*(r>>2); if(kv>qrel)p0[r]=NEG; if(kv+32>qrel)p1[r]=NEG;}
}

constexpr int NSLOT=3, SLOTB=8192;
constexpr int LDS_K=0, LDS_V=NSLOT*SLOTB, LDS_WS=2*NSLOT*SLOTB, LDS_OST=LDS_WS+NW*64*4, LDS_BYTES=LDS_OST+NW*4096;
constexpr float C2=0.125f*1.4426950408889634f;
__device__ __forceinline__ void glds16(const void*gsrc,unsigned lds_dst){unsigned keep;
  asm volatile("s_mov_b32 %0, m0\n\ts_mov_b32 m0, %2\n\ts_nop 0\n\tglobal_load_lds_dwordx4 %1, off\n\ts_mov_b32 m0, %0":"=&s"(keep):"v"(gsrc),"s"(lds_dst):"memory");}
__device__ __forceinline__ float max3f(float a,float b,float c){float r;asm("v_max3_f32 %0, %1, %2, %3":"=v"(r):"v"(a),"v"(b),"v"(c));return r;}
__device__ __forceinline__ float max2f(float a,float b){float r;asm("v_max_f32_e32 %0, %1, %2":"=v"(r):"v"(a),"v"(b));return r;}
__device__ __forceinline__ float fadd_s(float a,float b){float r;asm("v_add_f32_e32 %0, %1, %2":"=v"(r):"v"(a),"v"(b));return r;}
__device__ __forceinline__ float fsub_s(float a,float b){float r;asm("v_sub_f32_e32 %0, %1, %2":"=v"(r):"v"(a),"v"(b));return r;}
typedef float f32x2_t __attribute__((ext_vector_type(2))); typedef __bf16 bf16x2_t __attribute__((ext_vector_type(2)));
__device__ __forceinline__ unsigned cvtpk_s(float lo,float hi){f32x2_t v={lo,hi};bf16x2_t b=__builtin_convertvector(v,bf16x2_t);return __builtin_bit_cast(unsigned,b);}
#define WAIT_BAR(N) asm volatile("s_waitcnt vmcnt(" #N ") lgkmcnt(0)\n\ts_barrier":::"memory")

__device__ __forceinline__ void qkt(f32x16&p0,f32x16&p1,const char*Kslot,const bf16x8*qr,const f32x16&negm,int r32,int hi){
  const char*kb=Kslot+hi*1024+r32*16;
  #pragma unroll
  for(int d0=0;d0<4;++d0){
    const bf16x8 b0=*reinterpret_cast<const bf16x8*>(kb+d0*2048);
    const bf16x8 b1=*reinterpret_cast<const bf16x8*>(kb+d0*2048+512);
    if(d0==0){p0=__builtin_amdgcn_mfma_f32_32x32x16_bf16(b0,qr[0],negm,0,0,0);p1=__builtin_amdgcn_mfma_f32_32x32x16_bf16(b1,qr[0],negm,0,0,0);}
    else{p0=__builtin_amdgcn_mfma_f32_32x32x16_bf16(b0,qr[d0],p0,0,0,0);p1=__builtin_amdgcn_mfma_f32_32x32x16_bf16(b1,qr[d0],p1,0,0,0);}}
}
typedef __attribute__((address_space(3))) const char* lds_cptr;
typedef short v4i16_t __attribute__((ext_vector_type(4)));
__device__ __forceinline__ void kload8(bf16x8*kf,lds_cptr kp){
  kf[0]=*(const __attribute__((address_space(3))) bf16x8*)(kp);      kf[1]=*(const __attribute__((address_space(3))) bf16x8*)(kp+512);
  kf[2]=*(const __attribute__((address_space(3))) bf16x8*)(kp+2048); kf[3]=*(const __attribute__((address_space(3))) bf16x8*)(kp+2560);
  kf[4]=*(const __attribute__((address_space(3))) bf16x8*)(kp+4096); kf[5]=*(const __attribute__((address_space(3))) bf16x8*)(kp+4608);
  kf[6]=*(const __attribute__((address_space(3))) bf16x8*)(kp+6144); kf[7]=*(const __attribute__((address_space(3))) bf16x8*)(kp+6656);
}
__device__ __forceinline__ void kload2(bf16x8*kf,lds_cptr kp,int j){ kf[2*j]=*(const __attribute__((address_space(3))) bf16x8*)(kp+j*2048); kf[2*j+1]=*(const __attribute__((address_space(3))) bf16x8*)(kp+j*2048+512); }
__device__ __forceinline__ s16x4 vtr(lds_cptr p){ return __builtin_bit_cast(s16x4,__builtin_amdgcn_ds_read_tr16_b64_v4i16((__attribute__((address_space(3))) v4i16_t*)p)); }
__device__ __forceinline__ float rowmax(const f32x16&p0,const f32x16&p1){
  float a=max3f(p0[0],p0[1],p1[0]),b=max3f(p0[2],p0[3],p1[1]);a=max3f(a,p1[2],p1[3]);
  #pragma unroll
  for(int r=4;r<16;r+=4){a=max3f(a,p0[r],p0[r+1]);b=max3f(b,p0[r+2],p0[r+3]);a=max3f(a,p1[r],p1[r+1]);b=max3f(b,p1[r+2],p1[r+3]);}
  const float m=max2f(a,b);
  auto rr=__builtin_amdgcn_permlane32_swap(__float_as_uint(m),__float_as_uint(m),false,false);
  return max2f(__uint_as_float(rr[0]),__uint_as_float(rr[1]));
}
__device__ __forceinline__ void pv(f32x16*o,int vb,bf16x8 pa0,bf16x8 pa1,bf16x8 pa2,bf16x8 pa3){
  #pragma unroll
  for(int d0=0;d0<2;++d0){s16x4 lo[4],hi[4];
    #pragma unroll
    for(int ks=0;ks<4;++ks){
      asm volatile("ds_read_b64_tr_b16 %0,%1 offset:%c2":"=&v"(lo[ks]):"v"(vb),"i"(d0*4096+ks*1024):"memory");
      asm volatile("ds_read_b64_tr_b16 %0,%1 offset:%c2":"=&v"(hi[ks]):"v"(vb),"i"(d0*4096+ks*1024+512):"memory");}
    asm volatile("s_waitcnt lgkmcnt(0)":::"memory");SBAR();
    #define PK(k) (bf16x8){lo[k][0],lo[k][1],lo[k][2],lo[k][3],hi[k][0],hi[k][1],hi[k][2],hi[k][3]}
    o[d0]=__builtin_amdgcn_mfma_f32_32x32x16_bf16(pa0,PK(0),o[d0],0,0,0);
    o[d0]=__builtin_amdgcn_mfma_f32_32x32x16_bf16(pa1,PK(1),o[d0],0,0,0);
    o[d0]=__builtin_amdgcn_mfma_f32_32x32x16_bf16(pa2,PK(2),o[d0],0,0,0);
    o[d0]=__builtin_amdgcn_mfma_f32_32x32x16_bf16(pa3,PK(3),o[d0],0,0,0);
    #undef PK
  }
}

#ifndef ATTN_STORE16
#define ATTN_STORE16(p,v) (*(u32x4*)(p)=(v))
#endif
template<int THRL> __device__ __forceinline__ void attn_unit(int b,int h,int qb,const bf16*Q,const bf16*__restrict__ K,const bf16*__restrict__ V,bf16*O,const float*kmean,char*shm){
  int tid_l=threadIdx.x; asm volatile("":"+v"(tid_l)); const int tid=tid_l,lane=tid&63,r32=lane&31,hi=lane>>5; const int wid=__builtin_amdgcn_readfirstlane(tid>>6);
  const long rowbase=(long)b*SEQ; const int q0=qb*QB;
  const bf16*Qw=Q+(rowbase+q0+wid*QBLK)*DM+h*D;
  const bf16*Kh=K+rowbase*DM+h*D,*Vh=V+rowbase*DM+h*D;
  const unsigned lds0=(unsigned)(uintptr_t)shm;
  float*wsf=(float*)(shm+LDS_WS)+wid*64;
  const bf16*ksrc=Kh+(long)lane*DM+wid*8;
  const bf16*vsrc=Vh+(long)(16*(wid&3)+(lane>>2))*DM+(wid>>2)*32+(lane&3)*8;
  const unsigned kdst=lds0+LDS_K+wid*1024, vdst=lds0+LDS_V+wid*1024;
  #define DMA_K(t,slot) glds16(ksrc+(long)(t)*KVBLK*DM,(unsigned)__builtin_amdgcn_readfirstlane(kdst+(slot)))
  #define DMA_V(t,slot) glds16(vsrc+(long)(t)*KVBLK*DM,(unsigned)__builtin_amdgcn_readfirstlane(vdst+(slot)))
  const int vb0=(int)(lds0+LDS_V)+((lane>>4)&1)*32+(lane&3)*8+(4*hi+((lane&15)>>2))*64;
  const char*Kbase=shm+LDS_K; bf16x8 kf[8];
  const lds_cptr shm3=(lds_cptr)shm; const lds_cptr kp0=shm3+LDS_K+hi*1024+r32*16; const lds_cptr vp0=shm3+LDS_V+((lane>>4)&1)*32+(lane&3)*8+(4*hi+((lane&15)>>2))*64;
  const int NT=(q0+QB)/KVBLK;
  DMA_K(0,0);DMA_V(0,0);DMA_K(1,SLOTB);
  bf16x8 qr[4];
  #pragma unroll
  for(int d0=0;d0<4;++d0)qr[d0]=*reinterpret_cast<const bf16x8*>(&Qw[(long)r32*DM+d0*16+hi*8]);
  unsigned selm=0xffu;
  if(qb>=4){ float gsc[7]; const float*km=kmean+((long)(b*NHEAD+h)*8)*64;
    #pragma unroll
    for(int n=0;n<7;++n){ float s=-INFINITY;
      if(n<qb){ s=0.f;
        #pragma unroll
        for(int d0=0;d0<4;++d0){ const float4 k0=*reinterpret_cast<const float4*>(km+n*64+d0*16+hi*8),k1=*reinterpret_cast<const float4*>(km+n*64+d0*16+hi*8+4);
          const bf16x8 qq=qr[d0];
          s+=__uint_as_float((unsigned)(unsigned short)qq[0]<<16)*k0.x+__uint_as_float((unsigned)(unsigned short)qq[1]<<16)*k0.y+__uint_as_float((unsigned)(unsigned short)qq[2]<<16)*k0.z+__uint_as_float((unsigned)(unsigned short)qq[3]<<16)*k0.w
            +__uint_as_float((unsigned)(unsigned short)qq[4]<<16)*k1.x+__uint_as_float((unsigned)(unsigned short)qq[5]<<16)*k1.y+__uint_as_float((unsigned)(unsigned short)qq[6]<<16)*k1.z+__uint_as_float((unsigned)(unsigned short)qq[7]<<16)*k1.w; }
        s+=__shfl_xor(s,32); }
      gsc[n]=s; }
    selm=1u<<qb;
    #pragma unroll
    for(int n=0;n<7;++n){ int rank=0;
      #pragma unroll
      for(int m2=0;m2<7;++m2){ if(m2!=n){ if(gsc[m2]>gsc[n]||(gsc[m2]==gsc[n]&&m2<n))++rank; } }
      if(n<qb&&rank<3)selm|=1u<<n; } }
  float mhat=0.f,l_reg=0.f;f32x16 o[2];o[0]=f32x16{};o[1]=f32x16{};const f32x16 zero16=f32x16{};
  const bf16x8 kones=__builtin_bit_cast(bf16x8,(u32x4){hi==0?0x3F803F80u:0u,0u,0u,0u});
  const int qrel=wid*QBLK+r32;
  #define CMASK0(P0,P1,t) do{int jb_=(t)-(NT-4); if(jb_>=0)cmask(P0,P1,jb_,qrel,hi); else if(!((selm>>((t)>>2))&1u)){ _Pragma("unroll") for(int r_=0;r_<16;++r_){P0[r_]=-INFINITY;P1[r_]=-INFINITY;} } }while(0)
  #define CMASK(P0,P1,t) do{int jb_=(t)-(NT-4); if(jb_>=0)cmask(P0,P1,jb_,qrel,hi);}while(0)
  bool resc=false;
  #define START(P0,P1) do{ const float rm=rowmax(P0,P1); resc=false; \
    { const float dl=__builtin_ceilf(__builtin_fmaxf(rm,-30.f)); mhat=fadd_s(mhat,dl); \
      _Pragma("unroll") for(int r=0;r<16;++r){P0[r]=fsub_s(P0[r],dl);P1[r]=fsub_s(P1[r],dl);} \
      } \
    _Pragma("unroll") for(int r=0;r<16;++r)P0[r]=__builtin_amdgcn_exp2f(P0[r]); }while(0)
  #define RESC() do{ if(resc){ asm volatile("s_waitcnt lgkmcnt(0)":::"memory"); \
      _Pragma("unroll") for(int d_=0;d_<2;++d_) _Pragma("unroll") for(int r=0;r<16;++r)o[d_][r]*=wsf[crow(r,hi)]; } }while(0)
  f32x16 pA0,pA1,pB0,pB1;
  int sl_prev=0,sl_cur=0,sl_next=SLOTB;
  #define ROT() do{sl_prev=sl_cur;sl_cur=sl_next;sl_next=(sl_next==(NSLOT-1)*SLOTB)?0:sl_next+SLOTB;}while(0)
  DMA_K(2,2*SLOTB);
  WAIT_BAR(3);
  qkt(pA0,pA1,Kbase,qr,zero16,r32,hi);asm volatile("s_nop 15\n\ts_nop 7":"+v"(pA0),"+v"(pA1));CMASK0(pA0,pA1,0);
  START(pA0,pA1);
  _Pragma("unroll") for(int r=0;r<16;++r)pA1[r]=__builtin_amdgcn_exp2f(pA1[r]);
  WAIT_BAR(0);
  DMA_K(3,0);DMA_V(1,SLOTB);
  ROT();
  kload8(kf,kp0+sl_cur);
  WAIT_BAR(2);
  s16x4 vlo[8],vhi[8]; u32x4 pw0,pw1,pw2,pw3;
  #define PKW(P,B) cvtpk_s(P[B],P[B+1])
  #define PAF(k) __builtin_bit_cast(bf16x8,pw##k)
  #define VFR(i) (bf16x8){vlo[i][0],vlo[i][1],vlo[i][2],vlo[i][3],vhi[i][0],vhi[i][1],vhi[i][2],vhi[i][3]}
  #define PIN(x) asm volatile("":"+v"(x))
  #define MX3(a,b,c) __builtin_fmaxf(__builtin_fmaxf((a),(b)),(c))
  #define GAPA(MF,A0,A1,A2,A3,W0,W1,PW) do{ MF; sacc+=A0; sacc+=A1; sacc+=A2; sacc+=A3; PIN(sacc); W0; W1; PIN(PW); SBAR(); }while(0)
  #define EX(v) __builtin_amdgcn_exp2f(v)
  #define GAPB(MF,X,B) do{ MF; X[B]=EX(X[B]); X[B+1]=EX(X[B+1]); X[B+2]=EX(X[B+2]); X[B+3]=EX(X[B+3]); PIN(X); SBAR(); }while(0)
  #define VRD(i) do{ vlo[i]=vtr(vp_+(((i)>>2)*4096+((i)&3)*1024)); vhi[i]=vtr(vp_+(((i)>>2)*4096+((i)&3)*1024+512)); }while(0)
  #define KRD(G,j) do{ if(G){ kload2(kf,kp0+sl_next,j); SBAR(); } }while(0)
  #define STEP(C0,C1,P0,P1,t,GK,GV,GL) do{ SBAR(); \
    const lds_cptr vp_=vp0+sl_prev; \
    { const unsigned w_=(hi==0)?((__float_as_uint(-mhat)>>16)|(((selm>>((t)>>2))&1u)?0u:0xC6000000u)):0u; const bf16x8 qaug=__builtin_bit_cast(bf16x8,(u32x4){w_,0u,0u,0u}); \
      C0=__builtin_amdgcn_mfma_f32_32x32x16_bf16(kones,qaug,zero16,0,0,0); C1=__builtin_amdgcn_mfma_f32_32x32x16_bf16(kones,qaug,zero16,0,0,0); } \
    VRD(0); SBAR(); float sacc=(P0[0]+P0[1]); \
    GAPA(C0=__builtin_amdgcn_mfma_f32_32x32x16_bf16(kf[0],qr[0],C0,0,0,0), P0[2],P0[3],P0[4],P0[5],     pw0[0]=PKW(P0,0), pw0[1]=PKW(P0,2), pw0); \
    VRD(4); SBAR(); GAPA(C1=__builtin_amdgcn_mfma_f32_32x32x16_bf16(kf[1],qr[0],C1,0,0,0), P0[6],P0[7],P0[8],P0[9],     pw0[2]=PKW(P0,4), pw0[3]=PKW(P0,6), pw0); \
    VRD(1); SBAR(); GAPA(C0=__builtin_amdgcn_mfma_f32_32x32x16_bf16(kf[2],qr[1],C0,0,0,0),   P0[10],P0[11],P0[12],P0[13], pw1[0]=PKW(P0,8), pw1[1]=PKW(P0,10), pw1); \
    VRD(5); SBAR(); GAPA(C1=__builtin_amdgcn_mfma_f32_32x32x16_bf16(kf[3],qr[1],C1,0,0,0),   P0[14],P0[15],P1[0],P1[1],   pw1[2]=PKW(P0,12),pw1[3]=PKW(P0,14), pw1); \
    VRD(2); SBAR(); GAPA(C0=__builtin_amdgcn_mfma_f32_32x32x16_bf16(kf[4],qr[2],C0,0,0,0),   P1[2],P1[3],P1[4],P1[5],     pw2[0]=PKW(P1,0), pw2[1]=PKW(P1,2), pw2); \
    VRD(6); SBAR(); GAPA(C1=__builtin_amdgcn_mfma_f32_32x32x16_bf16(kf[5],qr[2],C1,0,0,0),   P1[6],P1[7],P1[8],P1[9],     pw2[2]=PKW(P1,4), pw2[3]=PKW(P1,6), pw2); \
    VRD(3); SBAR(); GAPA(C0=__builtin_amdgcn_mfma_f32_32x32x16_bf16(kf[6],qr[3],C0,0,0,0),   P1[10],P1[11],P1[12],P1[13], pw3[0]=PKW(P1,8), pw3[1]=PKW(P1,10), pw3); \
    VRD(7); SBAR(); GAPA(C1=__builtin_amdgcn_mfma_f32_32x32x16_bf16(kf[7],qr[3],C1,0,0,0),   P1[14],P1[15],0.f,0.f,       pw3[2]=PKW(P1,12),pw3[3]=PKW(P1,14), pw3); \
    l_reg+=sacc; \
    if(GK){DMA_K((t)+3,sl_cur);} if(GV){DMA_V((t)+1,sl_next);} \
    CMASK(C0,C1,t); \
    { float a=MX3(C0[0],C0[1],C1[0]),b=MX3(C0[2],C0[3],C1[1]); a=MX3(a,C1[2],C1[3]); \
      _Pragma("unroll") for(int r=4;r<16;r+=4){a=MX3(a,C0[r],C0[r+1]);b=MX3(b,C0[r+2],C0[r+3]);a=MX3(a,C1[r],C1[r+1]);b=MX3(b,C1[r+2],C1[r+3]);} \
      float rm=__builtin_fmaxf(a,b); { auto rr=__builtin_amdgcn_permlane32_swap(__float_as_uint(rm),__float_as_uint(rm),false,false); rm=__builtin_fmaxf(__uint_as_float(rr[0]),__uint_as_float(rr[1])); } \
      resc=false; \
      if(__builtin_expect(__any(rm>(float)THRL),0)){ const float dl=__builtin_ceilf(__builtin_fmaxf(rm,0.f)); mhat+=dl; \
        _Pragma("unroll") for(int r=0;r<16;++r){C0[r]-=dl;C1[r]-=dl;} \
        const float f=__builtin_amdgcn_exp2f(-dl); l_reg*=f; if(hi==0)wsf[r32]=f; resc=true; } } \
    SBAR(); \
    GAPB(o[0]=__builtin_amdgcn_mfma_f32_32x32x16_bf16(PAF(0),VFR(0),o[0],0,0,0), C0,0); \
    GAPB(o[1]=__builtin_amdgcn_mfma_f32_32x32x16_bf16(PAF(0),VFR(4),o[1],0,0,0), C0,4); \
    KRD(GL,0); GAPB(o[0]=__builtin_amdgcn_mfma_f32_32x32x16_bf16(PAF(1),VFR(1),o[0],0,0,0), C0,8); \
    KRD(GL,1); GAPB(o[1]=__builtin_amdgcn_mfma_f32_32x32x16_bf16(PAF(1),VFR(5),o[1],0,0,0), C0,12); \
    KRD(GL,2); GAPB(o[0]=__builtin_amdgcn_mfma_f32_32x32x16_bf16(PAF(2),VFR(2),o[0],0,0,0), C1,0); \
    KRD(GL,3); GAPB(o[1]=__builtin_amdgcn_mfma_f32_32x32x16_bf16(PAF(2),VFR(6),o[1],0,0,0), C1,4); \
    GAPB(o[0]=__builtin_amdgcn_mfma_f32_32x32x16_bf16(PAF(3),VFR(3),o[0],0,0,0), C1,8); \
    GAPB(o[1]=__builtin_amdgcn_mfma_f32_32x32x16_bf16(PAF(3),VFR(7),o[1],0,0,0), C1,12); \
    }while(0)
  int t=1;
  #undef CMASK
  #define CMASK(P0,P1,t) do{}while(0)
  for(;t+5<NT;t+=2){
    STEP(pB0,pB1,pA0,pA1,t,true,true,true);     WAIT_BAR(2); RESC(); ROT();
    STEP(pA0,pA1,pB0,pB1,t+1,true,true,true);   WAIT_BAR(2); RESC(); ROT();
  }
  #undef CMASK
  #define CMASK(P0,P1,t) do{int jb_=(t)-(NT-4); if(jb_>=0)cmask(P0,P1,jb_,qrel,hi);}while(0)
  #define ENDW(tt) do{ if((tt)+3<NT){WAIT_BAR(2);} else if((tt)+2<NT){WAIT_BAR(1);} else {WAIT_BAR(0);} }while(0)
  for(;t+1<NT;t+=2){
    STEP(pB0,pB1,pA0,pA1,t,(t+3<NT),(t+1<NT),(t+1<NT));       ENDW(t);   RESC(); ROT();
    STEP(pA0,pA1,pB0,pB1,t+1,(t+4<NT),(t+2<NT),(t+2<NT));     ENDW(t+1); RESC(); ROT();
  }
  STEP(pB0,pB1,pA0,pA1,NT-1,false,false,false); RESC();
  { float sacc=pB0[0]+pB0[1]; _Pragma("unroll") for(int r=2;r<16;++r)sacc+=pB0[r]; _Pragma("unroll") for(int r=0;r<16;++r)sacc+=pB1[r]; l_reg+=sacc;
    pw0=(u32x4){PKW(pB0,0),PKW(pB0,2),PKW(pB0,4),PKW(pB0,6)};pw1=(u32x4){PKW(pB0,8),PKW(pB0,10),PKW(pB0,12),PKW(pB0,14)};pw2=(u32x4){PKW(pB1,0),PKW(pB1,2),PKW(pB1,4),PKW(pB1,6)};pw3=(u32x4){PKW(pB1,8),PKW(pB1,10),PKW(pB1,12),PKW(pB1,14)};
    SBAR(); pv(o,vb0+sl_cur,PAF(0),PAF(1),PAF(2),PAF(3)); }
  #undef PKW
  #undef PAF
  #undef VFR
  #undef PIN
  #undef MX3
  #undef GAPA
  #undef GAPB
  #undef EX
  #undef VRD
  #undef KRD
  #undef STEP
  #undef ENDW
  {auto rr=__builtin_amdgcn_permlane32_swap(__float_as_uint(l_reg),__float_as_uint(l_reg),false,false);l_reg=__uint_as_float(rr[0])+__uint_as_float(rr[1]);}
  if(hi==0)wsf[32+r32]=l_reg;asm volatile("s_waitcnt lgkmcnt(0)":::"memory");
  float rli[16];
  #pragma unroll
  for(int r=0;r<16;++r)rli[r]=__builtin_amdgcn_rcpf(wsf[32+crow(r,hi)]);
  bf16*Ow=O+(rowbase+q0+wid*QBLK)*OPITCH+h*D;
  { bf16*stg=(bf16*)(shm+LDS_OST)+wid*2048;
    #pragma unroll
    for(int r=0;r<16;++r){const int orow=crow(r,hi);
      #pragma unroll
      for(int d0=0;d0<2;++d0)stg[orow*64+d0*32+r32]=__float2bfloat16(o[d0][r]*rli[r]);}
    asm volatile("s_waitcnt lgkmcnt(0)":::"memory");
    #pragma unroll
    for(int i=0;i<4;++i){const int row=i*8+(lane>>3),ch=lane&7; const u32x4 v=*(const u32x4*)(stg+row*64+ch*8); ATTN_STORE16(Ow+(long)row*OPITCH+ch*8,v);} }
  asm volatile("s_waitcnt lgkmcnt(0)\n\ts_barrier":::"memory");
  #undef DMA_K
  #undef DMA_V
  #undef CMASK
  #undef START
  #undef RESC
  #undef ROT
}
#undef SBAR
#undef WAIT_BAR
}
#define LAS __attribute__((address_space(3)))
typedef unsigned short bf16u;
typedef unsigned v4u __attribute__((ext_vector_type(4)));
typedef float f32x4g __attribute__((ext_vector_type(4)));
typedef short bf16x8g __attribute__((ext_vector_type(8)));
typedef float f32x16g __attribute__((ext_vector_type(16)));

constexpr int MTOK = 65536, SEQL = 2048, DMODEL = 1024, DIN = 5632, DFF = 2816;
constexpr float NEPS = 1e-6f;
constexpr size_t MiB = 1u << 20;
constexpr size_t WS_CTL = 0, WS_ROPE = 1 * MiB, WS_KMEAN = 1 * MiB + 512 * 1024, WS_WIN = 2 * MiB, WS_WA = 13 * MiB, WS_WB = 14 * MiB, WS_WOUT = 15 * MiB, WS_WUP = 17 * MiB, WS_WDN = 28 * MiB;
constexpr size_t WS_XN = 34 * MiB, WS_OA = 34 * MiB, WS_OB = 98 * MiB, WS_BIG = 162 * MiB;
constexpr size_t WS_HG = WS_BIG, WS_QKV = WS_BIG + 256 * MiB, WS_GT = WS_BIG + 448 * MiB, WS_MIX = WS_BIG, WS_UV = WS_BIG, WS_G = WS_BIG + 352 * MiB, WS_END = WS_BIG + 704 * MiB + 24 * MiB;
constexpr size_t WS_UFIRST = WS_BIG + 704 * MiB, WS_VFIRST = WS_UFIRST + 8 * MiB, WS_ULAST = WS_UFIRST + 16 * MiB;
constexpr int RING_BYTES = 131072, MISC_OFF = RING_BYTES + 320, LDS_BYTES = 149504, XCH_OFF = RING_BYTES + 512;
constexpr int NWAVES = 8;
constexpr int CW_BAR = 4096;
constexpr size_t WS_ROWSS = 512 * 1024;

__device__ __forceinline__ unsigned f2bf(float f) { unsigned u = __builtin_bit_cast(unsigned, f); return (u + 0x7fffu + ((u >> 16) & 1u)) >> 16; }
__device__ __forceinline__ unsigned pk2(float lo, float hi) { return pg8::cvt_pk_bf16(lo, hi); }
__device__ __forceinline__ float b2f(unsigned h) { return __uint_as_float(h << 16); }
__device__ __forceinline__ float wave_sum(float v) {
#pragma unroll
    for (int o = 1; o < 64; o <<= 1) v += __shfl_xor(v, o);
    return v;
}
#define LDS_WAIT() asm volatile("s_waitcnt lgkmcnt(0)" ::: "memory")

template <int REMAP, int TILED = 0> __device__ __forceinline__ void p0_transpose_item(const float* W, int K, int N, bf16u* WT, LAS float* scr, int item, int lane, const float* kscale = nullptr, int ldk = 0, int koff = 0) {
    const int nblk = N / 32, kb = item / nblk, nb = item % nblk, k0 = 64 * kb, n0 = 32 * nb;
    int nr = n0;
    if (REMAP == 2) { if (n0 >= 2048 && n0 < 3072) { const int o = n0 - 2048; nr = 2048 + (o & ~255) + 128 * ((o >> 5) & 1) + 32 * ((o >> 6) & 3); }
                      else if (n0 >= 3584) { const int o = (n0 - 3584) & 1023; nr = 3584 + (o >> 7) * 256 + (n0 >= 4608 ? 128 : 0) + (o & 127); } }
    else if (REMAP) { nr = (n0 < DFF) ? ((n0 >> 7) * 256 + (n0 & 127)) : (((n0 - DFF) >> 7) * 256 + 128 + ((n0 - DFF) & 127)); }
    float wv_[32];
#pragma unroll
    for (int i = 0; i < 32; ++i) { const int kk = 2 * i + (lane >> 5); wv_[i] = W[(size_t)(k0 + kk) * N + n0 + (lane & 31)] * (kscale ? kscale[k0 + kk] : 1.0f); }
#pragma unroll
    for (int i = 0; i < 32; ++i) { const int kk = 2 * i + (lane >> 5); scr[kk * 33 + (lane & 31)] = wv_[i]; }
    LDS_WAIT(); asm volatile("" ::: "memory");
    const int c = lane & 7;
#pragma unroll
    for (int j = 0; j < 4; ++j) { const int n = (lane >> 3) + 8 * j; const LAS float* s = scr + (8 * c) * 33 + n;
        v4u o; o.x = pk2(s[0 * 33], s[1 * 33]); o.y = pk2(s[2 * 33], s[3 * 33]); o.z = pk2(s[4 * 33], s[5 * 33]); o.w = pk2(s[6 * 33], s[7 * 33]);
        const int row_ = nr + n;
        if (TILED) *(v4u*)(WT + (size_t)(row_ >> 8) * 256 * K + (size_t)kb * 16384 + (row_ & 255) * 64 + 8 * c) = o;
        else *(v4u*)(WT + (size_t)row_ * (ldk ? ldk : K) + koff + k0 + 8 * c) = o; }
    LDS_WAIT(); asm volatile("" ::: "memory");
}
template <int R, int TILED = 0> __device__ __forceinline__ void rms_rows_to_bf16(const float* xrow, const float* g, bf16u* orow, int lane, int row0 = 0) {
    const f32x4g* gr = (const f32x4g*)g + lane;
    f32x4g v[R][4]; float s[R];
#pragma unroll
    for (int r = 0; r < R; ++r) { const f32x4g* xr = (const f32x4g*)(xrow + (size_t)r * DMODEL) + lane;
#pragma unroll
        for (int j = 0; j < 4; ++j) v[r][j] = xr[64 * j]; }
#pragma unroll
    for (int r = 0; r < R; ++r) { float a = 0.f;
#pragma unroll
        for (int j = 0; j < 4; ++j) a += (v[r][j].x * v[r][j].x + v[r][j].y * v[r][j].y) + (v[r][j].z * v[r][j].z + v[r][j].w * v[r][j].w);
        s[r] = 1.0f / sqrtf(wave_sum(a) * (1.f / DMODEL) + NEPS); }
#pragma unroll
    for (int j = 0; j < 4; ++j) { const f32x4g gg = gr[64 * j];
#pragma unroll
        for (int r = 0; r < R; ++r) { unsigned long long* o8 = (unsigned long long*)(orow + (size_t)r * DMODEL) + lane;
            if (TILED) { const int m_ = row0 + r; o8 = (unsigned long long*)(orow + (size_t)(m_ >> 8) * 256 * DMODEL + (size_t)(4 * j + (lane >> 4)) * 16384 + (m_ & 255) * 64 + 4 * (lane & 15)) - 64 * j; }
            o8[64 * j] = (unsigned long long)pk2(v[r][j].x * s[r] * gg.x, v[r][j].y * s[r] * gg.y) | ((unsigned long long)pk2(v[r][j].z * s[r] * gg.z, v[r][j].w * s[r] * gg.w) << 32); } }
}

__device__ __forceinline__ void qk_one(v4u raw, const float (&g)[8], const float (&cs)[8], const float (&sn)[8], int c, float scale, float (&out)[8]) {
    float x[8];
#pragma unroll
    for (int i = 0; i < 4; ++i) { x[2 * i] = b2f(raw[i] & 0xffffu); x[2 * i + 1] = b2f(raw[i] >> 16); }
    float ss = 0.f;
#pragma unroll
    for (int e = 0; e < 8; ++e) ss += x[e] * x[e];
    ss += __shfl_xor(ss, 1); ss += __shfl_xor(ss, 2); ss += __shfl_xor(ss, 4);
    const float rstd = 1.0f / sqrtf(ss * (1.f / 64.f) + NEPS);
#pragma unroll
    for (int e = 0; e < 8; ++e) { const float y = x[e] * rstd * g[e]; const float py = __shfl_xor(y, 4);
        out[e] = ((c < 4) ? (y * cs[e] - py * sn[e]) : (y * cs[e] + py * sn[e])) * scale; }
}
__device__ __forceinline__ void qk_prep_item(int b, int kb, bf16u* QKV, const float* qg, const float* kg, const float* rope, float* kmean, LAS float* scr, int tid) {
    const int r8 = tid >> 6, cc = tid & 63, hh = cc >> 3, c = cc & 7;
    float gq[8], gk[8], ks[8];
#pragma unroll
    for (int e = 0; e < 8; ++e) { gq[e] = qg[8 * c + e]; gk[e] = kg[8 * c + e]; ks[e] = 0.f; }
    const size_t rowbase = (size_t)b * SEQL + (size_t)kb * 256;
    for (int i = 0; i < 32; ++i) {
        const int rl = i * 8 + r8, pos = kb * 256 + rl;
        bf16u* prow = QKV + (rowbase + rl) * 1536 + hh * 64 + 8 * c;
        const v4u qv = *(const v4u*)prow; const v4u kv = *(const v4u*)(prow + 512);
        const f32x4g* tp = (const f32x4g*)(rope + ((size_t)pos * 32 + 8 * (c & 3)) * 2);
        float cs[8], sn[8];
#pragma unroll
        for (int j = 0; j < 4; ++j) { const f32x4g t = tp[j]; cs[2 * j] = t.x; sn[2 * j] = t.y; cs[2 * j + 1] = t.z; sn[2 * j + 1] = t.w; }
        float oq[8], ok[8];
        qk_one(qv, gq, cs, sn, c, 0.125f * 1.4426950408889634f, oq);
        qk_one(kv, gk, cs, sn, c, 1.0f, ok);
#pragma unroll
        for (int e = 0; e < 8; ++e) ks[e] += ok[e];
        v4u wq, wk;
#pragma unroll
        for (int j = 0; j < 4; ++j) { wq[j] = pk2(oq[2 * j], oq[2 * j + 1]); wk[j] = pk2(ok[2 * j], ok[2 * j + 1]); }
        *(v4u*)prow = wq; *(v4u*)(prow + 512) = wk;
    }
#pragma unroll
    for (int e = 0; e < 8; ++e) scr[(r8 * 64 + cc) * 8 + e] = ks[e];
    __syncthreads();
    { const int col = tid; float s = 0.f;
#pragma unroll
      for (int r = 0; r < 8; ++r) s += scr[(r * 64 + (col >> 3)) * 8 + (col & 7)];
      kmean[(((size_t)b * 8 + (col >> 6)) * 8 + kb) * 64 + (col & 63)] = s * (1.f / 256.f); }
    __syncthreads();
}

constexpr int H_QS = 136, H_SS = 72;
constexpr int L_QE = 0, L_KE = 17408, L_KET = 34816, L_VT = 53248, L_STP = 71680, L_A = 106496, L_TOT = 115712, L_SSB = 117760;
__device__ __forceinline__ int crowg(int r, int hi) { return (r & 3) + 8 * (r >> 2) + 4 * hi; }
#define MFMA32(a, b, c) __builtin_amdgcn_mfma_f32_32x32x16_bf16((a), (b), (c), 0, 0, 0)
#define HBAR() asm volatile("s_waitcnt lgkmcnt(0)\n\ts_barrier" ::: "memory")
__device__ __forceinline__ void hgrn_unit(int item, const bf16u* HG, const float* onorm_g, bf16u* OA, LAS unsigned char* lds, int tid) {
    asm volatile("" : "+v"(tid));
    const int b = item >> 2, h = item & 3;
    const int lane = tid & 63, w = __builtin_amdgcn_readfirstlane(tid >> 6), l31 = lane & 31, hi = lane >> 5;
    const int k = tid & 127, seg = tid >> 7;
    const int vb = w >> 1, tb = w & 1;
    LAS bf16u* QE = (LAS bf16u*)(lds + L_QE); LAS bf16u* KE = (LAS bf16u*)(lds + L_KE); LAS bf16u* KET = (LAS bf16u*)(lds + L_KET);
    LAS bf16u* VT = (LAS bf16u*)(lds + L_VT); LAS bf16u* STP = (LAS bf16u*)(lds + L_STP); LAS bf16u* AL = (LAS bf16u*)(lds + L_A);
    LAS float* TOT = (LAS float*)(lds + L_TOT); LAS float* SSB = (LAS float*)(lds + L_SSB);
    f32x16g st[2];
#pragma unroll
    for (int j = 0; j < 2; ++j)
#pragma unroll
        for (int r = 0; r < 16; ++r) st[j][r] = 0.f;
    unsigned rq[16], rl[16]; v4u rv[2];
#define HLOAD(cc) do { const size_t r0_ = (size_t)b * SEQL + (size_t)(cc) * 64; const bf16u* pq_ = HG + (r0_ + seg * 16) * 2048 + h * 128 + k; \
        _Pragma("unroll") for (int i = 0; i < 16; ++i) { rq[i] = pq_[(size_t)i * 2048]; rl[i] = pq_[(size_t)i * 2048 + 512]; } \
        _Pragma("unroll") for (int j = 0; j < 2; ++j) { const int id_ = tid + 512 * j; rv[j] = *(const v4u*)(HG + (r0_ + (id_ >> 4)) * 2048 + 1024 + h * 128 + (id_ & 15) * 8); } } while (0)
    HLOAD(0);
    for (int c = 0; c < 32; ++c) {
        const size_t row0 = (size_t)b * SEQL + (size_t)c * 64;
        v4u gvv[2];
#pragma unroll
        for (int j = 0; j < 2; ++j) { const int id = tid + 512 * j; gvv[j] = *(const v4u*)(HG + (row0 + (id >> 4)) * 2048 + 1536 + h * 128 + (id & 15) * 8); }
        float lf[16], qv[16], cs[16];
#pragma unroll
        for (int i = 0; i < 16; ++i) { qv[i] = b2f(rq[i]); lf[i] = b2f(rl[i]); }
        { float run = 0.f;
#pragma unroll
          for (int i = 0; i < 16; ++i) { run += lf[i]; cs[i] = run; }
          TOT[seg * 128 + k] = run; }
#pragma unroll
        for (int j = 0; j < 2; ++j) { const int id = tid + 512 * j, s = id >> 4, v0 = (id & 15) * 8; const v4u vv = rv[j];
            *(LAS v4u*)(VT + s * H_QS + v0) = vv; }
        if (c + 1 < 32) HLOAD(c + 1);
        HBAR();
        { const float t0 = TOT[k], t1 = TOT[128 + k], t2 = TOT[256 + k];
          const float mm = t0 + t1; const float p = (seg == 0) ? 0.f : (seg == 1) ? t0 : (seg == 2) ? mm : (mm + t2);
          unsigned kt[8];
#pragma unroll
          for (int ip = 0; ip < 8; ++ip) { const int s = seg * 16 + 2 * ip; const float c0 = p + cs[2 * ip], c1 = p + cs[2 * ip + 1];
              const float f0 = __expf(lf[2 * ip]), f1 = __expf(lf[2 * ip + 1]);
              const float qe0 = qv[2 * ip] * __expf(c0 - mm), qe1 = qv[2 * ip + 1] * __expf(c1 - mm), ke0 = (1.0f - f0) * __expf(mm - c0), ke1 = (1.0f - f1) * __expf(mm - c1);
              const unsigned pq = pk2(qe0, qe1), pk = pk2(ke0, ke1);
              QE[s * H_QS + k] = (bf16u)pq; QE[(s + 1) * H_QS + k] = (bf16u)(pq >> 16); KE[s * H_QS + k] = (bf16u)pk; KE[(s + 1) * H_QS + k] = (bf16u)(pk >> 16);
              kt[ip] = pk; }
          *(LAS v4u*)(KET + k * H_SS + seg * 16) = (v4u){kt[0], kt[1], kt[2], kt[3]};
          *(LAS v4u*)(KET + k * H_SS + seg * 16 + 8) = (v4u){kt[4], kt[5], kt[6], kt[7]}; }
#pragma unroll
        for (int j = 0; j < 2; ++j) { const int kk = (2 * (w & 1) + j) * 32 + l31; const float em = __expf(TOT[kk] + TOT[128 + kk]);
#pragma unroll
            for (int r = 0; r < 16; r += 2) { const unsigned pp = pk2(st[j][r] * em, st[j][r + 1] * em); const int v = vb * 32 + crowg(r, hi); STP[v * H_QS + kk] = (bf16u)pp; STP[(v + 1) * H_QS + kk] = (bf16u)(pp >> 16); } }
        HBAR();
        f32x16g o;
#pragma unroll
        for (int r = 0; r < 16; ++r) o[r] = 0.f;
#pragma unroll
        for (int ks = 0; ks < 8; ++ks) { const bf16x8g a = *(const LAS bf16x8g*)(STP + (vb * 32 + l31) * H_QS + ks * 16 + 8 * hi);
            const bf16x8g bq = *(const LAS bf16x8g*)(QE + (tb * 32 + l31) * H_QS + ks * 16 + 8 * hi); o = MFMA32(a, bq, o); }
        if (w < 4) { const int sb = vb; f32x16g A;
#pragma unroll
            for (int r = 0; r < 16; ++r) A[r] = 0.f;
            if (!(sb == 1 && tb == 0)) {
#pragma unroll
                for (int ks = 0; ks < 8; ++ks) { const bf16x8g a = *(const LAS bf16x8g*)(KE + (sb * 32 + l31) * H_QS + ks * 16 + 8 * hi);
                    const bf16x8g bq = *(const LAS bf16x8g*)(QE + (tb * 32 + l31) * H_QS + ks * 16 + 8 * hi); A = MFMA32(a, bq, A); } }
            const int t = tb * 32 + l31;
#pragma unroll
            for (int g = 0; g < 4; ++g) { const int s0 = sb * 32 + 8 * g + 4 * hi;
                const float a0 = (s0 + 0 <= t) ? A[4 * g + 0] : 0.f, a1 = (s0 + 1 <= t) ? A[4 * g + 1] : 0.f, a2 = (s0 + 2 <= t) ? A[4 * g + 2] : 0.f, a3 = (s0 + 3 <= t) ? A[4 * g + 3] : 0.f;
                typedef unsigned u2v __attribute__((ext_vector_type(2)));
                *(LAS u2v*)(AL + t * H_SS + s0) = (u2v){pk2(a0, a1), pk2(a2, a3)}; } }
        HBAR();
        { bf16x8g av[4];
#pragma unroll
          for (int ss = 0; ss < 4; ++ss)
#pragma unroll
              for (int e = 0; e < 8; ++e) av[ss][e] = (short)VT[(ss * 16 + 8 * hi + e) * H_QS + vb * 32 + l31];
#pragma unroll
          for (int ss = 0; ss < 4; ++ss) { const bf16x8g ba = *(const LAS bf16x8g*)(AL + (tb * 32 + l31) * H_SS + ss * 16 + 8 * hi); o = MFMA32(av[ss], ba, o); }
#pragma unroll
          for (int j = 0; j < 2; ++j) { const int kk = (2 * (w & 1) + j) * 32 + l31; f32x16g W;
#pragma unroll
              for (int r = 0; r < 16; ++r) W[r] = 0.f;
#pragma unroll
              for (int ss = 0; ss < 4; ++ss) { const bf16x8g bk = *(const LAS bf16x8g*)(KET + kk * H_SS + ss * 16 + 8 * hi); W = MFMA32(av[ss], bk, W); }
              const float mk = TOT[kk] + TOT[128 + kk], lastk = mk + TOT[256 + kk] + TOT[384 + kk];
              const float el = __expf(lastk), elm = __expf(lastk - mk);
#pragma unroll
              for (int r = 0; r < 16; ++r) st[j][r] = el * st[j][r] + elm * W[r]; } }
        { float q = 0.f;
#pragma unroll
          for (int r = 0; r < 16; ++r) q += o[r] * o[r];
          q += __shfl_xor(q, 32);
          if (hi == 0) SSB[vb * 64 + tb * 32 + l31] = q; }
        HBAR();
        { const int t = tb * 32 + l31; const float tot = (SSB[t] + SSB[64 + t]) + (SSB[128 + t] + SSB[192 + t]);
          const float rstd = 1.0f / sqrtf(tot * (1.f / 128.f) + NEPS);
#pragma unroll
          for (int g = 0; g < 4; ++g) { typedef unsigned u2w __attribute__((ext_vector_type(2)));
              *(LAS u2w*)(QE + t * H_QS + vb * 32 + 8 * g + 4 * hi) = (u2w){pk2(o[4 * g] * rstd, o[4 * g + 1] * rstd), pk2(o[4 * g + 2] * rstd, o[4 * g + 3] * rstd)}; } }
        HBAR();
#pragma unroll
        for (int j = 0; j < 2; ++j) { const int id = tid + 512 * j, t = id >> 4, v0 = (id & 15) * 8;
            const v4u ov = *(const LAS v4u*)(QE + t * H_QS + v0);
            const v4u gv = gvv[j];
            const f32x4g g0 = *(const f32x4g*)(onorm_g + h * 128 + v0), g1 = *(const f32x4g*)(onorm_g + h * 128 + v0 + 4);
            const float gn[8] = {g0.x, g0.y, g0.z, g0.w, g1.x, g1.y, g1.z, g1.w};
            v4u wv;
#pragma unroll
            for (int i = 0; i < 4; ++i) wv[i] = pk2(b2f(ov[i] & 0xffffu) * gn[2 * i] * b2f(gv[i] & 0xffffu), b2f(ov[i] >> 16) * gn[2 * i + 1] * b2f(gv[i] >> 16));
            *(v4u*)(OA + (row0 + t) * 1024 + h * 128 + v0) = wv; }
        HBAR();
    }
}

#undef HLOAD
#define GAS __attribute__((address_space(1)))
typedef GAS unsigned gu32;
#define XB_TMO      128
#define XB_XCNT(j)  (256  + 64 * (j))
#define XB_XSUB(j)  (1280 + 64 * (j))
#define XB_XGEN(j)  (2304 + 64 * (j))
#define XB_TOP      3328
#define XB_TOPGEN   3392
#define XCD_BAR_WORDS 3456
#define XB_SPIN_CAP (1u << 18)

__device__ __forceinline__ unsigned xb_ld(unsigned* p)              { return __hip_atomic_load(p, __ATOMIC_RELAXED, __HIP_MEMORY_SCOPE_AGENT); }
__device__ __forceinline__ unsigned xb_add(unsigned* p, unsigned v) { return __hip_atomic_fetch_add(p, v, __ATOMIC_RELAXED, __HIP_MEMORY_SCOPE_AGENT); }
__device__ __forceinline__ unsigned xb_xcc_id() { return (unsigned)__builtin_amdgcn_s_getreg((3 << 11) | 20) & 0xFu; }
#define XB_SPIN(cond, bar) do { unsigned _sp = 0; while (cond) { __builtin_amdgcn_s_sleep(1); \
    if ((++_sp & 255u) == 0u) { if (xb_ld(&(bar)[XB_TMO])) break; if (_sp > XB_SPIN_CAP) { atomicAdd(&(bar)[XB_TMO], 1u); break; } } } } while (0)

struct XcdBarrier {
    unsigned* bar; unsigned x;
    volatile LAS unsigned* st;
};

__device__ __forceinline__ XcdBarrier xcd_barrier_post(unsigned* bar, volatile LAS unsigned* st) {
    XcdBarrier b; b.bar = bar; b.x = xb_xcc_id(); b.st = st;
    if (threadIdx.x == 0) (void)xb_add(&bar[XB_XCNT(b.x)], 1u);
    return b;
}
__device__ __forceinline__ void xcd_barrier_complete(unsigned* bar, unsigned x, unsigned& nloc, unsigned& nx) {
    const unsigned G = gridDim.x * gridDim.y * gridDim.z;
    unsigned sum, cnt, mine, sp = 0u;
    for (;;) {
        sum = 0u; cnt = 0u; mine = 0u;
#pragma unroll
        for (unsigned j = 0; j < 16; ++j) { const unsigned c = xb_ld(&bar[XB_XCNT(j)]); sum += c; cnt += (c > 0u) ? 1u : 0u; mine = (j == x) ? c : mine; }
        if (sum == G) break;
        __builtin_amdgcn_s_sleep(1);
        if ((++sp & 255u) == 0u) { if (xb_ld(&bar[XB_TMO])) break; if (sp > XB_SPIN_CAP) { atomicAdd(&bar[XB_TMO], 1u); break; } }
    }
    nloc = mine > 0u ? mine : 1u; nx = cnt > 0u ? cnt : 1u;
}

__device__ __forceinline__ void xcd_barrier(const XcdBarrier& b) {
    asm volatile("s_waitcnt vmcnt(0)" ::: "memory");
    __syncthreads();
    if (threadIdx.x == 0) {
        unsigned* bar = b.bar;
        __builtin_amdgcn_s_waitcnt(0);
        unsigned nloc = b.st[0], nx = b.st[1];
        if (nloc == 0u) { xcd_barrier_complete(bar, b.x, nloc, nx); b.st[0] = nloc; b.st[1] = nx; }
        const unsigned old = xb_add(&bar[XB_XSUB(b.x)], 1u);
        const unsigned gen = old / nloc;
        if (old + 1u == (gen + 1u) * nloc) {
            __builtin_amdgcn_fence(__ATOMIC_RELEASE, "agent");
            asm volatile("s_waitcnt vmcnt(0)" ::: "memory");
            const unsigned og = xb_add(&bar[XB_TOP], 1u);
            const unsigned tg = og / nx;
            if (og + 1u == (tg + 1u) * nx) xb_add(&bar[XB_TOPGEN], 1u);
            else XB_SPIN(xb_ld(&bar[XB_TOPGEN]) == tg, bar);
            __builtin_amdgcn_fence(__ATOMIC_ACQUIRE, "agent");
            xb_add(&bar[XB_XGEN(b.x)], 1u);
            asm volatile("s_waitcnt vmcnt(0)" ::: "memory");
        } else {
            XB_SPIN(xb_ld(&bar[XB_XGEN(b.x)]) == gen, bar);
            __builtin_amdgcn_fence(__ATOMIC_ACQUIRE, "agent");
            asm volatile("s_waitcnt vmcnt(0)" ::: "memory");
        }
    }
    __syncthreads();
}

struct Args { const float* in[15]; float* out; unsigned char* ws; };
__global__ void __launch_bounds__(NWAVES * 64, 2) fwd_kernel(Args args) {
    extern __shared__ __attribute__((aligned(16))) unsigned char lds_raw[];
    cg::grid_group grid = cg::this_grid();
    LAS unsigned char* lds = (LAS unsigned char*)lds_raw;
    const int G = gridDim.x, bx = blockIdx.x;
    if (threadIdx.x < 32) ((volatile LAS unsigned*)(lds + MISC_OFF))[threadIdx.x] = 0u;
    __syncthreads();
#define PHASE_IDS int tid = threadIdx.x; asm volatile("" : "+v"(tid)); const int lane = tid & 63, wave = __builtin_amdgcn_readfirstlane(tid >> 6); const int gw = bx * NWAVES + wave, NGW = G * NWAVES; const int gt = bx * (NWAVES * 64) + tid, NGT = G * NWAVES * 64; (void)lane; (void)gw; (void)NGW; (void)gt; (void)NGT;
#define ws (args.ws)
#define X_IN (args.in[0])
#define norm1_g (args.in[1])
#define w_in (args.in[2])
#define lb_logits (args.in[3])
#define onorm_g (args.in[4])
#define qn_g (args.in[5])
#define kn_g (args.in[6])
#define w_a (args.in[7])
#define w_b (args.in[8])
#define w_out (args.in[9])
#define norm2_g (args.in[10])
#define w_up (args.in[11])
#define conv_w (args.in[12])
#define conv_b (args.in[13])
#define w_down (args.in[14])
#define OUT_P (args.out)
#define ctl ((unsigned*)(ws + WS_CTL))
#define rope ((float*)(ws + WS_ROPE))
#define kmean ((float*)(ws + WS_KMEAN))
#define Win_t ((bf16u*)(ws + WS_WIN))
#define Wa_t ((bf16u*)(ws + WS_WA))
#define Wb_t ((bf16u*)(ws + WS_WB))
#define Wout_t ((bf16u*)(ws + WS_WOUT))
#define Wup_t ((bf16u*)(ws + WS_WUP))
#define Wdn_t ((bf16u*)(ws + WS_WDN))
#define XN ((bf16u*)(ws + WS_XN))
#define OA ((bf16u*)(ws + WS_OA))
#define OB ((bf16u*)(ws + WS_OB))
#define HG ((bf16u*)(ws + WS_HG))
#define QKV ((bf16u*)(ws + WS_QKV))
#define GT ((bf16u*)(ws + WS_GT))
#define MIX ((bf16u*)(ws + WS_MIX))
#define UV ((bf16u*)(ws + WS_UV))
#define GB ((bf16u*)(ws + WS_G))

    { PHASE_IDS
        LAS float* scr = (LAS float*)(lds + wave * 16384);
        constexpr int I_IN = (DMODEL / 64) * (DIN / 32), I_A = (512 / 64) * (DMODEL / 32), I_OUT = (DMODEL / 64) * (DMODEL / 32), I_DN = (DFF / 64) * (DMODEL / 32);
        constexpr int NITEMS = 2 * I_IN + 2 * I_A + I_OUT + I_DN;
        for (int it = gw; it < NITEMS; it += NGW) {
            int r = it;
            if (r < I_IN) { p0_transpose_item<2, 1>(w_in, DMODEL, DIN, Win_t, scr, r, lane); continue; } r -= I_IN;
            if (r < I_IN) { p0_transpose_item<1>(w_up, DMODEL, DIN, Wup_t, scr, r, lane, norm2_g); continue; } r -= I_IN;
            if (r < I_A) { p0_transpose_item<0>(w_a, 512, DMODEL, Wa_t, scr, r, lane, nullptr, 1024, 0); continue; } r -= I_A;
            if (r < I_A) { p0_transpose_item<0>(w_b, 512, DMODEL, Wa_t, scr, r, lane, nullptr, 1024, 512); continue; } r -= I_A;
            if (r < I_OUT) { p0_transpose_item<0>(w_out, DMODEL, DMODEL, Wout_t, scr, r, lane); continue; } r -= I_OUT;
            p0_transpose_item<0>(w_down, DFF, DMODEL, Wdn_t, scr, r, lane);
        }
        for (int m = gw * 4; m < MTOK; m += NGW * 4) rms_rows_to_bf16<4, 1>(X_IN + (size_t)m * DMODEL, norm1_g, XN, lane, m);
        for (int e = gt; e < SEQL * 32; e += NGT) { const int pos = e >> 5, i = e & 31;
            const float inv = 1.0f / exp2f((float)i * (13.287712379549449f / 32.0f));
            const float ang = (float)pos * inv; float rv = ang * 0.15915494309189535f; rv -= floorf(rv);
            rope[2 * e] = __builtin_amdgcn_cosf(rv); rope[2 * e + 1] = __builtin_amdgcn_sinf(rv); }
        if (gt == 0) ctl[0] = 0u;
        for (int e = gt; e < MTOK; e += NGT) ((float*)(ws + WS_ROWSS))[e] = 0.f;
        for (int e = gt; e < 32 * 8 * 8 * 64; e += NGT) kmean[e] = 0.f;
        if (bx == 0) for (int i = tid; i < XCD_BAR_WORDS; i += NWAVES * 64) ctl[CW_BAR + i] = 0u;
    }
    grid.sync();
    XcdBarrier xbar = xcd_barrier_post(ctl + CW_BAR, (volatile LAS unsigned*)(lds + MISC_OFF) + 8);

    {
        pg8::Gemm g{XN, Win_t, MTOK, DIN, DMODEL}; pg8::StaticOrder S; S.init(MTOK, DIN, G, bx);
        pg8::EpiInProj E{HG, QKV, GT, lb_logits, qn_g, kn_g, rope, kmean};
        pg8::gemm_phase<pg8::EpiInProj, pg8::StaticOrder, PG8_ALIGN, PG8_SP2, true>(lds, g, S, E);
    }
    xcd_barrier(xbar);

    { PHASE_IDS
        volatile LAS unsigned* MISC = (volatile LAS unsigned*)(lds + MISC_OFF);
        for (;;) {
            if (tid == 0) MISC[0] = __hip_atomic_fetch_add(ctl, 1u, __ATOMIC_RELAXED, __HIP_MEMORY_SCOPE_AGENT);
            __syncthreads();
            const int item = (int)MISC[0];
            __syncthreads();
            if (item >= 128 + 2048) break;
            if (item < 128) hgrn_unit(item, HG, onorm_g, OA, lds, tid);
            else { const int j = item - 128, qb = 7 - (j >> 8), bh = j & 255;
                attn_body::attn_unit<8>(bh >> 3, bh & 7, qb, (const attn_body::bf16*)QKV, (const attn_body::bf16*)(QKV + 512), (const attn_body::bf16*)(QKV + 1024), (attn_body::bf16*)(OA + 512), kmean, (char*)lds_raw); }
        }
    }
    xcd_barrier(xbar);

    {
        pg8::Gemm g{OA, Wa_t, MTOK, DMODEL, DMODEL}; pg8::StaticOrder S; S.init(MTOK, DMODEL, G, bx);
        pg8::EpiMix E{MIX, GT};
        pg8::gemm_phase<pg8::EpiMix, pg8::StaticOrder, PG8_ALIGN, PG8_SP2>(lds, g, S, E);
    }
    xcd_barrier(xbar);

    {
        pg8::Gemm g{MIX, Wout_t, MTOK, DMODEL, DMODEL}; pg8::StaticOrder S; S.init(MTOK, DMODEL, G, bx);
        pg8::EpiResNorm E{X_IN, OUT_P, XN, (float*)(ws + WS_ROWSS)};
        pg8::gemm_phase<pg8::EpiResNorm, pg8::StaticOrder, PG8_ALIGN, PG8_SP2>(lds, g, S, E);
    }
    xcd_barrier(xbar);

    {
        pg8::Gemm g{XN, Wup_t, MTOK, DIN, DMODEL}; pg8::StaticOrder S; S.init(MTOK, DIN, G, bx);
        pg8::EpiUpConv E{GB, conv_w, conv_b, (float*)(ws + WS_UFIRST), (float*)(ws + WS_VFIRST), (float*)(ws + WS_ULAST), (LAS float*)(lds + XCH_OFF), (const float*)(ws + WS_ROWSS)};
        pg8::gemm_phase<pg8::EpiUpConv, pg8::StaticOrder, true, PG8_SP2>(lds, g, S, E);
    }
    xcd_barrier(xbar);
    { PHASE_IDS
        const float* ufirst = (const float*)(ws + WS_UFIRST); const float* vfirst = (const float*)(ws + WS_VFIRST); const float* ulast = (const float*)(ws + WS_ULAST);
        for (int idx = gt; idx < 256 * 2 * 352; idx += NGT) {
            const int pm = idx / 704, rem = idx - pm * 704, j = rem / 352, c0 = (rem - j * 352) * 8; const bool seq0 = (pm & 7) == 0;
            v4u wv;
#pragma unroll
            for (int i = 0; i < 4; ++i) { float rr[2];
#pragma unroll
                for (int hh = 0; hh < 2; ++hh) { const int c = c0 + 2 * i + hh;
                    const float uc = ufirst[(size_t)(pm * 2 + j) * DFF + c];
                    float um1, um2;
                    if (j == 0) { um1 = seq0 ? 0.f : ulast[(size_t)((pm - 1) * 2 + 1) * DFF + c]; um2 = seq0 ? 0.f : ulast[(size_t)((pm - 1) * 2 + 0) * DFF + c]; }
                    else { um1 = ufirst[(size_t)(pm * 2 + 0) * DFF + c]; um2 = seq0 ? 0.f : ulast[(size_t)((pm - 1) * 2 + 1) * DFF + c]; }
                    rr[hh] = conv_b[c] + conv_w[c] * um2 + conv_w[DFF + c] * um1 + conv_w[2 * DFF + c] * uc; }
                const pg8::f32x2 gl = pg8::gelu_pk((pg8::f32x2){rr[0], rr[1]});
                wv[i] = pk2(gl.x * vfirst[(size_t)(pm * 2 + j) * DFF + c0 + 2 * i], gl.y * vfirst[(size_t)(pm * 2 + j) * DFF + c0 + 2 * i + 1]); }
            *(v4u*)(GB + (size_t)(pm * 256 + j) * DFF + c0) = wv;
        }
    }
    xcd_barrier(xbar);

    {
        pg8::Gemm g{GB, Wdn_t, MTOK, DMODEL, DFF}; pg8::StaticOrder S; S.init(MTOK, DMODEL, G, bx);
        pg8::EpiResBf E{XN, OUT_P};
        pg8::gemm_phase<pg8::EpiResBf, pg8::StaticOrder, PG8_ALIGN, PG8_SP2>(lds, g, S, E);
    }
}

#undef ws
#undef X_IN
#undef norm1_g
#undef w_in
#undef lb_logits
#undef onorm_g
#undef qn_g
#undef kn_g
#undef w_a
#undef w_b
#undef w_out
#undef norm2_g
#undef w_up
#undef conv_w
#undef conv_b
#undef w_down
#undef OUT_P
#undef ctl
#undef rope
#undef kmean
#undef Win_t
#undef Wa_t
#undef Wb_t
#undef Wout_t
#undef Wup_t
#undef Wdn_t
#undef XN
#undef OA
#undef OB
#undef HG
#undef QKV
#undef GT
#undef MIX
#undef UV
#undef GB
extern "C" void kernel_launch(void* const* d_in, const int* in_sizes, int n_in, void* d_out, int out_size, void* d_ws, size_t ws_size, hipStream_t stream) {
    static int grid = 0;
    if (grid == 0) {
        if (n_in != 15 || out_size != MTOK * DMODEL || ws_size < WS_END) { fprintf(stderr, "kernel_launch: unexpected shapes (n_in %d out %d ws %zu)\n", n_in, out_size, ws_size); grid = -1; return; }
        int dev = 0, cus = 0, per_cu = 0;
        (void)hipGetDevice(&dev); (void)hipDeviceGetAttribute(&cus, hipDeviceAttributeMultiprocessorCount, dev);
        if (hipFuncSetAttribute((const void*)fwd_kernel, hipFuncAttributeMaxDynamicSharedMemorySize, LDS_BYTES) != hipSuccess) { fprintf(stderr, "kernel_launch: hipFuncSetAttribute failed\n"); grid = -1; return; }
        if (hipOccupancyMaxActiveBlocksPerMultiprocessor(&per_cu, (const void*)fwd_kernel, NWAVES * 64, LDS_BYTES) != hipSuccess || per_cu < 1) per_cu = 1;
        (void)hipGetLastError();
        grid = cus * 1;
        if (grid <= 0) grid = 256;
    }
    if (grid < 0) return;
    Args a{};
    for (int i = 0; i < 15; ++i) a.in[i] = (const float*)d_in[i];
    a.out = (float*)d_out; a.ws = (unsigned char*)d_ws;
    void* kargs[] = {&a};
    hipError_t e = hipLaunchCooperativeKernel((const void*)fwd_kernel, dim3(grid), dim3(NWAVES * 64), kargs, LDS_BYTES, stream);
    if (e != hipSuccess) fprintf(stderr, "kernel_launch: cooperative launch failed: %s (grid %d)\n", hipGetErrorString(e), grid);
}
```
